# Optimizing an MI355X kernel written in HIP

```python
import math
import jax, jax.numpy as jnp
from jax import lax
import numpy as np

D_MODEL = 1024
BATCH = 32
SEQ = 2048
DEPTH = 2

CTX_LEN = 256
GRID_W = 64
EPS = 1e-6

N_MIX_GROUPS = 4
GROUP_W = D_MODEL // N_MIX_GROUPS
D_MIX = N_MIX_GROUPS * GROUP_W

MLA_HEADS = 4
MLA_NOPE = 64
MLA_ROPE = 32
MLA_QK = MLA_NOPE + MLA_ROPE
MLA_V = GROUP_W // MLA_HEADS
MLA_Q_RANK = 3 * D_MODEL // 16
MLA_KV_RANK = D_MODEL // 8
ROPE_BASE = 10000.0
ATTN_BLOCK = 128

RET_HEADS = 4
RET_DK = 64
RET_DV = GROUP_W // RET_HEADS
RET_CHUNK = 128

HY_CH = GROUP_W
HY_CONV = 3
HY_BANDS = 16
HY_EMB = 1 + 2 * HY_BANDS
HY_FFN = 64
HY_FAST_PCT = 0.3
HY_SLOW_PCT = 1.5
HY_TARGET = 1e-2

LRU_W = GROUP_W
LRU_BLOCKS = 4
LRU_BW = LRU_W // LRU_BLOCKS
LRU_CONV = 4
LRU_C = 8.0

MOE_GROUPS = 4
MOE_PER_GROUP = 8
N_EXPERTS = MOE_GROUPS * MOE_PER_GROUP
TOP_K = 2
EXPERT_FF = D_MODEL // 2
MOE_BLOCK = 128

IN_SPLITS = (MLA_Q_RANK, MLA_KV_RANK, MLA_ROPE,
             RET_HEADS * RET_DK, RET_HEADS * RET_DK, GROUP_W, GROUP_W,
             3 * HY_CH, LRU_W, LRU_W)
IN_COLS = sum(IN_SPLITS)

kernel_name = 'hybrid_mla_retnet_hyena_rglru_hmoe_dit'


def rms_norm(x, g):
    xf = x.astype(jnp.float32)
    y = xf * lax.rsqrt(jnp.mean(xf * xf, axis=-1, keepdims=True) + EPS)
    return (y * g.astype(jnp.float32)).astype(x.dtype)


def modulate(h, shift, scale):
    return h * (1 + scale) + shift


def split_cols(z):
    out, o = [], 0
    for w in IN_SPLITS:
        out.append(z[..., o:o + w])
        o += w
    return out


def dwconv(x, w, b, pad_left):
    width, ch = w.shape
    y = lax.conv_general_dilated(x, w[:, None, :].astype(x.dtype), window_strides=(1,),
                                 padding=[(pad_left, width - 1 - pad_left)],
                                 dimension_numbers=('NWC', 'WIO', 'NWC'), feature_group_count=ch)
    return y + b.astype(x.dtype)


def axial_rope_angles(n_tokens):
    rows = n_tokens // GRID_W
    row = jnp.repeat(jnp.arange(rows), GRID_W).astype(jnp.float32)
    col = jnp.tile(jnp.arange(GRID_W), rows).astype(jnp.float32)
    half = MLA_ROPE // 4
    inv_freq = ROPE_BASE ** (-jnp.arange(half, dtype=jnp.float32) / half)
    ang = jnp.stack([row[:, None] * inv_freq, col[:, None] * inv_freq], axis=1)
    return jnp.cos(ang), jnp.sin(ang)


def apply_axial_rope(x, cos, sin):
    b, l, h, _ = x.shape
    xr = x.astype(jnp.float32).reshape(b, l, h, 2, 2, MLA_ROPE // 4)
    x1, x2 = xr[..., 0, :], xr[..., 1, :]
    cc, ss = cos[None, :, None], sin[None, :, None]
    out = jnp.stack([x1 * cc - x2 * ss, x2 * cc + x1 * ss], axis=-2)
    return out.reshape(b, l, h, MLA_ROPE).astype(x.dtype)


def rope_tail(t, cos, sin):
    return jnp.concatenate([t[..., :MLA_NOPE], apply_axial_rope(t[..., MLA_NOPE:], cos, sin)], axis=-1)


def mla_qkv(cq, ckv, kr, p):
    b, l, _ = cq.shape
    q = (rms_norm(cq, p['mla_q_norm_g']) @ p['mla_w_uq']).reshape(b, l, MLA_HEADS, MLA_QK)
    kv = (rms_norm(ckv, p['mla_kv_norm_g']) @ p['mla_w_ukv']).reshape(b, l, MLA_HEADS, MLA_NOPE + MLA_V)
    k_nope, v = kv[..., :MLA_NOPE], kv[..., MLA_NOPE:]
    k = jnp.concatenate([k_nope, jnp.broadcast_to(kr[:, :, None, :], (b, l, MLA_HEADS, MLA_ROPE))], axis=-1)
    return rms_norm(q, p['mla_qn_g']), rms_norm(k, p['mla_kn_g']), v


def softmax_attend(q, k, v):
    s = jnp.einsum('bqhd,bkhd->bhqk', q, k).astype(jnp.float32) * (MLA_QK ** -0.5)
    pr = jax.nn.softmax(s, axis=-1).astype(v.dtype)
    return jnp.einsum('bhqk,bkhd->bqhd', pr, v)


def blocked_attend(q, k, v):
    b, l, h, d = q.shape
    nb = l // ATTN_BLOCK
    qb = jnp.moveaxis(q.reshape(b, nb, ATTN_BLOCK, h, d), 1, 0)
    ob = lax.map(lambda qq: softmax_attend(qq, k, v), qb)
    return jnp.moveaxis(ob, 0, 1).reshape(b, l, h * v.shape[-1])


def ret_heads(zq, zk, zv):
    b, l, _ = zq.shape
    q = zq.astype(jnp.float32).reshape(b, l, RET_HEADS, RET_DK)
    k = zk.astype(jnp.float32).reshape(b, l, RET_HEADS, RET_DK) * (RET_DK ** -0.5)
    v = zv.astype(jnp.float32).reshape(b, l, RET_HEADS, RET_DV)
    return q, k, v


def retention_state(k, v, log_gamma):
    l = k.shape[1]
    w = jnp.exp((l - 1 - jnp.arange(l, dtype=jnp.float32))[:, None] * log_gamma)
    return jnp.einsum('blhk,blhv,lh->bhkv', k, v, w)


def retention_chunkwise(q, k, v, log_gamma, s0):
    b, l, h, dk = q.shape
    dv = v.shape[-1]
    n = l // RET_CHUNK
    j = jnp.arange(RET_CHUNK, dtype=jnp.float32)
    qc = q.reshape(b, n, RET_CHUNK, h, dk)
    kc = k.reshape(b, n, RET_CHUNK, h, dk)
    vc = v.reshape(b, n, RET_CHUNK, h, dv)
    rel = j[:, None] - j[None, :]
    dmask = jnp.where(rel[None] >= 0,
                      jnp.exp(jnp.maximum(rel, 0.0)[None] * log_gamma[:, None, None]), 0.0)
    inner = jnp.einsum('bnihk,bnjhk->bnhij', qc, kc) * dmask
    inner = jnp.einsum('bnhij,bnjhv->bnihv', inner, vc)
    k_dec = kc * jnp.exp((RET_CHUNK - 1 - j)[:, None] * log_gamma)[:, :, None]
    kv = jnp.einsum('bnjhk,bnjhv->nbhkv', k_dec, vc)
    chunk_decay = jnp.exp(RET_CHUNK * log_gamma)[None, :, None, None]

    def step(state, kv_i):
        return state * chunk_decay + kv_i, state

    _, prev = lax.scan(step, s0, kv)
    q_dec = qc * jnp.exp((j + 1)[:, None] * log_gamma)[:, :, None]
    cross = jnp.einsum('bnihk,nbhkv->bnihv', q_dec, prev)
    return (inner + cross).reshape(b, l, h, dv)


def retention_bidir(q, k, v, lg, s_fwd, s_bwd):
    fwd = retention_chunkwise(q, k, v, lg[0], s_fwd)
    bwd = retention_chunkwise(q[:, ::-1], k[:, ::-1], v[:, ::-1], lg[1], s_bwd)
    return fwd + bwd[:, ::-1]


def retention_out(o, zg, p):
    b, l = o.shape[0], o.shape[1]
    o = o * lax.rsqrt(jnp.mean(o * o, axis=-1, keepdims=True) + EPS)
    o = o.reshape(b, l, GROUP_W) * p['ret_norm_g'].astype(jnp.float32)
    return (o * jax.nn.silu(zg.astype(jnp.float32))).astype(zg.dtype)


def hyena_filter(n, p):
    f32 = jnp.float32
    t = jnp.linspace(0.0, 1.0, n, dtype=f32)[:, None]
    bands = jnp.linspace(1e-4, HY_BANDS - 1, HY_BANDS, dtype=f32)
    w = 2.0 * math.pi * jnp.arange(n, dtype=f32)[:, None] / n
    z = jnp.concatenate([t, jnp.cos(bands * w), -jnp.sin(bands * w)], axis=-1)
    freq = p['hy_freq'].astype(f32)
    hdn = jnp.sin(freq * (z @ p['hy_w1'].astype(f32) + p['hy_b1'].astype(f32)))
    hdn = jnp.sin(freq * (hdn @ p['hy_w2'].astype(f32) + p['hy_b2'].astype(f32)))
    filt = hdn @ p['hy_w3'].astype(f32)
    max_decay = math.log(HY_TARGET) / HY_FAST_PCT
    min_decay = math.log(HY_TARGET) / HY_SLOW_PCT
    deltas = jnp.abs(jnp.linspace(min_decay, max_decay, HY_CH, dtype=f32))
    window = jnp.exp(-t * deltas)
    h_fwd = filt[:, :HY_CH] * window
    h_bwd = filt[:, HY_CH:] * window
    return jnp.concatenate([h_fwd, jnp.zeros((1, HY_CH), f32), h_bwd[1:][::-1]], axis=0)


def hyena_mix(zh, p):
    l = zh.shape[1]
    u = dwconv(zh, p['hy_conv_w'], p['hy_conv_b'], HY_CONV // 2)
    x0, x1, v = jnp.split(u, 3, axis=-1)
    s = (x1 * v).astype(jnp.float32)
    hf = jnp.fft.rfft(hyena_filter(l, p), axis=0)
    y = jnp.fft.irfft(jnp.fft.rfft(s, n=2 * l, axis=1) * hf[None], n=2 * l, axis=1)[:, :l]
    y = y + s * p['hy_d'].astype(jnp.float32)
    return (x0.astype(jnp.float32) * y).astype(zh.dtype)


def rglru_scan(x, wa, ba, wx, bx, lam, h0):
    b, l, _ = x.shape
    xb = x.reshape(b, l, LRU_BLOCKS, LRU_BW)
    r = jax.nn.sigmoid(jnp.einsum('blnd,nde->blne', xb, wa).reshape(b, l, LRU_W) + ba)
    i = jax.nn.sigmoid(jnp.einsum('blnd,nde->blne', xb, wx).reshape(b, l, LRU_W) + bx)
    log_a = -LRU_C * r * jax.nn.softplus(-lam)
    a = jnp.exp(log_a)
    bt = jnp.sqrt(-jnp.expm1(2.0 * log_a)) * (i * x)
    bt = bt.at[:, 0].add(a[:, 0] * h0)

    def combine(lhs, rhs):
        a_l, b_l = lhs
        a_r, b_r = rhs
        return a_l * a_r, a_r * b_l + b_r

    _, h = lax.associative_scan(combine, (a, bt), axis=1)
    return h


def lru_dir_params(p, d):
    f = lambda t: t[d].astype(jnp.float32)
    return f(p['lru_wa']), f(p['lru_ba']), f(p['lru_wx']), f(p['lru_bx']), f(p['lru_lambda'])


def lru_out(h, zg):
    return (h * jax.nn.gelu(zg.astype(jnp.float32))).astype(zg.dtype)


def merge_groups(parts, p):
    y = jnp.concatenate(parts, axis=-1)
    shp = y.shape
    y = rms_norm(y.reshape(shp[:-1] + (N_MIX_GROUPS, GROUP_W)),
                 p['group_norm_g'].reshape(N_MIX_GROUPS, GROUP_W)).reshape(shp)
    return y @ p['w_out']


def parallel_mixer(a_lat, a_ctx, p, rope_cs, ctx_out):
    f32 = jnp.float32
    b = a_lat.shape[0]
    zl = split_cols(a_lat @ p['w_in'])
    zc = split_cols(a_ctx @ p['w_in'])
    cos, sin = rope_cs
    q_l, k_l, v_l = mla_qkv(zl[0], zl[1], zl[2], p)
    q_l, k_l = rope_tail(q_l, cos, sin), rope_tail(k_l, cos, sin)
    q_c, k_c, v_c = mla_qkv(zc[0], zc[1], zc[2], p)
    y_lat = [blocked_attend(q_l, jnp.concatenate([k_l, k_c], axis=1), jnp.concatenate([v_l, v_c], axis=1))]
    lg = p['ret_log_gamma'].astype(f32)
    rq_l, rk_l, rv_l = ret_heads(zl[3], zl[4], zl[5])
    rq_c, rk_c, rv_c = ret_heads(zc[3], zc[4], zc[5])
    s_f = retention_state(rk_c, rv_c, lg[0])
    s_b = retention_state(rk_c[:, ::-1], rv_c[:, ::-1], lg[1])
    y_lat.append(retention_out(retention_bidir(rq_l, rk_l, rv_l, lg, s_f, s_b), zl[6], p))
    y_lat.append(hyena_mix(zl[7], p))
    pf, pb = lru_dir_params(p, 0), lru_dir_params(p, 1)
    xc = dwconv(zc[8], p['lru_conv_w'], p['lru_conv_b'], LRU_CONV // 2).astype(f32)
    xl = dwconv(zl[8], p['lru_conv_w'], p['lru_conv_b'], LRU_CONV // 2).astype(f32)
    h0 = jnp.zeros((b, LRU_W), f32)
    hc_f = rglru_scan(xc, *pf, h0)
    hc_b = rglru_scan(xc[:, ::-1], *pb, h0)
    h_l = rglru_scan(xl, *pf, hc_f[:, -1]) + rglru_scan(xl[:, ::-1], *pb, hc_b[:, -1])[:, ::-1]
    y_lat.append(lru_out(h_l, zl[9]))
    out_lat = merge_groups(y_lat, p)
    if not ctx_out:
        return out_lat, None
    zero = jnp.zeros_like(s_f)
    n_ctx = a_ctx.shape[1]
    y_ctx = [softmax_attend(q_c, k_c, v_c).reshape(b, n_ctx, GROUP_W),
             retention_out(retention_bidir(rq_c, rk_c, rv_c, lg, zero, zero), zc[6], p),
             hyena_mix(zc[7], p),
             lru_out(hc_f + hc_b[:, ::-1], zc[9])]
    return out_lat, merge_groups(y_ctx, p)


def grouped_experts(h, eid, w, p):
    t, d = h.shape
    n_assign = t * TOP_K
    e_flat = eid.reshape(-1)
    w_flat = w.reshape(-1)
    tok = jnp.arange(n_assign, dtype=jnp.int32) // TOP_K
    counts = jnp.zeros((N_EXPERTS,), jnp.int32).at[e_flat].add(1)
    padded = (counts + MOE_BLOCK - 1) // MOE_BLOCK * MOE_BLOCK
    pad_end = jnp.cumsum(padded)
    pad_start = pad_end - padded
    raw_start = jnp.cumsum(counts) - counts
    order = jnp.argsort(e_flat)
    e_sorted = e_flat[order]
    dest = pad_start[e_sorted] + jnp.arange(n_assign, dtype=jnp.int32) - raw_start[e_sorted]
    n_blocks = -(-n_assign // MOE_BLOCK) + N_EXPERTS
    n_slots = n_blocks * MOE_BLOCK
    slot_tok = jnp.full((n_slots,), t, jnp.int32).at[dest].set(tok[order])
    slot_w = jnp.zeros((n_slots,), jnp.float32).at[dest].set(w_flat[order])
    block_exp = jnp.minimum(jnp.searchsorted(pad_end, jnp.arange(n_blocks, dtype=jnp.int32) * MOE_BLOCK,
                                             side='right'), N_EXPERTS - 1)
    h_pad = jnp.concatenate([h, jnp.zeros((1, d), h.dtype)], axis=0)
    xs = h_pad[slot_tok].reshape(n_blocks, MOE_BLOCK, d)

    def expert_block(args):
        xb, e = args
        return (jax.nn.silu(xb @ p['moe_w1'][e]) * (xb @ p['moe_w3'][e])) @ p['moe_w2'][e]

    ys = lax.map(expert_block, (xs, block_exp)).reshape(n_slots, d)
    out = jnp.zeros((t + 1, d), jnp.float32).at[slot_tok].add(ys.astype(jnp.float32) * slot_w[:, None])
    return out[:t].astype(h.dtype)


def hier_moe(h, p):
    t = h.shape[0]
    g_prob = jax.nn.softmax((h @ p['moe_w_group']).astype(jnp.float32), axis=-1)
    g_val, g_idx = lax.top_k(g_prob, 1)
    e_logits = (h @ p['moe_w_expert']).astype(jnp.float32).reshape(t, MOE_GROUPS, MOE_PER_GROUP)
    e_in_group = e_logits[jnp.arange(t), g_idx[:, 0]]
    e_val, e_idx = lax.top_k(e_in_group, TOP_K)
    w = g_val * jax.nn.softmax(e_val, axis=-1)
    eid = g_idx * MOE_PER_GROUP + e_idx
    return grouped_experts(h, eid, w, p)


def trunk_layer(x, ctx, c, c_ctx, p, rope_cs, ctx_out):
    b, s, d = x.shape
    n_ctx = ctx.shape[1]
    mod_l = (jax.nn.silu(c) @ p['w_mod'] + p['b_mod'])[:, None, :]
    mod_c = jax.nn.silu(c_ctx) @ p['w_mod'] + p['b_mod']
    sh1_l, sc1_l, g1_l, sh2_l, sc2_l, g2_l = jnp.split(mod_l, 6, axis=-1)
    sh1_c, sc1_c, g1_c, sh2_c, sc2_c, g2_c = jnp.split(mod_c, 6, axis=-1)
    a_l = modulate(rms_norm(x, p['norm1_g']), sh1_l, sc1_l)
    a_c = modulate(rms_norm(ctx, p['norm1_g']), sh1_c, sc1_c)
    m_l, m_c = parallel_mixer(a_l, a_c, p, rope_cs, ctx_out)
    x = x + g1_l * m_l
    f_l = modulate(rms_norm(x, p['norm2_g']), sh2_l, sc2_l).reshape(b * s, d)
    if ctx_out:
        ctx = ctx + g1_c * m_c
        f_c = modulate(rms_norm(ctx, p['norm2_g']), sh2_c, sc2_c).reshape(b * n_ctx, d)
        ff = hier_moe(jnp.concatenate([f_l, f_c], axis=0), p)
        x = x + g2_l * ff[:b * s].reshape(b, s, d)
        ctx = ctx + g2_c * ff[b * s:].reshape(b, n_ctx, d)
    else:
        x = x + g2_l * hier_moe(f_l, p).reshape(b, s, d)
    return x, ctx


def setup_inputs(seed: int = 0) -> dict:
    key = jax.random.key(seed)
    keys = list(jax.random.split(key, 48))

    def nrm(shape, scale):
        return scale * jax.random.normal(keys.pop(), shape, jnp.float32)

    def gain(shape):
        return 1.0 + 0.05 * jax.random.normal(keys.pop(), shape, jnp.float32)

    L = DEPTH
    x = nrm((BATCH, SEQ, D_MODEL), 1.0)
    c = nrm((BATCH, D_MODEL), 1.0)
    ctx = nrm((BATCH, CTX_LEN, D_MODEL), 1.0)
    c_ctx = nrm((D_MODEL,), 1.0)
    w_mod = nrm((L, D_MODEL, 6 * D_MODEL), 0.3 * D_MODEL ** -0.5)
    b_mod = nrm((L, 6 * D_MODEL), 0.02)
    norm1_g = gain((L, D_MODEL))
    norm2_g = gain((L, D_MODEL))
    w_in = nrm((L, D_MODEL, IN_COLS), D_MODEL ** -0.5)
    mla_q_norm_g = gain((L, MLA_Q_RANK))
    mla_w_uq = nrm((L, MLA_Q_RANK, MLA_HEADS * MLA_QK), MLA_Q_RANK ** -0.5)
    mla_kv_norm_g = gain((L, MLA_KV_RANK))
    mla_w_ukv = nrm((L, MLA_KV_RANK, MLA_HEADS * (MLA_NOPE + MLA_V)), MLA_KV_RANK ** -0.5)
    mla_qn_g = gain((L, MLA_QK))
    mla_kn_g = gain((L, MLA_QK))
    base_lg = jnp.log1p(-jnp.exp2(-5.0 - jnp.arange(RET_HEADS, dtype=jnp.float32)))
    ret_log_gamma = base_lg * gain((L, 2, RET_HEADS))
    ret_norm_g = gain((L, GROUP_W))
    hy_conv_w = nrm((L, HY_CONV, 3 * HY_CH), HY_CONV ** -0.5)
    hy_conv_b = nrm((L, 3 * HY_CH), 0.02)
    hy_w1 = nrm((L, HY_EMB, HY_FFN), HY_EMB ** -0.5)
    hy_b1 = nrm((L, HY_FFN), 0.02)
    hy_w2 = nrm((L, HY_FFN, HY_FFN), HY_FFN ** -0.5)
    hy_b2 = nrm((L, HY_FFN), 0.02)
    hy_w3 = nrm((L, HY_FFN, 2 * HY_CH), 0.1 * HY_FFN ** -0.5)
    hy_freq = gain((L, HY_FFN))
    hy_d = nrm((L, HY_CH), 0.5)
    lru_conv_w = nrm((L, LRU_CONV, LRU_W), LRU_CONV ** -0.5)
    lru_conv_b = nrm((L, LRU_W), 0.02)
    lru_wa = nrm((L, 2, LRU_BLOCKS, LRU_BW, LRU_BW), LRU_BW ** -0.5)
    lru_ba = nrm((L, 2, LRU_W), 0.02)
    lru_wx = nrm((L, 2, LRU_BLOCKS, LRU_BW, LRU_BW), LRU_BW ** -0.5)
    lru_bx = nrm((L, 2, LRU_W), 0.02)
    u = jax.random.uniform(keys.pop(), (L, 2, LRU_W), jnp.float32, 0.9, 0.999)
    a0 = u ** (1.0 / LRU_C)
    lru_lambda = jnp.log(a0) - jnp.log1p(-a0)
    group_norm_g = gain((L, D_MIX))
    w_out = nrm((L, D_MIX, D_MODEL), D_MIX ** -0.5)
    moe_w_group = nrm((L, D_MODEL, MOE_GROUPS), D_MODEL ** -0.5)
    moe_w_expert = nrm((L, D_MODEL, N_EXPERTS), D_MODEL ** -0.5)
    moe_w1 = nrm((L, N_EXPERTS, D_MODEL, EXPERT_FF), D_MODEL ** -0.5)
    moe_w3 = nrm((L, N_EXPERTS, D_MODEL, EXPERT_FF), D_MODEL ** -0.5)
    moe_w2 = nrm((L, N_EXPERTS, EXPERT_FF, D_MODEL), EXPERT_FF ** -0.5)
    return {'x': x, 'c': c, 'ctx': ctx, 'c_ctx': c_ctx, 'w_mod': w_mod, 'b_mod': b_mod,
            'norm1_g': norm1_g, 'norm2_g': norm2_g, 'w_in': w_in,
            'mla_q_norm_g': mla_q_norm_g, 'mla_w_uq': mla_w_uq, 'mla_kv_norm_g': mla_kv_norm_g,
            'mla_w_ukv': mla_w_ukv, 'mla_qn_g': mla_qn_g, 'mla_kn_g': mla_kn_g,
            'ret_log_gamma': ret_log_gamma, 'ret_norm_g': ret_norm_g,
            'hy_conv_w': hy_conv_w, 'hy_conv_b': hy_conv_b, 'hy_w1': hy_w1, 'hy_b1': hy_b1,
            'hy_w2': hy_w2, 'hy_b2': hy_b2, 'hy_w3': hy_w3, 'hy_freq': hy_freq, 'hy_d': hy_d,
            'lru_conv_w': lru_conv_w, 'lru_conv_b': lru_conv_b, 'lru_wa': lru_wa, 'lru_ba': lru_ba,
            'lru_wx': lru_wx, 'lru_bx': lru_bx, 'lru_lambda': lru_lambda,
            'group_norm_g': group_norm_g, 'w_out': w_out,
            'moe_w_group': moe_w_group, 'moe_w_expert': moe_w_expert,
            'moe_w1': moe_w1, 'moe_w3': moe_w3, 'moe_w2': moe_w2}


def reference(x, c, ctx, c_ctx, w_mod, b_mod, norm1_g, norm2_g, w_in,
              mla_q_norm_g, mla_w_uq, mla_kv_norm_g, mla_w_ukv, mla_qn_g, mla_kn_g,
              ret_log_gamma, ret_norm_g,
              hy_conv_w, hy_conv_b, hy_w1, hy_b1, hy_w2, hy_b2, hy_w3, hy_freq, hy_d,
              lru_conv_w, lru_conv_b, lru_wa, lru_ba, lru_wx, lru_bx, lru_lambda,
              group_norm_g, w_out, moe_w_group, moe_w_expert, moe_w1, moe_w3, moe_w2):
    rope_cs = axial_rope_angles(x.shape[1])
    for l in range(DEPTH):
        p = dict(w_mod=w_mod[l], b_mod=b_mod[l], norm1_g=norm1_g[l], norm2_g=norm2_g[l], w_in=w_in[l],
                 mla_q_norm_g=mla_q_norm_g[l], mla_w_uq=mla_w_uq[l], mla_kv_norm_g=mla_kv_norm_g[l],
                 mla_w_ukv=mla_w_ukv[l], mla_qn_g=mla_qn_g[l], mla_kn_g=mla_kn_g[l],
                 ret_log_gamma=ret_log_gamma[l], ret_norm_g=ret_norm_g[l],
                 hy_conv_w=hy_conv_w[l], hy_conv_b=hy_conv_b[l], hy_w1=hy_w1[l], hy_b1=hy_b1[l],
                 hy_w2=hy_w2[l], hy_b2=hy_b2[l], hy_w3=hy_w3[l], hy_freq=hy_freq[l], hy_d=hy_d[l],
                 lru_conv_w=lru_conv_w[l], lru_conv_b=lru_conv_b[l], lru_wa=lru_wa[l], lru_ba=lru_ba[l],
                 lru_wx=lru_wx[l], lru_bx=lru_bx[l], lru_lambda=lru_lambda[l],
                 group_norm_g=group_norm_g[l], w_out=w_out[l],
                 moe_w_group=moe_w_group[l], moe_w_expert=moe_w_expert[l],
                 moe_w1=moe_w1[l], moe_w3=moe_w3[l], moe_w2=moe_w2[l])
        x, ctx = trunk_layer(x, ctx, c, c_ctx, p, rope_cs, l < DEPTH - 1)
    return x
```

```cpp
#include <hip/hip_runtime.h>
#include <cstdio>
#include <cstdint>

#define DI __device__ __forceinline__
typedef unsigned short bf16_t;
typedef short bf16x8 __attribute__((ext_vector_type(8)));
typedef float f32x4 __attribute__((ext_vector_type(4)));
typedef float f32x16 __attribute__((ext_vector_type(16)));
typedef unsigned u32x4 __attribute__((ext_vector_type(4)));
typedef unsigned u32x2 __attribute__((ext_vector_type(2)));

constexpr int D = 1024, NB = 32, SEQ = 2048, CTXL = 256, PALL = SEQ + CTXL;
constexpr int TL = NB * SEQ, TC = NB * CTXL, T = TL + TC;
constexpr int ZW = 2816, INC = 2656;
constexpr int ZC_CQ = 0, ZC_CKV = 192, ZC_KR = 320, ZC_RQ = 352, ZC_RK = 608, ZC_RV = 864, ZC_RG = 1120,
              ZC_HX0 = 1376, ZC_HX1 = 1632, ZC_HV = 1888, ZC_LX = 2144, ZC_LG = 2400;
constexpr float EPS = 1e-6f;
constexpr int NEXP = 32, EFF = 512, CAPE = T;
constexpr int MAXSLOT = 155648;

enum { I_X = 0, I_C, I_CTX, I_CCTX, I_WMOD, I_BMOD, I_N1G, I_N2G, I_WIN, I_QNG, I_WUQ, I_KVNG, I_WUKV, I_QN, I_KN, I_RLG, I_RNG,
       I_HCW, I_HCB, I_HW1, I_HB1, I_HW2, I_HB2, I_HW3, I_HFREQ, I_HD, I_LCW, I_LCB, I_LWA, I_LBA, I_LWX, I_LBX, I_LLAM, I_GNG, I_WOUT,
       I_MWG, I_MWE, I_MW1, I_MW3, I_MW2, N_IN };

constexpr size_t MiB = 1024ull * 1024ull;
constexpr size_t WS_CTL = 0;
constexpr size_t WS_MOD = 1 * MiB;
constexpr size_t WS_G2048 = 3 * MiB;
constexpr size_t WS_G256 = 5 * MiB;
constexpr size_t WS_WUQ_T = 6 * MiB;
constexpr size_t WS_WUKV_T = 6 * MiB + 256 * 1024;
constexpr size_t WS_LRUW_T = 6 * MiB + 512 * 1024;
constexpr size_t WS_WIN_T = 7 * MiB;
constexpr size_t WS_WOUT_T = 13 * MiB;
constexpr size_t WS_W13_T = 15 * MiB;
constexpr size_t WS_W2_T = 79 * MiB;
constexpr size_t WS_ETOK = 111 * MiB;
constexpr size_t WS_EW = 120 * MiB;
constexpr size_t WS_XC = 129 * MiB;
constexpr size_t WS_ACT = 161 * MiB;
constexpr size_t WS_Q = WS_ACT;
constexpr size_t WS_K = WS_Q + 56623104ull;
constexpr size_t WS_VT = WS_K + 56623104ull;
constexpr size_t WS_YA = 305 * MiB;
constexpr size_t WS_OF = 341 * MiB;
constexpr size_t WS_OB = 377 * MiB;
constexpr size_t WS_HF = 413 * MiB;
constexpr size_t WS_HB = 449 * MiB;
constexpr size_t WS_Z = 485 * MiB;
constexpr size_t WS_SL = 881 * MiB;
constexpr size_t WS_SC = 913 * MiB;
constexpr size_t WS_YT = 917 * MiB;
constexpr size_t WS_YTC = 949 * MiB;
constexpr size_t WS_H = WS_Z;
constexpr size_t WS_YTOK = WS_Z + 152 * MiB;
constexpr size_t WS_XT = 953 * MiB;
constexpr size_t WS_END = 989 * MiB;
constexpr int CW_COUNT = 4096;

struct Params { const float* in[N_IN]; float* out; unsigned char* ws; };

DI bf16_t f2bf(float f) { unsigned u = __float_as_uint(f); u += 0x7FFFu + ((u >> 16) & 1u); return (bf16_t)(u >> 16); }
DI float bf2f(bf16_t b) { return __uint_as_float(((unsigned)b) << 16); }
DI float wave_sum(float v) {
#pragma unroll
    for (int o = 32; o > 0; o >>= 1) v += __shfl_xor(v, o);
    return v;
}
DI float hw_sin(float x) { float r = x * 0.15915494309189535f; r -= floorf(r); return __builtin_amdgcn_sinf(r); }
DI float siluf(float v) { return v / (1.f + expf(-v)); }
DI float gelu_tanh(float x) { const float u = 0.7978845608028654f * (x + 0.044715f * x * x * x); return 0.5f * x * (1.f + tanhf(u)); }
DI const float* modrow(const Params& p, int l, int r) { return (const float*)(p.ws + WS_MOD) + ((size_t)l * 33 + r) * 6144; }
DI int tok_batch(int tok) { return tok < TL ? tok / SEQ : (tok - TL) / CTXL; }

__global__ void __launch_bounds__(512) k_mod(Params p) {
    extern __shared__ float sm[];
    float* MOD = (float*)(p.ws + WS_MOD);
    const int tid = threadIdx.x;
    for (int i = tid; i < 33 * 1024; i += 512) { const int r = i >> 10, k = i & 1023; const float v = r < 32 ? p.in[I_C][r * 1024 + k] : p.in[I_CCTX][k]; sm[i] = siluf(v); }
    __syncthreads();
    const int col = tid % 48, ks = tid / 48;
    const int gcol = blockIdx.x * 48 + col, l = gcol / 6144, n = gcol % 6144;
    float acc[33];
#pragma unroll
    for (int r = 0; r < 33; ++r) acc[r] = 0.f;
    if (ks < 8) {
        const float* w = p.in[I_WMOD] + (size_t)l * 1024 * 6144 + n;
        for (int k = ks * 128; k < ks * 128 + 128; ++k) {
            const float wv = w[(size_t)k * 6144];
#pragma unroll
            for (int r = 0; r < 33; ++r) acc[r] += sm[r * 1024 + k] * wv;
        }
    }
    __syncthreads();
    if (ks < 8) {
#pragma unroll
        for (int r = 0; r < 33; ++r) sm[(ks * 33 + r) * 48 + col] = acc[r];
    }
    __syncthreads();
    for (int i = tid; i < 33 * 48; i += 512) {
        const int r = i / 48, c = i % 48; float s = 0.f;
        for (int k2 = 0; k2 < 8; ++k2) s += sm[(k2 * 33 + r) * 48 + c];
        const int g = blockIdx.x * 48 + c, l2 = g / 6144, n2 = g % 6144;
        MOD[((size_t)l2 * 33 + r) * 6144 + n2] = s + p.in[I_BMOD][l2 * 6144 + n2];
    }
}

DI void tconv_tile(const float* src, int lds_, int K, int N, bf16_t* dst, int ldd, int k0, int n0, int drow0, float* tile, int tid) {
    __syncthreads();
#pragma unroll
    for (int i = 0; i < 8; ++i) { const int idx = tid + 512 * i, kk = idx >> 6, nn = idx & 63; float v = 0.f; if (k0 + kk < K && n0 + nn < N) v = src[(size_t)(k0 + kk) * lds_ + n0 + nn]; tile[kk * 65 + nn] = v; }
    __syncthreads();
#pragma unroll
    for (int i = 0; i < 8; ++i) { const int idx = tid + 512 * i, nn = idx >> 6, kk = idx & 63; if (k0 + kk < K && n0 + nn < N) dst[(size_t)(drow0 + nn) * ldd + k0 + kk] = f2bf(tile[kk * 65 + nn]); }
}
__global__ void __launch_bounds__(512) k_convert(Params p, int l) {
    __shared__ float tile[64 * 65];
    const int tid = threadIdx.x;
    bf16_t* WIN_T = (bf16_t*)(p.ws + WS_WIN_T); bf16_t* WOUT_T = (bf16_t*)(p.ws + WS_WOUT_T); bf16_t* W13_T = (bf16_t*)(p.ws + WS_W13_T); bf16_t* W2_T = (bf16_t*)(p.ws + WS_W2_T);
    bf16_t* WUQ_T = (bf16_t*)(p.ws + WS_WUQ_T); bf16_t* WUKV_T = (bf16_t*)(p.ws + WS_WUKV_T); bf16_t* LRUW_T = (bf16_t*)(p.ws + WS_LRUW_T);
    constexpr int N0 = 16 * 42, N1 = N0 + 256, N2 = N1 + 32 * 2 * 128, N3 = N2 + 32 * 128, N4 = N3 + 18, N5 = N4 + 16, N6 = N5 + 16;
    for (int t = blockIdx.x; t < N6; t += gridDim.x) {
        if (t < N0) { const int kt = t / 42, nt = t % 42; tconv_tile(p.in[I_WIN] + (size_t)l * 1024 * INC, INC, 1024, INC, WIN_T, 1024, kt * 64, nt * 64, nt * 64, tile, tid); }
        else if (t < N1) { const int u = t - N0, kt = u / 16, nt = u % 16; tconv_tile(p.in[I_WOUT] + (size_t)l * 1024 * 1024, 1024, 1024, 1024, WOUT_T, 1024, kt * 64, nt * 64, nt * 64, tile, tid); }
        else if (t < N2) { const int u = t - N1, e = u / 256, r = u % 256, bj = r / 128, q = r % 128, kt = q / 8, nt = q % 8; const int n0 = nt * 64;
            const float* src = p.in[bj ? I_MW3 : I_MW1] + ((size_t)l * NEXP + e) * 1024 * 512;
            tconv_tile(src, 512, 1024, 512, W13_T + (size_t)e * 1024 * 1024, 1024, kt * 64, n0, 256 * (n0 / 128) + 128 * bj + (n0 % 128), tile, tid); }
        else if (t < N3) { const int u = t - N2, e = u / 128, q = u % 128, kt = q / 16, nt = q % 16;
            tconv_tile(p.in[I_MW2] + ((size_t)l * NEXP + e) * 512 * 1024, 1024, 512, 1024, W2_T + (size_t)e * 1024 * 512, 512, kt * 64, nt * 64, nt * 64, tile, tid); }
        else if (t < N4) { const int u = t - N3, kt = u / 6, nt = u % 6; tconv_tile(p.in[I_WUQ] + (size_t)l * 192 * 384, 384, 192, 384, WUQ_T, 192, kt * 64, nt * 64, nt * 64, tile, tid); }
        else if (t < N5) { const int u = t - N4, kt = u / 8, nt = u % 8; tconv_tile(p.in[I_WUKV] + (size_t)l * 128 * 512, 512, 128, 512, WUKV_T, 128, kt * 64, nt * 64, nt * 64, tile, tid); }
        else { const int u = t - N5, dir = u / 8, gate = (u / 4) & 1, n = u % 4;
            const float* src = p.in[gate ? I_LWX : I_LWA] + (((size_t)l * 2 + dir) * 4 + n) * 4096;
            tconv_tile(src, 64, 64, 64, LRUW_T + (size_t)((dir * 2 + gate) * 4 + n) * 4096, 64, 0, 0, 0, tile, tid); }
    }
    for (size_t i = (size_t)blockIdx.x * 512 + tid; i < (size_t)(ZW - INC) * 1024; i += (size_t)gridDim.x * 512) WIN_T[(size_t)INC * 1024 + i] = 0;
}

__global__ void __launch_bounds__(512) k_filter(Params p, int l) {
    __shared__ float z[33], h1[64], h2[64];
    const int tid = threadIdx.x;
    bf16_t* G2048 = (bf16_t*)(p.ws + WS_G2048); bf16_t* G256 = (bf16_t*)(p.ws + WS_G256);
    const float* w1 = p.in[I_HW1] + (size_t)l * 33 * 64; const float* b1 = p.in[I_HB1] + l * 64; const float* w2 = p.in[I_HW2] + (size_t)l * 64 * 64; const float* b2 = p.in[I_HB2] + l * 64;
    const float* w3 = p.in[I_HW3] + (size_t)l * 64 * 512; const float* fr = p.in[I_HFREQ] + l * 64; const float* hd = p.in[I_HD] + l * 256;
    for (int pi = blockIdx.x; pi < 2048 + 256; pi += gridDim.x) {
        const int n = pi < 2048 ? 2048 : 256, i = pi < 2048 ? pi : pi - 2048;
        bf16_t* G = pi < 2048 ? G2048 : G256;
        const float tt = (float)i / (float)(n - 1);
        __syncthreads();
        if (tid < 33) {
            float v;
            if (tid == 0) v = tt;
            else { const int j = (tid - 1) & 15; const float band = 1e-4f + (15.f - 1e-4f) * (float)j / 15.f; float rev = band * ((float)i / (float)n); rev -= floorf(rev);
                v = tid <= 16 ? __builtin_amdgcn_cosf(rev) : -__builtin_amdgcn_sinf(rev); }
            z[tid] = v;
        }
        __syncthreads();
        if (tid < 64) { float s = b1[tid];
#pragma unroll 4
            for (int m = 0; m < 33; ++m) s += z[m] * w1[m * 64 + tid]; h1[tid] = hw_sin(fr[tid] * s); }
        __syncthreads();
        if (tid < 64) { float s = b2[tid];
#pragma unroll 4
            for (int m = 0; m < 64; ++m) s += h1[m] * w2[m * 64 + tid]; h2[tid] = hw_sin(fr[tid] * s); }
        __syncthreads();
        {
            const int j = tid; float s = 0.f;
#pragma unroll 4
            for (int m = 0; m < 64; ++m) s += h2[m] * w3[m * 512 + j];
            const int c = j & 255; const float mind = logf(1e-2f) / 1.5f, maxd = logf(1e-2f) / 0.3f; const float delta = fabsf(mind + (maxd - mind) * (float)c / 255.f);
            float hv = s * expf(-tt * delta);
            if (j < 256) { if (i == 0) hv += hd[c]; G[(size_t)c * 2 * n + (n - i)] = f2bf(hv); if (i == 0) G[(size_t)c * 2 * n] = 0; }
            else if (i >= 1) G[(size_t)c * 2 * n + (n + i)] = f2bf(hv);
        }
    }
}

DI void norm_mod_row(const float* xr, const float* g, const float* sh, const float* sc, bf16_t* dst, int lane, float (&xv)[16]) {
    float ss = 0.f;
#pragma unroll
    for (int j = 0; j < 4; ++j) { const f32x4 v = *(const f32x4*)(xr + j * 256 + lane * 4); xv[j * 4 + 0] = v[0]; xv[j * 4 + 1] = v[1]; xv[j * 4 + 2] = v[2]; xv[j * 4 + 3] = v[3]; ss += v[0] * v[0] + v[1] * v[1] + v[2] * v[2] + v[3] * v[3]; }
    ss = wave_sum(ss);
    const float rstd = rsqrtf(ss * (1.f / 1024.f) + EPS);
#pragma unroll
    for (int j = 0; j < 4; ++j) {
        const int k = j * 256 + lane * 4; bf16_t o[4];
#pragma unroll
        for (int q = 0; q < 4; ++q) { const float y = xv[j * 4 + q] * rstd * g[k + q]; xv[j * 4 + q] = y * (1.f + sc[k + q]) + sh[k + q]; o[q] = f2bf(xv[j * 4 + q]); }
        u32x2 w; w.x = (unsigned)o[0] | ((unsigned)o[1] << 16); w.y = (unsigned)o[2] | ((unsigned)o[3] << 16);
        *(u32x2*)(dst + k) = w;
    }
}
__global__ void __launch_bounds__(256) k_norm1(Params p, int l) {
    const int lane = threadIdx.x & 63; const int w = blockIdx.x * 4 + (threadIdx.x >> 6);
    bf16_t* ACT = (bf16_t*)(p.ws + WS_ACT);
    for (int tok = w; tok < T; tok += gridDim.x * 4) {
        const float* xr = tok < TL ? p.in[I_X] + (size_t)tok * D : p.in[I_CTX] + (size_t)(tok - TL) * D;
        const float* m = modrow(p, l, tok < TL ? tok / SEQ : 32);
        float xv[16];
        norm_mod_row(xr, p.in[I_N1G] + l * D, m, m + 1024, ACT + (size_t)tok * D, lane, xv);
    }
}

DI f32x16 wave_gemm32(const bf16_t* arow, const bf16_t* brow, int K, int lane) {
    f32x16 acc; for (int i = 0; i < 16; ++i) acc[i] = 0.f;
    const int h = lane >> 5;
    for (int k0 = 0; k0 < K; k0 += 16) {
        const bf16x8 a = *(const bf16x8*)(arow + k0 + 8 * h), b = *(const bf16x8*)(brow + k0 + 8 * h);
        acc = __builtin_amdgcn_mfma_f32_32x32x16_bf16(a, b, acc, 0, 0, 0);
    }
    return acc;
}
__global__ void __launch_bounds__(256) k_inproj(Params p) {
    const int lane = threadIdx.x & 63, h = lane >> 5; const long w = (long)blockIdx.x * 4 + (threadIdx.x >> 6);
    const int ntn = ZW / 32; const int tm = (int)(w / ntn), tn = (int)(w % ntn); if (tm >= T / 32) return;
    const bf16_t* A = (const bf16_t*)(p.ws + WS_ACT); const bf16_t* Bt = (const bf16_t*)(p.ws + WS_WIN_T); bf16_t* Z = (bf16_t*)(p.ws + WS_Z);
    const f32x16 acc = wave_gemm32(A + (size_t)(tm * 32 + (lane & 31)) * D, Bt + (size_t)(tn * 32 + (lane & 31)) * D, D, lane);
#pragma unroll
    for (int r = 0; r < 16; ++r) { const int m = tm * 32 + 8 * (r >> 2) + 4 * h + (r & 3), n = tn * 32 + (lane & 31); Z[(size_t)m * ZW + n] = f2bf(acc[r]); }
}
__global__ void __launch_bounds__(256) k_outproj(Params p, int l) {
    const int lane = threadIdx.x & 63, h = lane >> 5; const long w = (long)blockIdx.x * 4 + (threadIdx.x >> 6);
    const int M = l == 0 ? T : TL; const int ntn = D / 32; const int tm = (int)(w / ntn), tn = (int)(w % ntn); if (tm >= M / 32) return;
    const bf16_t* A = (const bf16_t*)(p.ws + WS_ACT); const bf16_t* Bt = (const bf16_t*)(p.ws + WS_WOUT_T);
    const f32x16 acc = wave_gemm32(A + (size_t)(tm * 32 + (lane & 31)) * D, Bt + (size_t)(tn * 32 + (lane & 31)) * D, D, lane);
    float* XC = (float*)(p.ws + WS_XC);
#pragma unroll
    for (int r = 0; r < 16; ++r) {
        const int m = tm * 32 + 8 * (r >> 2) + 4 * h + (r & 3), n = tn * 32 + (lane & 31);
        if (m < TL) { const float* xin = l == 0 ? p.in[I_X] : p.out; const float g1 = modrow(p, l, m / SEQ)[2048 + n]; p.out[(size_t)m * D + n] = xin[(size_t)m * D + n] + g1 * acc[r]; }
        else { const int mc = m - TL; const float g1 = modrow(p, l, 32)[2048 + n]; XC[(size_t)mc * D + n] = p.in[I_CTX][(size_t)mc * D + n] + g1 * acc[r]; }
    }
}

__global__ void __launch_bounds__(64) k_mprep(Params p, int l) {
    __shared__ float xin[352], qf[384], kvf[512];
    const int lane = threadIdx.x;
    const bf16_t* Z = (const bf16_t*)(p.ws + WS_Z); const bf16_t* WUQ_T = (const bf16_t*)(p.ws + WS_WUQ_T); const bf16_t* WUKV_T = (const bf16_t*)(p.ws + WS_WUKV_T);
    bf16_t* Q = (bf16_t*)(p.ws + WS_Q); bf16_t* Kb = (bf16_t*)(p.ws + WS_K); bf16_t* VT = (bf16_t*)(p.ws + WS_VT);
    const float* gq = p.in[I_QNG] + l * 192; const float* gkv = p.in[I_KVNG] + l * 128; const float* qng = p.in[I_QN] + l * 96; const float* kng = p.in[I_KN] + l * 96;
    for (int tok = blockIdx.x; tok < T; tok += gridDim.x) {
        const bf16_t* row = Z + (size_t)tok * ZW;
        __syncthreads();
        for (int i = lane; i < 352; i += 64) xin[i] = bf2f(row[i]);
        __syncthreads();
        float sq = 0.f, skv = 0.f;
        for (int i = lane; i < 192; i += 64) sq += xin[i] * xin[i];
        for (int i = lane; i < 128; i += 64) skv += xin[192 + i] * xin[192 + i];
        sq = wave_sum(sq); skv = wave_sum(skv);
        const float rq = rsqrtf(sq / 192.f + EPS), rkv = rsqrtf(skv / 128.f + EPS);
        __syncthreads();
        for (int i = lane; i < 192; i += 64) xin[i] = xin[i] * rq * gq[i];
        for (int i = lane; i < 128; i += 64) xin[192 + i] = xin[192 + i] * rkv * gkv[i];
        __syncthreads();
        for (int n = lane; n < 384; n += 64) { float s = 0.f; const bf16_t* wr = WUQ_T + (size_t)n * 192; for (int k = 0; k < 192; ++k) s += xin[k] * bf2f(wr[k]); qf[n] = s; }
        for (int n = lane; n < 512; n += 64) { float s = 0.f; const bf16_t* wr = WUKV_T + (size_t)n * 128; for (int k = 0; k < 128; ++k) s += xin[192 + k] * bf2f(wr[k]); kvf[n] = s; }
        __syncthreads();
        const bool lat = tok < TL; const int b = tok_batch(tok); const int pos = lat ? tok % SEQ : SEQ + (tok - TL) % CTXL;
        if (lane < 8) {
            const int hh = lane & 3; const bool isq = lane < 4;
            float v[96];
#pragma unroll
            for (int d = 0; d < 96; ++d) v[d] = isq ? qf[hh * 96 + d] : (d < 64 ? kvf[hh * 128 + d] : xin[320 + d - 64]);
            float ss = 0.f;
#pragma unroll
            for (int d = 0; d < 96; ++d) ss += v[d] * v[d];
            const float rs = rsqrtf(ss / 96.f + EPS); const float* g = isq ? qng : kng;
#pragma unroll
            for (int d = 0; d < 96; ++d) v[d] = v[d] * rs * g[d];
            if (lat) {
                const int t = tok % SEQ; const float posa[2] = {(float)(t / 64), (float)(t % 64)};
#pragma unroll
                for (int a = 0; a < 2; ++a)
#pragma unroll
                    for (int i = 0; i < 8; ++i) {
                        const float invf = powf(10000.f, -(float)i / 8.f); const float ang = posa[a] * invf; const float cs = cosf(ang), sn = sinf(ang);
                        const int d0 = 64 + a * 16 + i, d1 = d0 + 8; const float x1 = v[d0], x2 = v[d1]; v[d0] = x1 * cs - x2 * sn; v[d1] = x2 * cs + x1 * sn;
                    }
            }
            const float qscale = isq ? 0.10206207261596575f * 1.4426950408889634f : 1.f;
            bf16_t* dst = (isq ? Q : Kb) + (((size_t)b * 4 + hh) * PALL + pos) * 96;
#pragma unroll
            for (int d = 0; d < 96; ++d) dst[d] = f2bf(v[d] * qscale);
        }
        for (int i = lane; i < 256; i += 64) { const int hh = i >> 6, d = i & 63; VT[(((size_t)b * 4 + hh) * 64 + d) * PALL + pos] = f2bf(kvf[hh * 128 + 64 + d]); }
    }
}

__global__ void __launch_bounds__(64) k_attn(Params p, int l) {
    const int nq = l == 0 ? PALL : SEQ;
    const int gid = blockIdx.x * 64 + threadIdx.x; const int qi = gid % nq, bh = gid / nq; if (bh >= NB * 4) return;
    const int b = bh >> 2, hh = bh & 3;
    const bf16_t* Q = (const bf16_t*)(p.ws + WS_Q) + ((size_t)bh * PALL + qi) * 96; const bf16_t* Kb = (const bf16_t*)(p.ws + WS_K) + (size_t)bh * PALL * 96; const bf16_t* VT = (const bf16_t*)(p.ws + WS_VT) + (size_t)bh * 64 * PALL;
    float q[96], o[64];
#pragma unroll
    for (int d = 0; d < 96; ++d) q[d] = bf2f(Q[d]);
#pragma unroll
    for (int d = 0; d < 64; ++d) o[d] = 0.f;
    float m = -1e30f, lsum = 0.f;
    const int k0 = qi < SEQ ? 0 : SEQ, k1 = PALL;
    for (int key = k0; key < k1; ++key) {
        const bf16_t* kr = Kb + (size_t)key * 96; float s = 0.f;
#pragma unroll
        for (int d = 0; d < 96; ++d) s += q[d] * bf2f(kr[d]);
        const float mn = fmaxf(m, s), alpha = exp2f(m - mn), pw = exp2f(s - mn);
        lsum = lsum * alpha + pw; m = mn;
#pragma unroll
        for (int d = 0; d < 64; ++d) o[d] = o[d] * alpha + pw * bf2f(VT[(size_t)d * PALL + key]);
    }
    const int tok = qi < SEQ ? b * SEQ + qi : TL + b * CTXL + (qi - SEQ);
    bf16_t* YA = (bf16_t*)(p.ws + WS_YA) + (size_t)tok * 256 + hh * 64; const float inv = 1.f / lsum;
#pragma unroll
    for (int d = 0; d < 64; ++d) YA[d] = f2bf(o[d] * inv);
}

__global__ void __launch_bounds__(64) k_ret(Params p, int l) {
    const int nq = l == 0 ? PALL : SEQ;
    const int gid = blockIdx.x * 64 + threadIdx.x; const int qi = gid % nq, bh = gid / nq; if (bh >= NB * 4) return;
    const int b = bh >> 2, hh = bh & 3;
    const bf16_t* Z = (const bf16_t*)(p.ws + WS_Z);
    const float lgf = p.in[I_RLG][(l * 2 + 0) * 4 + hh], lgb = p.in[I_RLG][(l * 2 + 1) * 4 + hh];
    const int tok = qi < SEQ ? b * SEQ + qi : TL + b * CTXL + (qi - SEQ);
    float q[64], of[64], ob[64];
#pragma unroll
    for (int d = 0; d < 64; ++d) { q[d] = bf2f(Z[(size_t)tok * ZW + ZC_RQ + hh * 64 + d]); of[d] = 0.f; ob[d] = 0.f; }
    const int k0 = qi < SEQ ? 0 : SEQ;
    for (int key = k0; key < PALL; ++key) {
        float wf, wb;
        if (qi < SEQ) {
            if (key < SEQ) { wf = key <= qi ? expf(lgf * (float)(qi - key)) : 0.f; wb = key >= qi ? expf(lgb * (float)(key - qi)) : 0.f; }
            else { const int c = key - SEQ; wf = expf(lgf * (float)(256 + qi - c)); wb = expf(lgb * (float)(2048 - qi + c)); }
        } else { const int c = qi - SEQ, c2 = key - SEQ; wf = c2 <= c ? expf(lgf * (float)(c - c2)) : 0.f; wb = c2 >= c ? expf(lgb * (float)(c2 - c)) : 0.f; }
        const int kt = key < SEQ ? b * SEQ + key : TL + b * CTXL + (key - SEQ);
        const bf16_t* kr = Z + (size_t)kt * ZW + ZC_RK + hh * 64; const bf16_t* vr = Z + (size_t)kt * ZW + ZC_RV + hh * 64;
        float s = 0.f;
#pragma unroll
        for (int d = 0; d < 64; ++d) s += q[d] * bf2f(kr[d]);
        s *= 0.125f; const float sf = s * wf, sb = s * wb;
#pragma unroll
        for (int d = 0; d < 64; ++d) { const float v = bf2f(vr[d]); of[d] += sf * v; ob[d] += sb * v; }
    }
    bf16_t* OF = (bf16_t*)(p.ws + WS_OF) + (size_t)tok * 256 + hh * 64; bf16_t* OB = (bf16_t*)(p.ws + WS_OB) + (size_t)tok * 256 + hh * 64;
#pragma unroll
    for (int d = 0; d < 64; ++d) { OF[d] = f2bf(of[d]); OB[d] = f2bf(ob[d]); }
}

DI float conv3_at(const bf16_t* Z, int tokbase, int t, int L, int zcol, const float* cw, const float* cb, int ch768) {
    float s = cb[ch768];
#pragma unroll
    for (int j = 0; j < 3; ++j) { const int tt = t - 1 + j; if (tt >= 0 && tt < L) s += cw[j * 768 + ch768] * bf2f(Z[(size_t)(tokbase + tt) * ZW + zcol]); }
    return s;
}
__global__ void __launch_bounds__(256) k_hyprep(Params p, int l) {
    const bf16_t* Z = (const bf16_t*)(p.ws + WS_Z); const float* cw = p.in[I_HCW] + (size_t)l * 3 * 768; const float* cb = p.in[I_HCB] + l * 768;
    const size_t nl = (size_t)256 * NB * SEQ, nc = l == 0 ? (size_t)256 * NB * CTXL : 0;
    for (size_t i = (size_t)blockIdx.x * 256 + threadIdx.x; i < nl + nc; i += (size_t)gridDim.x * 256) {
        const bool lat = i < nl; const size_t j = lat ? i : i - nl; const int L = lat ? SEQ : CTXL;
        const int t = (int)(j % L), b = (int)((j / L) % NB), c = (int)(j / ((size_t)L * NB));
        const int tokbase = lat ? b * SEQ : TL + b * CTXL;
        const float x1 = conv3_at(Z, tokbase, t, L, ZC_HX1 + c, cw, cb, 256 + c), v = conv3_at(Z, tokbase, t, L, ZC_HV + c, cw, cb, 512 + c);
        bf16_t* dst = (bf16_t*)(p.ws + (lat ? WS_SL : WS_SC)); dst[j] = f2bf(x1 * v);
    }
}
__global__ void __launch_bounds__(256) k_hyena(Params p, int l) {
    const size_t nl = (size_t)256 * NB * SEQ, nc = l == 0 ? (size_t)256 * NB * CTXL : 0;
    for (size_t i = (size_t)blockIdx.x * 256 + threadIdx.x; i < nl + nc; i += (size_t)gridDim.x * 256) {
        const bool lat = i < nl; const size_t j = lat ? i : i - nl; const int L = lat ? SEQ : CTXL;
        const int t = (int)(j % L), cb_ = (int)(j / L);
        const int c = cb_ / NB;
        const bf16_t* S = (const bf16_t*)(p.ws + (lat ? WS_SL : WS_SC)) + (size_t)cb_ * L;
        const bf16_t* G = (const bf16_t*)(p.ws + (lat ? WS_G2048 : WS_G256)) + (size_t)c * 2 * L;
        float acc = 0.f;
        for (int s = 0; s < L; ++s) acc += bf2f(G[s - t + L]) * bf2f(S[s]);
        bf16_t* dst = (bf16_t*)(p.ws + (lat ? WS_YT : WS_YTC)); dst[j] = f2bf(acc);
    }
}

__global__ void __launch_bounds__(256) k_lruprep(Params p, int l) {
    const bf16_t* Z = (const bf16_t*)(p.ws + WS_Z); bf16_t* XT = (bf16_t*)(p.ws + WS_XT);
    const float* cw = p.in[I_LCW] + (size_t)l * 4 * 256; const float* cb = p.in[I_LCB] + l * 256;
    for (size_t i = (size_t)blockIdx.x * 256 + threadIdx.x; i < (size_t)T * 256; i += (size_t)gridDim.x * 256) {
        const int ch = (int)(i & 255), tok = (int)(i >> 8); const bool lat = tok < TL; const int L = lat ? SEQ : CTXL; const int t = lat ? tok % SEQ : (tok - TL) % CTXL; const int base = tok - t;
        float s = cb[ch];
#pragma unroll
        for (int j = 0; j < 4; ++j) { const int tt = t - 2 + j; if (tt >= 0 && tt < L) s += cw[j * 256 + ch] * bf2f(Z[(size_t)(base + tt) * ZW + ZC_LX + ch]); }
        XT[i] = f2bf(s);
    }
}
__global__ void __launch_bounds__(64) k_lru(Params p, int l) {
    const int u = blockIdx.x; const int b = u >> 3, blk = (u >> 1) & 3, dir = u & 1; const int e = threadIdx.x, ch = blk * 64 + e;
    const bf16_t* XT = (const bf16_t*)(p.ws + WS_XT);
    const float* wa = p.in[I_LWA] + (((size_t)l * 2 + dir) * 4 + blk) * 4096; const float* wx = p.in[I_LWX] + (((size_t)l * 2 + dir) * 4 + blk) * 4096;
    const float ba = p.in[I_LBA][(l * 2 + dir) * 256 + ch], bx = p.in[I_LBX][(l * 2 + dir) * 256 + ch], lam = p.in[I_LLAM][(l * 2 + dir) * 256 + ch];
    const float sp = log1pf(expf(-lam));
    bf16_t* HO = (bf16_t*)(p.ws + (dir ? WS_HB : WS_HF));
    float h = 0.f;
    for (int step = 0; step < PALL; ++step) {
        int tok;
        if (step < CTXL) { const int c = dir ? CTXL - 1 - step : step; tok = TL + b * CTXL + c; }
        else { const int s2 = step - CTXL; const int t = dir ? SEQ - 1 - s2 : s2; tok = b * SEQ + t; }
        const bf16_t* xr = XT + (size_t)tok * 256 + blk * 64;
        float ra = ba, ri = bx, xe = 0.f;
        for (int d = 0; d < 64; ++d) { const float xd = bf2f(xr[d]); ra += xd * wa[d * 64 + e]; ri += xd * wx[d * 64 + e]; if (d == e) xe = xd; }
        const float r = 1.f / (1.f + expf(-ra)), ig = 1.f / (1.f + expf(-ri));
        const float log_a = -8.f * r * sp, a = expf(log_a), mult = sqrtf(-expm1f(2.f * log_a));
        h = a * h + mult * (ig * xe);
        HO[(size_t)tok * 256 + ch] = f2bf(h);
    }
}

__global__ void __launch_bounds__(64) k_merge(Params p, int l) {
    const int lane = threadIdx.x; const int M = l == 0 ? T : TL;
    const bf16_t* Z = (const bf16_t*)(p.ws + WS_Z); bf16_t* ACT = (bf16_t*)(p.ws + WS_ACT);
    const bf16_t* YA = (const bf16_t*)(p.ws + WS_YA); const bf16_t* OF = (const bf16_t*)(p.ws + WS_OF); const bf16_t* OB = (const bf16_t*)(p.ws + WS_OB);
    const bf16_t* HF = (const bf16_t*)(p.ws + WS_HF); const bf16_t* HB = (const bf16_t*)(p.ws + WS_HB);
    const float* gng = p.in[I_GNG] + l * 1024; const float* rng = p.in[I_RNG] + l * 256; const float* cw = p.in[I_HCW] + (size_t)l * 3 * 768; const float* cb = p.in[I_HCB] + l * 768;
    for (int tok = blockIdx.x; tok < M; tok += gridDim.x) {
        const bool lat = tok < TL; const int L = lat ? SEQ : CTXL; const int b = tok_batch(tok); const int t = lat ? tok % SEQ : (tok - TL) % CTXL; const int base = tok - t;
        const bf16_t* zr = Z + (size_t)tok * ZW;
        float v[4][4];
        for (int j = 0; j < 4; ++j) v[0][j] = bf2f(YA[(size_t)tok * 256 + lane + 64 * j]);
        for (int j = 0; j < 4; ++j) {
            const int ch = lane + 64 * j; const float o = bf2f(OF[(size_t)tok * 256 + ch]) + bf2f(OB[(size_t)tok * 256 + ch]);
            const float ss = wave_sum(o * o); const float rs = rsqrtf(ss / 64.f + EPS);
            v[1][j] = o * rs * rng[ch] * siluf(bf2f(zr[ZC_RG + ch]));
        }
        for (int j = 0; j < 4; ++j) {
            const int ch = lane + 64 * j; const float x0 = conv3_at(Z, base, t, L, ZC_HX0 + ch, cw, cb, ch);
            const bf16_t* YT = (const bf16_t*)(p.ws + (lat ? WS_YT : WS_YTC)); const float y = bf2f(YT[((size_t)ch * NB + b) * L + t]);
            v[2][j] = x0 * y;
        }
        for (int j = 0; j < 4; ++j) { const int ch = lane + 64 * j; const float hsum = bf2f(HF[(size_t)tok * 256 + ch]) + bf2f(HB[(size_t)tok * 256 + ch]); v[3][j] = hsum * gelu_tanh(bf2f(zr[ZC_LG + ch])); }
        for (int g = 0; g < 4; ++g) {
            float ss = 0.f; for (int j = 0; j < 4; ++j) ss += v[g][j] * v[g][j];
            ss = wave_sum(ss); const float rs = rsqrtf(ss / 256.f + EPS);
            for (int j = 0; j < 4; ++j) { const int ch = lane + 64 * j; ACT[(size_t)tok * D + g * 256 + ch] = f2bf(v[g][j] * rs * gng[g * 256 + ch]); }
        }
    }
}

__global__ void __launch_bounds__(256) k_norm2(Params p, int l) {
    const int lane = threadIdx.x & 63; const int w = blockIdx.x * 4 + (threadIdx.x >> 6); const int M = l == 0 ? T : TL;
    bf16_t* ACT = (bf16_t*)(p.ws + WS_ACT); const float* XC = (const float*)(p.ws + WS_XC);
    const float* wg = p.in[I_MWG] + (size_t)l * 1024 * 4; const float* we = p.in[I_MWE] + (size_t)l * 1024 * 32;
    unsigned* cnt = (unsigned*)(p.ws + WS_CTL) + CW_COUNT + l * 32; int* ETOK = (int*)(p.ws + WS_ETOK); float* EW = (float*)(p.ws + WS_EW);
    for (int tok = w; tok < M; tok += gridDim.x * 4) {
        const float* xr = tok < TL ? p.out + (size_t)tok * D : XC + (size_t)(tok - TL) * D;
        const float* m = modrow(p, l, tok < TL ? tok / SEQ : 32);
        float f[16];
        norm_mod_row(xr, p.in[I_N2G] + l * D, m + 3072, m + 4096, ACT + (size_t)tok * D, lane, f);
        float lg[4];
#pragma unroll
        for (int j = 0; j < 4; ++j) lg[j] = 0.f;
#pragma unroll
        for (int jj = 0; jj < 4; ++jj)
#pragma unroll
            for (int q = 0; q < 4; ++q) { const int k = jj * 256 + lane * 4 + q; const f32x4 wv = *(const f32x4*)(wg + (size_t)k * 4); const float fv = f[jj * 4 + q]; lg[0] += fv * wv[0]; lg[1] += fv * wv[1]; lg[2] += fv * wv[2]; lg[3] += fv * wv[3]; }
#pragma unroll
        for (int j = 0; j < 4; ++j) lg[j] = wave_sum(lg[j]);
        int gi = 0; float gm = lg[0];
#pragma unroll
        for (int j = 1; j < 4; ++j) if (lg[j] > gm) { gm = lg[j]; gi = j; }
        float den = 0.f;
#pragma unroll
        for (int j = 0; j < 4; ++j) den += expf(lg[j] - gm);
        const float gval = 1.f / den;
        float el[8];
#pragma unroll
        for (int j = 0; j < 8; ++j) el[j] = 0.f;
#pragma unroll
        for (int jj = 0; jj < 4; ++jj)
#pragma unroll
            for (int q = 0; q < 4; ++q) { const int k = jj * 256 + lane * 4 + q; const float* wr = we + (size_t)k * 32 + gi * 8; const f32x4 w0 = *(const f32x4*)wr, w1 = *(const f32x4*)(wr + 4); const float fv = f[jj * 4 + q];
                el[0] += fv * w0[0]; el[1] += fv * w0[1]; el[2] += fv * w0[2]; el[3] += fv * w0[3]; el[4] += fv * w1[0]; el[5] += fv * w1[1]; el[6] += fv * w1[2]; el[7] += fv * w1[3]; }
#pragma unroll
        for (int j = 0; j < 8; ++j) el[j] = wave_sum(el[j]);
        int i1 = 0; float m1 = el[0];
#pragma unroll
        for (int j = 1; j < 8; ++j) if (el[j] > m1) { m1 = el[j]; i1 = j; }
        int i2 = -1; float m2 = -3.0e38f;
#pragma unroll
        for (int j = 0; j < 8; ++j) if (j != i1 && el[j] > m2) { m2 = el[j]; i2 = j; }
        const float e2 = expf(m2 - m1); const float w1v = gval / (1.f + e2), w2v = gval * e2 / (1.f + e2);
        if (lane == 0) {
            const int ea = gi * 8 + i1, eb = gi * 8 + i2;
            const unsigned pa = atomicAdd(&cnt[ea], 1u); ETOK[(size_t)ea * CAPE + pa] = tok * 2; EW[(size_t)ea * CAPE + pa] = w1v;
            const unsigned pb = atomicAdd(&cnt[eb], 1u); ETOK[(size_t)eb * CAPE + pb] = tok * 2 + 1; EW[(size_t)eb * CAPE + pb] = w2v;
        }
    }
}

DI int pad_start_of(const unsigned* cnt, int e) { int s = 0; for (int i = 0; i < e; ++i) s += (int)((cnt[i] + 255u) & ~255u); return s; }
__global__ void __launch_bounds__(64) k_moe1(Params p, int l) {
    const int lane = threadIdx.x, h = lane >> 5; const int ct = blockIdx.x, rt = blockIdx.y, e = blockIdx.z;
    const unsigned* cnt = (const unsigned*)(p.ws + WS_CTL) + CW_COUNT + l * 32; const int n = (int)cnt[e]; if (rt * 32 >= n) return;
    const int ps = pad_start_of(cnt, e);
    const int* ETOK = (const int*)(p.ws + WS_ETOK) + (size_t)e * CAPE;
    const int pos = rt * 32 + (lane & 31); const int tok = pos < n ? (ETOK[pos] >> 1) : 0;
    const bf16_t* A = (const bf16_t*)(p.ws + WS_ACT) + (size_t)tok * D; const bf16_t* W = (const bf16_t*)(p.ws + WS_W13_T) + (size_t)e * 1024 * 1024;
    const int c = ct * 32 + (lane & 31); const int r1 = 256 * (c / 128) + (c % 128);
    const f32x16 a1 = wave_gemm32(A, W + (size_t)r1 * D, D, lane), a3 = wave_gemm32(A, W + (size_t)(r1 + 128) * D, D, lane);
    bf16_t* H = (bf16_t*)(p.ws + WS_H);
#pragma unroll
    for (int r = 0; r < 16; ++r) { const int pr = rt * 32 + 8 * (r >> 2) + 4 * h + (r & 3); if (pr < n) H[(size_t)(ps + pr) * EFF + c] = f2bf(siluf(a1[r]) * a3[r]); }
}
__global__ void __launch_bounds__(64) k_moe2(Params p, int l) {
    const int lane = threadIdx.x, h = lane >> 5; const int ct = blockIdx.x, rt = blockIdx.y, e = blockIdx.z;
    const unsigned* cnt = (const unsigned*)(p.ws + WS_CTL) + CW_COUNT + l * 32; const int n = (int)cnt[e]; if (rt * 32 >= n) return;
    const int ps = pad_start_of(cnt, e);
    const int* ETOK = (const int*)(p.ws + WS_ETOK) + (size_t)e * CAPE; const float* EW = (const float*)(p.ws + WS_EW) + (size_t)e * CAPE;
    const int pos = rt * 32 + (lane & 31); const int arow = pos < n ? ps + pos : ps;
    const bf16_t* A = (const bf16_t*)(p.ws + WS_H) + (size_t)arow * EFF; const bf16_t* W = (const bf16_t*)(p.ws + WS_W2_T) + (size_t)e * 1024 * 512;
    const int c = ct * 32 + (lane & 31);
    const f32x16 acc = wave_gemm32(A, W + (size_t)c * EFF, EFF, lane);
    bf16_t* Y = (bf16_t*)(p.ws + WS_YTOK);
#pragma unroll
    for (int r = 0; r < 16; ++r) { const int pr = rt * 32 + 8 * (r >> 2) + 4 * h + (r & 3); if (pr < n) { const int dst = ETOK[pr]; Y[(size_t)dst * D + c] = f2bf(EW[pr] * acc[r]); } }
}

__global__ void __launch_bounds__(256) k_combine(Params p, int l) {
    const int lane = threadIdx.x & 63; const int w = blockIdx.x * 4 + (threadIdx.x >> 6); const int M = l == 0 ? T : TL;
    const bf16_t* Y = (const bf16_t*)(p.ws + WS_YTOK); bf16_t* ACT = (bf16_t*)(p.ws + WS_ACT); float* XC = (float*)(p.ws + WS_XC);
    for (int tok = w; tok < M; tok += gridDim.x * 4) {
        float* xr = tok < TL ? p.out + (size_t)tok * D : XC + (size_t)(tok - TL) * D;
        const int mr = tok < TL ? tok / SEQ : 32; const float* g2 = modrow(p, l, mr) + 5120;
        float xv[16]; float ss = 0.f;
#pragma unroll
        for (int j = 0; j < 4; ++j) {
            const int k = j * 256 + lane * 4; const f32x4 v = *(const f32x4*)(xr + k);
            const u32x2 y0 = *(const u32x2*)(Y + (size_t)(tok * 2) * D + k), y1 = *(const u32x2*)(Y + (size_t)(tok * 2 + 1) * D + k);
            float ya[4] = {__uint_as_float(y0.x << 16), __uint_as_float(y0.x & 0xffff0000u), __uint_as_float(y0.y << 16), __uint_as_float(y0.y & 0xffff0000u)};
            float yb[4] = {__uint_as_float(y1.x << 16), __uint_as_float(y1.x & 0xffff0000u), __uint_as_float(y1.y << 16), __uint_as_float(y1.y & 0xffff0000u)};
            f32x4 o;
#pragma unroll
            for (int q = 0; q < 4; ++q) { o[q] = v[q] + g2[k + q] * (ya[q] + yb[q]); xv[j * 4 + q] = o[q]; ss += o[q] * o[q]; }
            *(f32x4*)(xr + k) = o;
        }
        if (l == 0) {
            ss = wave_sum(ss); const float rstd = rsqrtf(ss * (1.f / 1024.f) + EPS);
            const float* m = modrow(p, 1, mr); const float* g = p.in[I_N1G] + D;
#pragma unroll
            for (int j = 0; j < 4; ++j) {
                const int k = j * 256 + lane * 4; bf16_t o[4];
#pragma unroll
                for (int q = 0; q < 4; ++q) o[q] = f2bf(xv[j * 4 + q] * rstd * g[k + q] * (1.f + m[1024 + k + q]) + m[k + q]);
                u32x2 wv; wv.x = (unsigned)o[0] | ((unsigned)o[1] << 16); wv.y = (unsigned)o[2] | ((unsigned)o[3] << 16);
                *(u32x2*)(ACT + (size_t)tok * D + k) = wv;
            }
        }
    }
}

extern "C" void kernel_launch(void* const* d_in, const int* in_sizes, int n_in, void* d_out, int out_size, void* d_ws, size_t ws_size, hipStream_t stream) {
    static int init = 0;
    if (!init) {
        init = 1;
        if (ws_size < WS_END) fprintf(stderr, "kernel_launch: workspace too small: %zu < %zu\n", ws_size, (size_t)WS_END);
        hipFuncSetAttribute((const void*)k_mod, hipFuncAttributeMaxDynamicSharedMemorySize, 33 * 1024 * 4);
    }
    Params p{};
    for (int i = 0; i < N_IN; ++i) p.in[i] = (const float*)d_in[i];
    p.out = (float*)d_out; p.ws = (unsigned char*)d_ws;
    hipMemsetAsync((char*)d_ws + WS_CTL, 0, 1 * MiB, stream);
    hipLaunchKernelGGL(k_mod, dim3(256), dim3(512), 33 * 1024 * 4, stream, p);
    hipLaunchKernelGGL(k_convert, dim3(1024), dim3(512), 0, stream, p, 0);
    hipLaunchKernelGGL(k_filter, dim3(1152), dim3(512), 0, stream, p, 0);
    hipLaunchKernelGGL(k_norm1, dim3(2048), dim3(256), 0, stream, p, 0);
    for (int l = 0; l < 2; ++l) {
        const int M = l == 0 ? T : TL;
        hipLaunchKernelGGL(k_inproj, dim3((T / 32) * (ZW / 32) / 4), dim3(256), 0, stream, p);
        hipLaunchKernelGGL(k_mprep, dim3(8192), dim3(64), 0, stream, p, l);
        hipLaunchKernelGGL(k_hyprep, dim3(8192), dim3(256), 0, stream, p, l);
        hipLaunchKernelGGL(k_lruprep, dim3(8192), dim3(256), 0, stream, p, l);
        const int nq = l == 0 ? PALL : SEQ;
        hipLaunchKernelGGL(k_attn, dim3(NB * 4 * nq / 64), dim3(64), 0, stream, p, l);
        hipLaunchKernelGGL(k_ret, dim3(NB * 4 * nq / 64), dim3(64), 0, stream, p, l);
        hipLaunchKernelGGL(k_hyena, dim3(16384), dim3(256), 0, stream, p, l);
        hipLaunchKernelGGL(k_lru, dim3(256), dim3(64), 0, stream, p, l);
        hipLaunchKernelGGL(k_merge, dim3(16384), dim3(64), 0, stream, p, l);
        hipLaunchKernelGGL(k_outproj, dim3((M / 32) * (D / 32) / 4), dim3(256), 0, stream, p, l);
        hipLaunchKernelGGL(k_norm2, dim3(2048), dim3(256), 0, stream, p, l);
        hipLaunchKernelGGL(k_moe1, dim3(16, M / 32, NEXP), dim3(64), 0, stream, p, l);
        hipLaunchKernelGGL(k_moe2, dim3(32, M / 32, NEXP), dim3(64), 0, stream, p, l);
        if (l == 0) {
            hipLaunchKernelGGL(k_convert, dim3(1024), dim3(512), 0, stream, p, 1);
            hipLaunchKernelGGL(k_filter, dim3(1152), dim3(512), 0, stream, p, 1);
        }
        hipLaunchKernelGGL(k_combine, dim3(2048), dim3(256), 0, stream, p, l);
    }
}
```

```cpp
#include <hip/hip_runtime.h>
#include <cstdio>
#include <cstdint>

#define DI __device__ __forceinline__
#define LAS __attribute__((address_space(3)))
typedef unsigned short bf16_t;
typedef short bf16x8 __attribute__((ext_vector_type(8)));
typedef float f32x4 __attribute__((ext_vector_type(4)));
typedef float f32x16 __attribute__((ext_vector_type(16)));
typedef unsigned u32x4 __attribute__((ext_vector_type(4)));
typedef unsigned u32x2 __attribute__((ext_vector_type(2)));

constexpr int D = 1024, NB = 32, SEQ = 2048, CTXL = 256, PALL = SEQ + CTXL;
constexpr int TL = NB * SEQ, TC = NB * CTXL, T = TL + TC;
constexpr int ZW = 2816, INC = 2656;
constexpr int ZC_CQ = 0, ZC_CKV = 192, ZC_KR = 320, ZC_RQ = 352, ZC_RK = 608, ZC_RV = 864, ZC_RG = 1120,
              ZC_HX0 = 1376, ZC_HX1 = 1632, ZC_HV = 1888, ZC_LX = 2144, ZC_LG = 2400;
constexpr float EPS = 1e-6f;
constexpr int NEXP = 32, EFF = 512, CAPE = T;
constexpr int MAXSLOT = 155648;

enum { I_X = 0, I_C, I_CTX, I_CCTX, I_WMOD, I_BMOD, I_N1G, I_N2G, I_WIN, I_QNG, I_WUQ, I_KVNG, I_WUKV, I_QN, I_KN, I_RLG, I_RNG,
       I_HCW, I_HCB, I_HW1, I_HB1, I_HW2, I_HB2, I_HW3, I_HFREQ, I_HD, I_LCW, I_LCB, I_LWA, I_LBA, I_LWX, I_LBX, I_LLAM, I_GNG, I_WOUT,
       I_MWG, I_MWE, I_MW1, I_MW3, I_MW2, N_IN };

constexpr size_t MiB = 1024ull * 1024ull;
constexpr size_t WS_CTL = 0;
constexpr size_t WS_MOD = 1 * MiB;
constexpr size_t WS_G2048 = 3 * MiB;
constexpr size_t WS_G256 = 5 * MiB;
constexpr size_t WS_WUQ_T = 6 * MiB;
constexpr size_t WS_WUKV_T = 6 * MiB + 256 * 1024;
constexpr size_t WS_LRUW_T = 6 * MiB + 512 * 1024;
constexpr size_t WS_WIN_T = 7 * MiB;
constexpr size_t WS_WOUT_T = 13 * MiB;
constexpr size_t WS_W13_T = 15 * MiB;
constexpr size_t WS_W2_T = 79 * MiB;
constexpr size_t WS_ETOK = 111 * MiB;
constexpr size_t WS_EW = 120 * MiB;
constexpr size_t WS_XC = 129 * MiB;
constexpr size_t WS_ACT = 161 * MiB;
constexpr size_t WS_Q = WS_ACT;
constexpr size_t WS_K = WS_Q + 56623104ull;
constexpr size_t WS_VT = WS_K + 56623104ull;
constexpr size_t WS_YA = 305 * MiB;
constexpr size_t WS_OF = 341 * MiB;
constexpr size_t WS_OB = 377 * MiB;
constexpr size_t WS_HF = 413 * MiB;
constexpr size_t WS_HB = 449 * MiB;
constexpr size_t WS_Z = 485 * MiB;
constexpr size_t WS_SL = 881 * MiB;
constexpr size_t WS_SC = 913 * MiB;
constexpr size_t WS_YT = 917 * MiB;
constexpr size_t WS_YTC = 949 * MiB;
constexpr size_t WS_H = WS_Z;
constexpr size_t WS_YTOK = WS_Z + 152 * MiB;
constexpr size_t WS_XT = 953 * MiB;
constexpr size_t WS_END = 989 * MiB;
constexpr int CW_COUNT = 4096;

struct Params { const float* in[N_IN]; float* out; unsigned char* ws; int ph_lo, ph_hi; };
#define CPARAMS const __attribute__((address_space(4))) Params&
typedef const __attribute__((address_space(4))) Params* KP;
DI int ltid() { int t = threadIdx.x; asm volatile("" : "+v"(t)); return t; }
DI KP launder_kp(KP k) { asm volatile("" : "+s"(k)); return k; }

DI bf16_t f2bf(float f) { unsigned u = __float_as_uint(f); u += 0x7FFFu + ((u >> 16) & 1u); return (bf16_t)(u >> 16); }
DI float bf2f(bf16_t b) { return __uint_as_float(((unsigned)b) << 16); }
DI float wave_sum(float v) {
#pragma unroll
    for (int o = 32; o > 0; o >>= 1) v += __shfl_xor(v, o);
    return v;
}
DI float hw_sin(float x) { float r = x * 0.15915494309189535f; r -= floorf(r); return __builtin_amdgcn_sinf(r); }
DI float siluf(float v) { return v / (1.f + expf(-v)); }
DI float gelu_tanh(float x) { const float u = 0.7978845608028654f * (x + 0.044715f * x * x * x); return 0.5f * x * (1.f + tanhf(u)); }
DI const float* modrow(CPARAMS p, int l, int r) { return (const float*)(p.ws + WS_MOD) + ((size_t)l * 33 + r) * 6144; }
DI int tok_batch(int tok) { return tok < TL ? tok / SEQ : (tok - TL) / CTXL; }

DI void phase_mod(CPARAMS p, LAS float* sm) {
  for (int vb = blockIdx.x; vb < 256; vb += gridDim.x) {
    __syncthreads();
    float* MOD = (float*)(p.ws + WS_MOD);
    const int tid = ltid();
    for (int i = tid; i < 33 * 1024; i += 512) { const int r = i >> 10, k = i & 1023; const float v = r < 32 ? p.in[I_C][r * 1024 + k] : p.in[I_CCTX][k]; sm[i] = siluf(v); }
    __syncthreads();
    const int col = tid % 48, ks = tid / 48;
    const int gcol = vb * 48 + col, l = gcol / 6144, n = gcol % 6144;
    float acc[33];
#pragma unroll
    for (int r = 0; r < 33; ++r) acc[r] = 0.f;
    if (ks < 8) {
        const float* w = p.in[I_WMOD] + (size_t)l * 1024 * 6144 + n;
        for (int k = ks * 128; k < ks * 128 + 128; ++k) {
            const float wv = w[(size_t)k * 6144];
#pragma unroll
            for (int r = 0; r < 33; ++r) acc[r] += sm[r * 1024 + k] * wv;
        }
    }
    __syncthreads();
    if (ks < 8) {
#pragma unroll
        for (int r = 0; r < 33; ++r) sm[(ks * 33 + r) * 48 + col] = acc[r];
    }
    __syncthreads();
    for (int i = tid; i < 33 * 48; i += 512) {
        const int r = i / 48, c = i % 48; float s = 0.f;
        for (int k2 = 0; k2 < 8; ++k2) s += sm[(k2 * 33 + r) * 48 + c];
        const int g = vb * 48 + c, l2 = g / 6144, n2 = g % 6144;
        MOD[((size_t)l2 * 33 + r) * 6144 + n2] = s + p.in[I_BMOD][l2 * 6144 + n2];
    }
  }
}

DI void tconv_tile(const float* src, int lds_, int K, int N, bf16_t* dst, int ldd, int k0, int n0, int drow0, LAS float* tile, int tid, const float* kscale = nullptr) {
    __syncthreads();
#pragma unroll
    for (int i = 0; i < 8; ++i) { const int idx = tid + 512 * i, kk = idx >> 6, nn = idx & 63; float v = 0.f; if (k0 + kk < K && n0 + nn < N) { v = src[(size_t)(k0 + kk) * lds_ + n0 + nn]; if (kscale) v *= kscale[k0 + kk]; } tile[kk * 65 + nn] = v; }
    __syncthreads();
#pragma unroll
    for (int i = 0; i < 8; ++i) { const int idx = tid + 512 * i, nn = idx >> 6, kk = idx & 63; if (k0 + kk < K && n0 + nn < N) dst[(size_t)(drow0 + nn) * ldd + k0 + kk] = f2bf(tile[kk * 65 + nn]); }
}
DI void phase_convert(CPARAMS p, int l, LAS float* tile) {
    const int tid = ltid();
    bf16_t* WIN_T = (bf16_t*)(p.ws + WS_WIN_T); bf16_t* WOUT_T = (bf16_t*)(p.ws + WS_WOUT_T); bf16_t* W13_T = (bf16_t*)(p.ws + WS_W13_T); bf16_t* W2_T = (bf16_t*)(p.ws + WS_W2_T);
    bf16_t* WUQ_T = (bf16_t*)(p.ws + WS_WUQ_T); bf16_t* WUKV_T = (bf16_t*)(p.ws + WS_WUKV_T); bf16_t* LRUW_T = (bf16_t*)(p.ws + WS_LRUW_T);
    constexpr int N0 = 16 * 42, N1 = N0 + 256, N2 = N1 + 32 * 2 * 128, N3 = N2 + 32 * 128, N4 = N3 + 18, N5 = N4 + 16, N6 = N5 + 16;
    for (int t = blockIdx.x; t < N6; t += gridDim.x) {
        if (t < N0) { const int kt = t / 42, nt = t % 42; tconv_tile(p.in[I_WIN] + (size_t)l * 1024 * INC, INC, 1024, INC, WIN_T, 1024, kt * 64, nt * 64, nt * 64, tile, tid); }
        else if (t < N1) { const int u = t - N0, kt = u / 16, nt = u % 16; tconv_tile(p.in[I_WOUT] + (size_t)l * 1024 * 1024, 1024, 1024, 1024, WOUT_T, 1024, kt * 64, nt * 64, nt * 64, tile, tid); }
        else if (t < N2) { const int u = t - N1, e = u / 256, r = u % 256, bj = r / 128, q = r % 128, kt = q / 8, nt = q % 8; const int n0 = nt * 64;
            const float* src = p.in[bj ? I_MW3 : I_MW1] + ((size_t)l * NEXP + e) * 1024 * 512;
            tconv_tile(src, 512, 1024, 512, W13_T + (size_t)e * 1024 * 1024, 1024, kt * 64, n0, 256 * (n0 / 128) + 128 * bj + (n0 % 128), tile, tid); }
        else if (t < N3) { const int u = t - N2, e = u / 128, q = u % 128, kt = q / 16, nt = q % 16;
            tconv_tile(p.in[I_MW2] + ((size_t)l * NEXP + e) * 512 * 1024, 1024, 512, 1024, W2_T + (size_t)e * 1024 * 512, 512, kt * 64, nt * 64, nt * 64, tile, tid); }
        else if (t < N4) { const int u = t - N3, kt = u / 6, nt = u % 6; tconv_tile(p.in[I_WUQ] + (size_t)l * 192 * 384, 384, 192, 384, WUQ_T, 192, kt * 64, nt * 64, nt * 64, tile, tid, p.in[I_QNG] + l * 192); }
        else if (t < N5) { const int u = t - N4, kt = u / 8, nt = u % 8; tconv_tile(p.in[I_WUKV] + (size_t)l * 128 * 512, 512, 128, 512, WUKV_T, 128, kt * 64, nt * 64, nt * 64, tile, tid, p.in[I_KVNG] + l * 128); }
        else { const int u = t - N5, dir = u / 8, gate = (u / 4) & 1, n = u % 4;
            const float* src = p.in[gate ? I_LWX : I_LWA] + (((size_t)l * 2 + dir) * 4 + n) * 4096;
            tconv_tile(src, 64, 64, 64, LRUW_T + (size_t)((dir * 2 + gate) * 4 + n) * 4096, 64, 0, 0, 0, tile, tid); }
    }
    for (size_t i = (size_t)blockIdx.x * 512 + tid; i < (size_t)(ZW - INC) * 1024; i += (size_t)gridDim.x * 512) WIN_T[(size_t)INC * 1024 + i] = 0;
}

DI void phase_filter(CPARAMS p, int l, LAS float* fl) {
    LAS float* z = fl; LAS float* h1 = fl + 64; LAS float* h2 = fl + 128;
    const int tid = ltid();
    bf16_t* G2048 = (bf16_t*)(p.ws + WS_G2048); bf16_t* G256 = (bf16_t*)(p.ws + WS_G256);
    const float* w1 = p.in[I_HW1] + (size_t)l * 33 * 64; const float* b1 = p.in[I_HB1] + l * 64; const float* w2 = p.in[I_HW2] + (size_t)l * 64 * 64; const float* b2 = p.in[I_HB2] + l * 64;
    const float* w3 = p.in[I_HW3] + (size_t)l * 64 * 512; const float* fr = p.in[I_HFREQ] + l * 64; const float* hd = p.in[I_HD] + l * 256;
    for (int pi = blockIdx.x; pi < 2048 + 256; pi += gridDim.x) {
        const int n = pi < 2048 ? 2048 : 256, i = pi < 2048 ? pi : pi - 2048;
        bf16_t* G = pi < 2048 ? G2048 : G256;
        const float tt = (float)i / (float)(n - 1);
        __syncthreads();
        if (tid < 33) {
            float v;
            if (tid == 0) v = tt;
            else { const int j = (tid - 1) & 15; const float band = 1e-4f + (15.f - 1e-4f) * (float)j / 15.f; float rev = band * ((float)i / (float)n); rev -= floorf(rev);
                v = tid <= 16 ? __builtin_amdgcn_cosf(rev) : -__builtin_amdgcn_sinf(rev); }
            z[tid] = v;
        }
        __syncthreads();
        if (tid < 64) { float s = b1[tid];
#pragma unroll 4
            for (int m = 0; m < 33; ++m) s += z[m] * w1[m * 64 + tid]; h1[tid] = hw_sin(fr[tid] * s); }
        __syncthreads();
        if (tid < 64) { float s = b2[tid];
#pragma unroll 4
            for (int m = 0; m < 64; ++m) s += h1[m] * w2[m * 64 + tid]; h2[tid] = hw_sin(fr[tid] * s); }
        __syncthreads();
        {
            const int j = tid; float s = 0.f;
#pragma unroll 4
            for (int m = 0; m < 64; ++m) s += h2[m] * w3[m * 512 + j];
            const int c = j & 255; const float mind = logf(1e-2f) / 1.5f, maxd = logf(1e-2f) / 0.3f; const float delta = fabsf(mind + (maxd - mind) * (float)c / 255.f);
            float hv = s * expf(-tt * delta);
            if (j < 256) { if (i == 0) hv += hd[c]; G[(size_t)c * 2 * n + (n - i)] = f2bf(hv); if (i == 0) G[(size_t)c * 2 * n] = 0; }
            else if (i >= 1) G[(size_t)c * 2 * n + (n + i)] = f2bf(hv);
        }
    }
}

DI void norm_mod_row(const float* xr, const float* g, const float* sh, const float* sc, bf16_t* dst, int lane, float (&xv)[16]) {
    float ss = 0.f;
#pragma unroll
    for (int j = 0; j < 4; ++j) { const f32x4 v = *(const f32x4*)(xr + j * 256 + lane * 4); xv[j * 4 + 0] = v[0]; xv[j * 4 + 1] = v[1]; xv[j * 4 + 2] = v[2]; xv[j * 4 + 3] = v[3]; ss += v[0] * v[0] + v[1] * v[1] + v[2] * v[2] + v[3] * v[3]; }
    ss = wave_sum(ss);
    const float rstd = rsqrtf(ss * (1.f / 1024.f) + EPS);
#pragma unroll
    for (int j = 0; j < 4; ++j) {
        const int k = j * 256 + lane * 4; bf16_t o[4];
#pragma unroll
        for (int q = 0; q < 4; ++q) { const float y = xv[j * 4 + q] * rstd * g[k + q]; xv[j * 4 + q] = y * (1.f + sc[k + q]) + sh[k + q]; o[q] = f2bf(xv[j * 4 + q]); }
        u32x2 w; w.x = (unsigned)o[0] | ((unsigned)o[1] << 16); w.y = (unsigned)o[2] | ((unsigned)o[3] << 16);
        *(u32x2*)(dst + k) = w;
    }
}
DI void phase_norm1(CPARAMS p, int l) {
    const int lane = ltid() & 63; const int w = blockIdx.x * 8 + (ltid() >> 6);
    bf16_t* ACT = (bf16_t*)(p.ws + WS_ACT);
    for (int tok = w; tok < T; tok += gridDim.x * 8) {
        const float* xr = tok < TL ? p.in[I_X] + (size_t)tok * D : p.in[I_CTX] + (size_t)(tok - TL) * D;
        const float* m = modrow(p, l, tok < TL ? tok / SEQ : 32);
        float xv[16];
        norm_mod_row(xr, p.in[I_N1G] + l * D, m, m + 1024, ACT + (size_t)tok * D, lane, xv);
    }
}

DI float conv3_at(const bf16_t* Z, int tokbase, int t, int L, int zcol, const float* cw, const float* cb, int ch768) {
    float s = cb[ch768];
#pragma unroll
    for (int j = 0; j < 3; ++j) { const int tt = t - 1 + j; if (tt >= 0 && tt < L) s += cw[j * 768 + ch768] * bf2f(Z[(size_t)(tokbase + tt) * ZW + zcol]); }
    return s;
}
DI void phase_merge(CPARAMS p, int l) {
    const int lane = ltid() & 63; const int M = l == 0 ? T : TL;
    const bf16_t* Z = (const bf16_t*)(p.ws + WS_Z); bf16_t* ACT = (bf16_t*)(p.ws + WS_ACT);
    const bf16_t* YA = (const bf16_t*)(p.ws + WS_YA); const bf16_t* OF = (const bf16_t*)(p.ws + WS_OF); const bf16_t* OB = (const bf16_t*)(p.ws + WS_OB);
    const bf16_t* HF = (const bf16_t*)(p.ws + WS_HF); const bf16_t* HB = (const bf16_t*)(p.ws + WS_HB);
    const float* gng = p.in[I_GNG] + l * 1024; const float* rng = p.in[I_RNG] + l * 256; const float* cw = p.in[I_HCW] + (size_t)l * 3 * 768; const float* cb = p.in[I_HCB] + l * 768;
    for (int tok = blockIdx.x * 8 + (ltid() >> 6); tok < M; tok += gridDim.x * 8) {
        const bool lat = tok < TL; const int L = lat ? SEQ : CTXL; const int b = tok_batch(tok); const int t = lat ? tok % SEQ : (tok - TL) % CTXL; const int base = tok - t;
        const bf16_t* zr = Z + (size_t)tok * ZW;
        float v[4][4];
        for (int j = 0; j < 4; ++j) v[0][j] = bf2f(YA[(size_t)tok * 256 + lane + 64 * j]);
        for (int j = 0; j < 4; ++j) {
            const int ch = lane + 64 * j; const float o = bf2f(OF[(size_t)tok * 256 + ch]) + bf2f(OB[(size_t)tok * 256 + ch]);
            const float ss = wave_sum(o * o); const float rs = rsqrtf(ss / 64.f + EPS);
            v[1][j] = o * rs * rng[ch] * siluf(bf2f(zr[ZC_RG + ch]));
        }
        for (int j = 0; j < 4; ++j) {
            const int ch = lane + 64 * j; const float x0 = conv3_at(Z, base, t, L, ZC_HX0 + ch, cw, cb, ch);
            const bf16_t* YT = (const bf16_t*)(p.ws + (lat ? WS_YT : WS_YTC)); const float y = bf2f(YT[((size_t)ch * NB + b) * L + t]);
            v[2][j] = x0 * y;
        }
        for (int j = 0; j < 4; ++j) { const int ch = lane + 64 * j; const float hsum = bf2f(HF[(size_t)tok * 256 + ch]) + bf2f(HB[(size_t)tok * 256 + ch]); v[3][j] = hsum * gelu_tanh(bf2f(zr[ZC_LG + ch])); }
        for (int g = 0; g < 4; ++g) {
            float ss = 0.f; for (int j = 0; j < 4; ++j) ss += v[g][j] * v[g][j];
            ss = wave_sum(ss); const float rs = rsqrtf(ss / 256.f + EPS);
            for (int j = 0; j < 4; ++j) { const int ch = lane + 64 * j; ACT[(size_t)tok * D + g * 256 + ch] = f2bf(v[g][j] * rs * gng[g * 256 + ch]); }
        }
    }
}

DI void phase_norm2(CPARAMS p, int l) {
    const int lane = ltid() & 63; const int w = blockIdx.x * 8 + (ltid() >> 6); const int M = l == 0 ? T : TL;
    bf16_t* ACT = (bf16_t*)(p.ws + WS_ACT); const float* XC = (const float*)(p.ws + WS_XC);
    const float* wg = p.in[I_MWG] + (size_t)l * 1024 * 4; const float* we = p.in[I_MWE] + (size_t)l * 1024 * 32;
    unsigned* cnt = (unsigned*)(p.ws + WS_CTL) + CW_COUNT + l * 32; int* ETOK = (int*)(p.ws + WS_ETOK); float* EW = (float*)(p.ws + WS_EW);
    for (int tok = w; tok < M; tok += gridDim.x * 8) {
        const float* xr = tok < TL ? p.out + (size_t)tok * D : XC + (size_t)(tok - TL) * D;
        const float* m = modrow(p, l, tok < TL ? tok / SEQ : 32);
        float f[16];
        norm_mod_row(xr, p.in[I_N2G] + l * D, m + 3072, m + 4096, ACT + (size_t)tok * D, lane, f);
        float lg[4];
#pragma unroll
        for (int j = 0; j < 4; ++j) lg[j] = 0.f;
#pragma unroll
        for (int jj = 0; jj < 4; ++jj)
#pragma unroll
            for (int q = 0; q < 4; ++q) { const int k = jj * 256 + lane * 4 + q; const f32x4 wv = *(const f32x4*)(wg + (size_t)k * 4); const float fv = f[jj * 4 + q]; lg[0] += fv * wv[0]; lg[1] += fv * wv[1]; lg[2] += fv * wv[2]; lg[3] += fv * wv[3]; }
#pragma unroll
        for (int j = 0; j < 4; ++j) lg[j] = wave_sum(lg[j]);
        int gi = 0; float gm = lg[0];
#pragma unroll
        for (int j = 1; j < 4; ++j) if (lg[j] > gm) { gm = lg[j]; gi = j; }
        float den = 0.f;
#pragma unroll
        for (int j = 0; j < 4; ++j) den += expf(lg[j] - gm);
        const float gval = 1.f / den;
        float el[8];
#pragma unroll
        for (int j = 0; j < 8; ++j) el[j] = 0.f;
#pragma unroll
        for (int jj = 0; jj < 4; ++jj)
#pragma unroll
            for (int q = 0; q < 4; ++q) { const int k = jj * 256 + lane * 4 + q; const float* wr = we + (size_t)k * 32 + gi * 8; const f32x4 w0 = *(const f32x4*)wr, w1 = *(const f32x4*)(wr + 4); const float fv = f[jj * 4 + q];
                el[0] += fv * w0[0]; el[1] += fv * w0[1]; el[2] += fv * w0[2]; el[3] += fv * w0[3]; el[4] += fv * w1[0]; el[5] += fv * w1[1]; el[6] += fv * w1[2]; el[7] += fv * w1[3]; }
#pragma unroll
        for (int j = 0; j < 8; ++j) el[j] = wave_sum(el[j]);
        int i1 = 0; float m1 = el[0];
#pragma unroll
        for (int j = 1; j < 8; ++j) if (el[j] > m1) { m1 = el[j]; i1 = j; }
        int i2 = -1; float m2 = -3.0e38f;
#pragma unroll
        for (int j = 0; j < 8; ++j) if (j != i1 && el[j] > m2) { m2 = el[j]; i2 = j; }
        const float e2 = expf(m2 - m1); const float w1v = gval / (1.f + e2), w2v = gval * e2 / (1.f + e2);
        if (lane == 0) {
            const int ea = gi * 8 + i1, eb = gi * 8 + i2;
            const unsigned pa = atomicAdd(&cnt[ea], 1u); ETOK[(size_t)ea * CAPE + pa] = tok * 2; EW[tok * 2] = w1v;
            const unsigned pb = atomicAdd(&cnt[eb], 1u); ETOK[(size_t)eb * CAPE + pb] = tok * 2 + 1; EW[tok * 2 + 1] = w2v;
        }
    }
}

DI void phase_combine(CPARAMS p, int l) {
    const int lane = ltid() & 63; const int w = blockIdx.x * 8 + (ltid() >> 6); const int M = l == 0 ? T : TL;
    const bf16_t* Y = (const bf16_t*)(p.ws + WS_YTOK); bf16_t* ACT = (bf16_t*)(p.ws + WS_ACT); float* XC = (float*)(p.ws + WS_XC);
    for (int tok = w; tok < M; tok += gridDim.x * 8) {
        float* xr = tok < TL ? p.out + (size_t)tok * D : XC + (size_t)(tok - TL) * D;
        const int mr = tok < TL ? tok / SEQ : 32; const float* g2 = modrow(p, l, mr) + 5120;
        const float tw0 = ((const float*)(p.ws + WS_EW))[tok * 2], tw1 = ((const float*)(p.ws + WS_EW))[tok * 2 + 1];
        float xv[16]; float ss = 0.f;
#pragma unroll
        for (int j = 0; j < 4; ++j) {
            const int k = j * 256 + lane * 4; const f32x4 v = *(const f32x4*)(xr + k);
            const u32x2 y0 = *(const u32x2*)(Y + (size_t)(tok * 2) * D + k), y1 = *(const u32x2*)(Y + (size_t)(tok * 2 + 1) * D + k);
            float ya[4] = {__uint_as_float(y0.x << 16), __uint_as_float(y0.x & 0xffff0000u), __uint_as_float(y0.y << 16), __uint_as_float(y0.y & 0xffff0000u)};
            float yb[4] = {__uint_as_float(y1.x << 16), __uint_as_float(y1.x & 0xffff0000u), __uint_as_float(y1.y << 16), __uint_as_float(y1.y & 0xffff0000u)};
            f32x4 o;
#pragma unroll
            for (int q = 0; q < 4; ++q) { o[q] = v[q] + g2[k + q] * (tw0 * ya[q] + tw1 * yb[q]); xv[j * 4 + q] = o[q]; ss += o[q] * o[q]; }
            *(f32x4*)(xr + k) = o;
        }
        if (l == 0) {
            ss = wave_sum(ss); const float rstd = rsqrtf(ss * (1.f / 1024.f) + EPS);
            const float* m = modrow(p, 1, mr); const float* g = p.in[I_N1G] + D;
#pragma unroll
            for (int j = 0; j < 4; ++j) {
                const int k = j * 256 + lane * 4; bf16_t o[4];
#pragma unroll
                for (int q = 0; q < 4; ++q) o[q] = f2bf(xv[j * 4 + q] * rstd * g[k + q] * (1.f + m[1024 + k + q]) + m[k + q]);
                u32x2 wv; wv.x = (unsigned)o[0] | ((unsigned)o[1] << 16); wv.y = (unsigned)o[2] | ((unsigned)o[3] << 16);
                *(u32x2*)(ACT + (size_t)tok * D + k) = wv;
            }
        }
    }
}


namespace gp {
#define GP_LAS __attribute__((address_space(3)))
constexpr int BM = 256, BK = 64, HALF = 128, HTB = HALF * BK * 2, STAGE_BYTES = 8 * HTB, NXCD = 8, WGM = 8;
__host__ __device__ __forceinline__ int lds_byte(int r, int c) { const int st = (r >> 4) * 2 + (c >> 5), rr = r & 15, cc = c & 31, ob = rr * 64 + cc * 2; return st * 1024 + (ob ^ (((ob >> 9) & 1) << 5)); }
__host__ __device__ __forceinline__ void stage_rc(int b, int& R, int& C) { const int st = b / 1024, sb = b % 1024, swz = sb ^ (((sb >> 9) & 1) << 5); R = (st >> 1) * 16 + swz / 64; C = (st & 1) * 32 + (swz % 64) / 2; }
__host__ __device__ __forceinline__ int perm32(int rho) { const int n = rho >> 4, i = rho & 15; return 8 * (i >> 2) + 4 * n + (i & 3); }
__device__ __forceinline__ unsigned cvt_pk_bf16(float lo, float hi) { unsigned r; asm volatile("v_cvt_pk_bf16_f32 %0, %1, %2" : "=v"(r) : "v"(lo), "v"(hi)); return r; }

struct Unit { int pm, pn, e, pos0, nvalid; };

struct StaticOrder {
    int nM, nN, nwg, G, c;
    __device__ void init(int nM_, int nN_, int G_, int c_) { nM = nM_; nN = nN_; nwg = nM * nN; G = G_; c = c_; }
    __device__ bool next(int i, Unit& u) const {
        const long L = (long)i * G + c; if (L >= nwg) return false;
        int wgid = (int)L; { const int q = nwg / NXCD, r = nwg % NXCD, xcd = wgid % NXCD, off = wgid / NXCD; wgid = (xcd < r ? xcd * (q + 1) : r * (q + 1) + (xcd - r) * q) + off; }
        const int nig = WGM * nN, gid = wgid / nig, fm = gid * WGM, gsz = (nM - fm) < WGM ? (nM - fm) : WGM;
        u.pm = fm + ((wgid % nig) % gsz); u.pn = (wgid % nig) / gsz; u.e = 0; u.pos0 = 0; u.nvalid = 256; return true;
    }
};
struct MoeOrder {
    StaticOrder so; const unsigned* cnt;
    __device__ void init(const unsigned* cnt_, int nN, int G, int c) { cnt = cnt_; int nb = 0; for (int e = 0; e < NEXP; ++e) nb += (int)((cnt[e] + 255u) >> 8); so.init(nb, nN, G, c); }
    __device__ bool next(int i, Unit& u) const {
        if (!so.next(i, u)) return false;
        int b0 = 0, e = 0;
        for (; e < NEXP; ++e) { const int nb = (int)((cnt[e] + 255u) >> 8); if (u.pm < b0 + nb) break; b0 += nb; }
        u.e = e; u.pos0 = (u.pm - b0) * 256; const int rem = (int)cnt[e] - u.pos0; u.nvalid = rem < 256 ? rem : 256; return true;
    }
};

struct SrcPlain {
    static constexpr bool GATHER = false;
    const bf16_t* A; const bf16_t* Bt; int lda, K;
    __device__ __forceinline__ const char* a_base(const Unit& u) const { return (const char*)A + (size_t)u.pm * 256 * lda * 2; }
    __device__ __forceinline__ const char* b_base(const Unit& u) const { return (const char*)Bt + (size_t)u.pn * 256 * K * 2; }
    __device__ __forceinline__ unsigned a_off(const Unit&, int, int) const { return 0u; }
};
struct SrcMoe2 {
    static constexpr bool GATHER = false;
    const bf16_t* A; const bf16_t* Bt; int lda, K;
    __device__ __forceinline__ const char* a_base(const Unit& u) const { return (const char*)A + (size_t)u.pm * 256 * lda * 2; }
    __device__ __forceinline__ const char* b_base(const Unit& u) const { return (const char*)Bt + ((size_t)u.e * 1024 + (size_t)u.pn * 256) * K * 2; }
    __device__ __forceinline__ unsigned a_off(const Unit&, int, int) const { return 0u; }
};
struct SrcMoe1 {
    static constexpr bool GATHER = true;
    const bf16_t* A; const bf16_t* Bt; int lda, K; const int* etok;
    __device__ __forceinline__ const char* a_base(const Unit&) const { return (const char*)A; }
    __device__ __forceinline__ const char* b_base(const Unit& u) const { return (const char*)Bt + ((size_t)u.e * 1024 + (size_t)u.pn * 256) * K * 2; }
    __device__ __forceinline__ unsigned a_off(const Unit& u, int r, int c) const {
        const int tok = r < u.nvalid ? (etok[(size_t)u.e * CAPE + u.pos0 + r] >> 1) : 0; return (unsigned)(tok * lda + c) * 2u; }
};

struct EpiBf16 {
    static constexpr bool PERM = true;
    bf16_t* O; int ldc;
    __device__ __forceinline__ void operator()(const f32x4 (&acc)[2][2][4][2], const Unit& u, int wr, int wc, int fr, int fq) const {
        const int row0 = u.pm * BM + wr * 64 + fr, col0 = u.pn * BM + wc * 32 + 8 * fq;
#pragma unroll
        for (int ai = 0; ai < 2; ++ai)
#pragma unroll
            for (int m = 0; m < 4; ++m) { bf16_t* rowp = O + (size_t)(row0 + ai * HALF + m * 16) * ldc + col0;
#pragma unroll
                for (int bj = 0; bj < 2; ++bj) { const f32x4 v0 = acc[ai][bj][m][0], v1 = acc[ai][bj][m][1];
                    u32x4 w; w.x = cvt_pk_bf16(v0[0], v0[1]); w.y = cvt_pk_bf16(v0[2], v0[3]); w.z = cvt_pk_bf16(v1[0], v1[1]); w.w = cvt_pk_bf16(v1[2], v1[3]);
                    *(u32x4*)(rowp + bj * HALF) = w; } }
    }
};
struct EpiResid {
    static constexpr bool PERM = false;
    const float* xinL; float* outL; const float* xinC; float* outC; const float* mod;
    __device__ __forceinline__ void operator()(const f32x4 (&acc)[2][2][4][2], const Unit& u, int wr, int wc, int fr, int fq) const {
        const int trow = u.pm * BM; const bool lat = trow < TL;
        const float* xin = lat ? xinL + (size_t)trow * D : xinC + (size_t)(trow - TL) * D; float* out = lat ? outL + (size_t)trow * D : outC + (size_t)(trow - TL) * D;
        const float* g1 = mod + (size_t)(lat ? trow / SEQ : 32) * 6144 + 2048;
        const int row0 = wr * 64 + fr, col0 = u.pn * BM + wc * 32 + 4 * fq;
        f32x4 gv[2][2];
#pragma unroll
        for (int bj = 0; bj < 2; ++bj)
#pragma unroll
            for (int n = 0; n < 2; ++n) gv[bj][n] = *(const f32x4*)(g1 + col0 + bj * HALF + n * 16);
#pragma unroll
        for (int ai = 0; ai < 2; ++ai)
#pragma unroll
            for (int m = 0; m < 4; ++m) { const size_t ro = (size_t)(row0 + ai * HALF + m * 16) * D + col0;
#pragma unroll
                for (int bj = 0; bj < 2; ++bj)
#pragma unroll
                    for (int n = 0; n < 2; ++n) { const f32x4 xv = *(const f32x4*)(xin + ro + bj * HALF + n * 16); *(f32x4*)(out + ro + bj * HALF + n * 16) = xv + gv[bj][n] * acc[ai][bj][m][n]; } }
    }
};
__device__ __forceinline__ float silu_fast(float v) { return v * __builtin_amdgcn_rcpf(1.f + __builtin_amdgcn_exp2f(-1.4426950408889634f * v)); }
struct EpiMoeH {
    static constexpr bool PERM = true;
    bf16_t* H;
    __device__ __forceinline__ void operator()(const f32x4 (&acc)[2][2][4][2], const Unit& u, int wr, int wc, int fr, int fq) const {
        const int row0 = u.pm * BM + wr * 64 + fr, col0 = u.pn * HALF + wc * 32 + 8 * fq;
#pragma unroll
        for (int ai = 0; ai < 2; ++ai)
#pragma unroll
            for (int m = 0; m < 4; ++m) {
                float h[8];
#pragma unroll
                for (int n = 0; n < 2; ++n)
#pragma unroll
                    for (int q = 0; q < 4; ++q) h[n * 4 + q] = silu_fast(acc[ai][0][m][n][q]) * acc[ai][1][m][n][q];
                u32x4 w; w.x = cvt_pk_bf16(h[0], h[1]); w.y = cvt_pk_bf16(h[2], h[3]); w.z = cvt_pk_bf16(h[4], h[5]); w.w = cvt_pk_bf16(h[6], h[7]);
                *(u32x4*)(H + (size_t)(row0 + ai * HALF + m * 16) * EFF + col0) = w; }
    }
};
struct EpiMoeY {
    static constexpr bool PERM = true;
    bf16_t* Y; const int* etok;
    __device__ __forceinline__ void operator()(const f32x4 (&acc)[2][2][4][2], const Unit& u, int wr, int wc, int fr, int fq) const {
        const int col0 = u.pn * BM + wc * 32 + 8 * fq;
#pragma unroll
        for (int ai = 0; ai < 2; ++ai)
#pragma unroll
            for (int m = 0; m < 4; ++m) {
                const int r = ai * HALF + wr * 64 + m * 16 + fr;
                if (r < u.nvalid) {
                    const int dst = etok[(size_t)u.e * CAPE + u.pos0 + r];
                    bf16_t* rowp = Y + (size_t)dst * D + col0;
#pragma unroll
                    for (int bj = 0; bj < 2; ++bj) { const f32x4 v0 = acc[ai][bj][m][0], v1 = acc[ai][bj][m][1];
                        u32x4 w; w.x = cvt_pk_bf16(v0[0], v0[1]); w.y = cvt_pk_bf16(v0[2], v0[3]); w.z = cvt_pk_bf16(v1[0], v1[1]); w.w = cvt_pk_bf16(v1[2], v1[3]);
                        *(u32x4*)(rowp + bj * HALF) = w; } } }
    }
};

template <class Epi, class Sched, class Src>
__device__ __forceinline__ void gemm_phase(GP_LAS unsigned char* lds, const Sched& S, const Src& src, const Epi& E) {
    const int tid = ltid(), wid = __builtin_amdgcn_readfirstlane(tid >> 6), lane = tid & 63, wr = wid >> 2, wc = wid & 3, fr = lane & 15, fq = lane >> 4;
    const int K = src.K, nt = K / BK;
    int sR[2], sC[2]; unsigned voffA[2], voffB[2];
#pragma unroll
    for (int i = 0; i < 2; ++i) { int R, C; stage_rc(tid * 16 + i * 8192, R, C); sR[i] = R; sC[i] = C; const int Rb = Epi::PERM ? ((R & ~31) + perm32(R & 31)) : R;
        voffA[i] = (unsigned)(R * src.lda + C) * 2u; voffB[i] = (unsigned)(Rb * K + C) * 2u; }
    const size_t kstep = (size_t)(BK * 2);
    const size_t hstepA = (size_t)HALF * src.lda * 2, hstepB = (size_t)HALF * K * 2;
    const unsigned ldsw = (unsigned)wid * 1024u;
    const int aoff = lds_byte(wr * 64 + fr, fq * 8), boff = lds_byte(wc * 32 + fr, fq * 8);
#define GP_SA(b, h) (((b) * 2 + (h)) * HTB)
#define GP_SB(b, h) ((4 + (b) * 2 + (h)) * HTB)
#define GP_STAGE_A(b, h, kb, nx) do { _Pragma("unroll") for (int _i = 0; _i < 2; ++_i) { const char* _g; \
        if constexpr (Src::GATHER) _g = cA + (kb) + ((nx) ? nofs[h][_i] : cofs[h][_i]); \
        else _g = ((nx) ? nA : cA) + (size_t)(h) * hstepA + (kb) + voffA[_i]; \
        __builtin_amdgcn_global_load_lds((const unsigned*)_g, (GP_LAS unsigned*)(lds + GP_SA(b, h) + ldsw + _i * 8192), 16, 0, 0); } } while (0)
#define GP_STAGE_B(b, h, kb, nx) do { _Pragma("unroll") for (int _i = 0; _i < 2; ++_i) { const char* _g = ((nx) ? nB : cB) + (size_t)(h) * hstepB + (kb) + voffB[_i]; \
        __builtin_amdgcn_global_load_lds((const unsigned*)_g, (GP_LAS unsigned*)(lds + GP_SB(b, h) + ldsw + _i * 8192), 16, 0, 0); } } while (0)
#define GP_LDA(dst, b, h) do { _Pragma("unroll") for (int m = 0; m < 4; ++m) _Pragma("unroll") for (int k = 0; k < 2; ++k) dst[m][k] = *(const GP_LAS bf16x8*)(lds + GP_SA(b, h) + aoff + m * 2048 + k * 1024); } while (0)
#define GP_LDB(dst, b, h) do { _Pragma("unroll") for (int n = 0; n < 2; ++n) _Pragma("unroll") for (int k = 0; k < 2; ++k) dst[n][k] = *(const GP_LAS bf16x8*)(lds + GP_SB(b, h) + boff + n * 2048 + k * 1024); } while (0)
#define GP_MMA(ai, bj, At, Bt) do { __builtin_amdgcn_s_setprio(1); _Pragma("unroll") for (int m = 0; m < 4; ++m) _Pragma("unroll") for (int n = 0; n < 2; ++n) _Pragma("unroll") for (int k = 0; k < 2; ++k) \
        acc[ai][bj][m][n] = __builtin_amdgcn_mfma_f32_16x16x32_bf16(Bt[n][k], At[m][k], acc[ai][bj][m][n], 0, 0, 0); __builtin_amdgcn_s_setprio(0); } while (0)
#define GP_WAIT_V(n) asm volatile("s_waitcnt vmcnt(" #n ")" ::: "memory")
#define GP_WAIT_L(n) asm volatile("s_waitcnt lgkmcnt(" #n ")" ::: "memory")
#define GP_BAR __builtin_amdgcn_s_barrier()
#define GP_SCHED __builtin_amdgcn_sched_barrier(0)
    Unit cur, nxt; int ui = 0;
    if (!S.next(0, cur)) return;
    f32x4 acc[2][2][4][2];
#pragma unroll
    for (int a = 0; a < 2; ++a)
#pragma unroll
        for (int b = 0; b < 2; ++b)
#pragma unroll
            for (int m = 0; m < 4; ++m)
#pragma unroll
                for (int n = 0; n < 2; ++n) acc[a][b][m][n] = (f32x4){0.f, 0.f, 0.f, 0.f};
    bf16x8 At[4][2], B0[2][2], B1[2][2];
    const char* cA = src.a_base(cur); const char* cB = src.b_base(cur);
    const char* nA = cA; const char* nB = cB;
    unsigned cofs[2][2], nofs[2][2];
#pragma unroll
    for (int h = 0; h < 2; ++h)
#pragma unroll
        for (int i = 0; i < 2; ++i) { cofs[h][i] = Src::GATHER ? src.a_off(cur, h * HALF + sR[i], sC[i]) : 0u; nofs[h][i] = cofs[h][i]; }
    GP_STAGE_B(0, 0, 0, false); GP_STAGE_B(0, 1, 0, false); GP_STAGE_A(0, 0, 0, false); GP_STAGE_A(0, 1, 0, false);
    if (wr == 1) GP_BAR;
    GP_WAIT_V(2); GP_BAR;
    GP_STAGE_B(1, 0, kstep, false); GP_STAGE_A(1, 0, kstep, false); GP_STAGE_B(1, 1, kstep, false);
    GP_WAIT_V(6); GP_BAR;
    for (;;) {
        const bool has_next = S.next(ui + 1, nxt);
        if (has_next) { nA = src.a_base(nxt); nB = src.b_base(nxt);
            if constexpr (Src::GATHER) { const int t2 = ltid();
#pragma unroll
                for (int i = 0; i < 2; ++i) { int R, C; stage_rc(t2 * 16 + i * 8192, R, C);
#pragma unroll
                    for (int h = 0; h < 2; ++h) nofs[h][i] = src.a_off(nxt, h * HALF + R, C); } }
        } else { nA = cA; nB = cB;
#pragma unroll
            for (int h = 0; h < 2; ++h)
#pragma unroll
                for (int i = 0; i < 2; ++i) nofs[h][i] = cofs[h][i]; }
        for (int t = 0; t < nt; t += 2) {
            const bool last = (t == nt - 2);
            const size_t k1 = (size_t)(t + 1) * kstep, k2 = last ? 0 : (size_t)(t + 2) * kstep, k3 = k2 + kstep;
            GP_LDB(B0, 0, 0); GP_LDB(B1, 0, 1); GP_SCHED; GP_LDA(At, 0, 0); GP_STAGE_A(1, 1, k1, false);
            GP_WAIT_V(8); GP_WAIT_L(0); GP_BAR; GP_MMA(0, 0, At, B0); GP_MMA(0, 1, At, B1); GP_BAR; GP_SCHED;
            GP_LDA(At, 0, 1); GP_STAGE_B(0, 0, k2, last); GP_STAGE_B(0, 1, k2, last); GP_STAGE_A(0, 0, k2, last);
            GP_WAIT_V(8); GP_WAIT_L(0); GP_BAR; GP_MMA(1, 0, At, B0); GP_MMA(1, 1, At, B1); GP_BAR; GP_SCHED;
            GP_LDB(B0, 1, 0); GP_LDB(B1, 1, 1); GP_SCHED; GP_LDA(At, 1, 0); GP_STAGE_A(0, 1, k2, last);
            GP_WAIT_V(8); GP_WAIT_L(0); GP_BAR; GP_MMA(0, 0, At, B0); GP_MMA(0, 1, At, B1); GP_BAR; GP_SCHED;
            GP_LDA(At, 1, 1); GP_STAGE_B(1, 0, k3, last); GP_STAGE_B(1, 1, k3, last); GP_STAGE_A(1, 0, k3, last);
            GP_WAIT_V(8); GP_WAIT_L(0); GP_BAR; GP_MMA(1, 0, At, B0); GP_MMA(1, 1, At, B1); GP_BAR; GP_SCHED;
        }
        if (wr == 0) GP_BAR;
        E(acc, cur, wr, wc, fr, fq);
        if (!has_next) break;
#pragma unroll
        for (int a = 0; a < 2; ++a)
#pragma unroll
            for (int b = 0; b < 2; ++b)
#pragma unroll
                for (int m = 0; m < 4; ++m)
#pragma unroll
                    for (int n = 0; n < 2; ++n) acc[a][b][m][n] = (f32x4){0.f, 0.f, 0.f, 0.f};
        cur = nxt; cA = nA; cB = nB; ++ui;
#pragma unroll
        for (int h = 0; h < 2; ++h)
#pragma unroll
            for (int i = 0; i < 2; ++i) cofs[h][i] = nofs[h][i];
        if (wr == 1) GP_BAR;
    }
    GP_WAIT_V(0);
    GP_BAR;
#undef GP_SA
#undef GP_SB
#undef GP_STAGE_A
#undef GP_STAGE_B
#undef GP_LDA
#undef GP_LDB
#undef GP_MMA
#undef GP_WAIT_V
#undef GP_WAIT_L
#undef GP_BAR
#undef GP_SCHED
}
}

constexpr int LDS_BYTES = 147456;

DI void phase_inproj(CPARAMS p, LAS unsigned char* lds) {
    gp::StaticOrder S; S.init(T / 256, ZW / 256, gridDim.x, blockIdx.x);
    gp::SrcPlain src{(const bf16_t*)(p.ws + WS_ACT), (const bf16_t*)(p.ws + WS_WIN_T), D, D};
    gp::EpiBf16 E{(bf16_t*)(p.ws + WS_Z), ZW};
    gp::gemm_phase(lds, S, src, E);
}
DI void phase_outproj(CPARAMS p, int l, LAS unsigned char* lds) {
    gp::StaticOrder S; S.init((l == 0 ? T : TL) / 256, D / 256, gridDim.x, blockIdx.x);
    gp::SrcPlain src{(const bf16_t*)(p.ws + WS_ACT), (const bf16_t*)(p.ws + WS_WOUT_T), D, D};
    gp::EpiResid E{l == 0 ? p.in[I_X] : p.out, p.out, p.in[I_CTX], (float*)(p.ws + WS_XC), (const float*)(p.ws + WS_MOD) + (size_t)l * 33 * 6144};
    gp::gemm_phase(lds, S, src, E);
}
DI void phase_moe1(CPARAMS p, int l, LAS unsigned char* lds) {
    gp::MoeOrder S; S.init((const unsigned*)(p.ws + WS_CTL) + CW_COUNT + l * 32, 4, gridDim.x, blockIdx.x);
    gp::SrcMoe1 src{(const bf16_t*)(p.ws + WS_ACT), (const bf16_t*)(p.ws + WS_W13_T), D, D, (const int*)(p.ws + WS_ETOK)};
    gp::EpiMoeH E{(bf16_t*)(p.ws + WS_H)};
    gp::gemm_phase(lds, S, src, E);
}
DI void phase_moe2(CPARAMS p, int l, LAS unsigned char* lds) {
    gp::MoeOrder S; S.init((const unsigned*)(p.ws + WS_CTL) + CW_COUNT + l * 32, 4, gridDim.x, blockIdx.x);
    gp::SrcMoe2 src{(const bf16_t*)(p.ws + WS_H), (const bf16_t*)(p.ws + WS_W2_T), EFF, EFF};
    gp::EpiMoeY E{(bf16_t*)(p.ws + WS_YTOK), (const int*)(p.ws + WS_ETOK)};
    gp::gemm_phase(lds, S, src, E);
}


typedef __bf16 bf16x2_t __attribute__((ext_vector_type(2)));
typedef float f32x2_t __attribute__((ext_vector_type(2)));
DI unsigned pk_bf16(float a, float b) { f32x2_t v = {a, b}; bf16x2_t r = __builtin_convertvector(v, bf16x2_t); return __builtin_bit_cast(unsigned, r); }
DI bf16x8 pack8(const f32x16& x, int s) { u32x4 p; p.x = pk_bf16(x[8 * s], x[8 * s + 1]); p.y = pk_bf16(x[8 * s + 2], x[8 * s + 3]); p.z = pk_bf16(x[8 * s + 4], x[8 * s + 5]); p.w = pk_bf16(x[8 * s + 6], x[8 * s + 7]); return __builtin_bit_cast(bf16x8, p); }
#define MFMA32(a, b, c) __builtin_amdgcn_mfma_f32_32x32x16_bf16((a), (b), (c), 0, 0, 0)
constexpr int AT_KP = 208, AT_VP = 264, AT_KBYTES = 128 * AT_KP, AT_VBYTES = 64 * AT_VP, AT_BUF = AT_KBYTES + AT_VBYTES;

DI void attn_unit(CPARAMS p, int bh, int q0, int key0, int nkt, LAS unsigned char* lds) {
    const int tid = ltid(), lane = tid & 63, wid = tid >> 6, h = lane >> 5, c = lane & 31;
    const bf16_t* Qg = (const bf16_t*)(p.ws + WS_Q) + ((size_t)bh * PALL + q0 + wid * 32 + c) * 96;
    const bf16_t* Kg = (const bf16_t*)(p.ws + WS_K) + ((size_t)bh * PALL + key0) * 96;
    const bf16_t* Vg = (const bf16_t*)(p.ws + WS_VT) + (size_t)bh * 64 * PALL + key0;
    bf16x8 qf[6];
#pragma unroll
    for (int s = 0; s < 6; ++s) qf[s] = *(const bf16x8*)(Qg + 16 * s + 8 * h);
    f32x16 o[2];
#pragma unroll
    for (int i = 0; i < 16; ++i) { o[0][i] = 0.f; o[1][i] = 0.f; }
    float m = -1e30f, lsum = 0.f;
    u32x4 kreg[3], vreg[2];
    int krow[3], kpc[3], vd[2], vpc[2];
#pragma unroll
    for (int j = 0; j < 3; ++j) { const int pi = tid + 512 * j; krow[j] = pi / 12; kpc[j] = pi % 12; }
#pragma unroll
    for (int j = 0; j < 2; ++j) { const int pi = tid + 512 * j; vd[j] = pi >> 4; vpc[j] = pi & 15; }
#define AT_LOAD(t) do { _Pragma("unroll") for (int j = 0; j < 3; ++j) kreg[j] = *(const u32x4*)(Kg + (size_t)(128 * (t) + krow[j]) * 96 + kpc[j] * 8); \
        _Pragma("unroll") for (int j = 0; j < 2; ++j) vreg[j] = *(const u32x4*)(Vg + (size_t)vd[j] * PALL + 128 * (t) + vpc[j] * 8); } while (0)
#define AT_STORE(bs) do { LAS unsigned char* _b = lds + (bs) * AT_BUF; \
        _Pragma("unroll") for (int j = 0; j < 3; ++j) *(LAS u32x4*)(_b + krow[j] * AT_KP + kpc[j] * 16) = kreg[j]; \
        _Pragma("unroll") for (int j = 0; j < 2; ++j) { LAS unsigned char* _v = _b + AT_KBYTES + vd[j] * AT_VP + vpc[j] * 16; u32x2 lo = {vreg[j].x, vreg[j].y}, hi = {vreg[j].z, vreg[j].w}; *(LAS u32x2*)_v = lo; *(LAS u32x2*)(_v + 8) = hi; } } while (0)
    AT_LOAD(0); AT_STORE(0);
    __syncthreads();
    for (int t = 0; t < nkt; ++t) {
        if (t + 1 < nkt) AT_LOAD(t + 1);
        LAS unsigned char* base = lds + (t & 1) * AT_BUF;
        f32x16 st[4];
#pragma unroll
        for (int kt = 0; kt < 4; ++kt) {
#pragma unroll
            for (int i = 0; i < 16; ++i) st[kt][i] = 0.f;
#pragma unroll
            for (int s = 0; s < 6; ++s) { const bf16x8 a = *(const LAS bf16x8*)(base + (32 * kt + c) * AT_KP + (16 * s + 8 * h) * 2); st[kt] = MFMA32(a, qf[s], st[kt]); }
        }
        float mx = st[0][0];
#pragma unroll
        for (int kt = 0; kt < 4; ++kt)
#pragma unroll
            for (int i = 0; i < 16; ++i) mx = fmaxf(mx, st[kt][i]);
        mx = fmaxf(mx, __shfl_xor(mx, 32));
        const float mn = fmaxf(m, mx), alpha = __builtin_amdgcn_exp2f(m - mn); m = mn;
        float ps = 0.f;
#pragma unroll
        for (int kt = 0; kt < 4; ++kt)
#pragma unroll
            for (int i = 0; i < 16; ++i) { const float e = __builtin_amdgcn_exp2f(st[kt][i] - mn); st[kt][i] = e; ps += e; }
        lsum = lsum * alpha + ps;
#pragma unroll
        for (int i = 0; i < 16; ++i) { o[0][i] *= alpha; o[1][i] *= alpha; }
#pragma unroll
        for (int kt = 0; kt < 4; ++kt)
#pragma unroll
            for (int s2 = 0; s2 < 2; ++s2) {
                const bf16x8 pb = pack8(st[kt], s2);
#pragma unroll
                for (int dt = 0; dt < 2; ++dt) {
                    const LAS unsigned char* vb = base + AT_KBYTES + (32 * dt + c) * AT_VP + (32 * kt + 16 * s2 + 4 * h) * 2;
                    const u32x2 lo = *(const LAS u32x2*)vb, hi = *(const LAS u32x2*)(vb + 16);
                    u32x4 av = {lo.x, lo.y, hi.x, hi.y};
                    o[dt] = MFMA32(__builtin_bit_cast(bf16x8, av), pb, o[dt]);
                }
            }
        if (t + 1 < nkt) AT_STORE((t + 1) & 1);
        __syncthreads();
    }
#undef AT_LOAD
#undef AT_STORE
    const float inv = 1.f / (lsum + __shfl_xor(lsum, 32));
    const int b = bh >> 2, hh = bh & 3, qpos = q0 + wid * 32 + c;
    const int tok = qpos < SEQ ? b * SEQ + qpos : TL + b * CTXL + (qpos - SEQ);
    bf16_t* YA = (bf16_t*)(p.ws + WS_YA) + (size_t)tok * 256 + hh * 64;
#pragma unroll
    for (int dt = 0; dt < 2; ++dt)
#pragma unroll
        for (int g = 0; g < 4; ++g) { u32x2 w; w.x = pk_bf16(o[dt][4 * g] * inv, o[dt][4 * g + 1] * inv); w.y = pk_bf16(o[dt][4 * g + 2] * inv, o[dt][4 * g + 3] * inv); *(u32x2*)(YA + 32 * dt + 8 * g + 4 * h) = w; }
}
DI void phase_attn(CPARAMS p, int l, LAS unsigned char* lds) {
    const int cI = blockIdx.x, xcd = cI & 7, j = cI >> 3;
    for (int r = 0; r < 4; ++r) { const int bh = r * 32 + xcd * 4 + (j >> 3), qb = j & 7; attn_unit(p, bh, qb * 256, 0, 18, lds); }
    if (l == 0 && cI < 128) attn_unit(p, cI, SEQ, SEQ, 2, lds);
}


constexpr int RT_QP = 144, RT_TP = 272;
constexpr int RT_QS = 0, RT_KS = 128 * RT_QP, RT_KT = 2 * 128 * RT_QP, RT_VT = RT_KT + 64 * RT_TP, RT_ST = RT_VT + 64 * RT_TP, RT_END = RT_ST + 64 * RT_QP;
DI int ret_tok(int b, int dir, int ci, int j) {
    if (ci < 2) { const int cp = 128 * ci + j; return TL + b * CTXL + (dir ? CTXL - 1 - cp : cp); }
    const int tp = 128 * (ci - 2) + j; return b * SEQ + (dir ? SEQ - 1 - tp : tp);
}
DI void ret_unit(CPARAMS p, int l, int b, int hh, int dir, LAS unsigned char* lds) {
    const int tid = ltid(), lane = tid & 63, wid = tid >> 6, h = lane >> 5, c = lane & 31;
    const float lg = p.in[I_RLG][(l * 2 + dir) * 4 + hh];
    const int jp = lane, dg = wid;
    const float qs[2] = {expf(lg * (float)(2 * jp)), expf(lg * (float)(2 * jp + 1))};
    const float ks[2] = {expf(-lg * (float)(2 * jp)) * 0.125f, expf(-lg * (float)(2 * jp + 1)) * 0.125f};
    const float gam = expf(lg), g127 = expf(lg * 127.f), g128 = expf(lg * 128.f);
    const bf16_t* Z = (const bf16_t*)(p.ws + WS_Z);
    bf16_t* OUT = (bf16_t*)(p.ws + (dir ? WS_OB : WS_OF));
    __syncthreads();
    for (int i = tid; i < 64 * RT_QP / 4; i += 512) ((LAS unsigned*)(lds + RT_ST))[i] = 0u;
    f32x16 sacc;
#pragma unroll
    for (int i = 0; i < 16; ++i) sacc[i] = 0.f;
    u32x4 rq[2], rk[2], rv[2];
#define RT_LOAD(ci) do { _Pragma("unroll") for (int r = 0; r < 2; ++r) { const bf16_t* row = Z + (size_t)ret_tok(b, dir, (ci), 2 * jp + r) * ZW + hh * 64 + 8 * dg; \
        rq[r] = *(const u32x4*)(row + ZC_RQ); rk[r] = *(const u32x4*)(row + ZC_RK); rv[r] = *(const u32x4*)(row + ZC_RV); } } while (0)
#define RT_STORE() do { u32x4 nk[2]; \
        _Pragma("unroll") for (int r = 0; r < 2; ++r) { u32x4 nq; \
            _Pragma("unroll") for (int d4 = 0; d4 < 4; ++d4) { const unsigned wq = rq[r][d4], wk = rk[r][d4]; \
                nq[d4] = pk_bf16(__uint_as_float(wq << 16) * qs[r], __uint_as_float(wq & 0xffff0000u) * qs[r]); \
                nk[r][d4] = pk_bf16(__uint_as_float(wk << 16) * ks[r], __uint_as_float(wk & 0xffff0000u) * ks[r]); } \
            *(LAS u32x4*)(lds + RT_QS + (2 * jp + r) * RT_QP + dg * 16) = nq; *(LAS u32x4*)(lds + RT_KS + (2 * jp + r) * RT_QP + dg * 16) = nk[r]; } \
        _Pragma("unroll") for (int d4 = 0; d4 < 4; ++d4) { \
            *(LAS unsigned*)(lds + RT_KT + (8 * dg + 2 * d4) * RT_TP + jp * 4) = (nk[0][d4] & 0xffffu) | (nk[1][d4] << 16); \
            *(LAS unsigned*)(lds + RT_KT + (8 * dg + 2 * d4 + 1) * RT_TP + jp * 4) = (nk[0][d4] >> 16) | (nk[1][d4] & 0xffff0000u); \
            *(LAS unsigned*)(lds + RT_VT + (8 * dg + 2 * d4) * RT_TP + jp * 4) = (rv[0][d4] & 0xffffu) | (rv[1][d4] << 16); \
            *(LAS unsigned*)(lds + RT_VT + (8 * dg + 2 * d4 + 1) * RT_TP + jp * 4) = (rv[0][d4] >> 16) | (rv[1][d4] & 0xffff0000u); } } while (0)
    RT_LOAD(0); RT_STORE();
    __syncthreads();
    const int I = wid >> 1, dt = wid & 1;
    for (int ci = 0; ci < 18; ++ci) {
        if (ci + 1 < 18) RT_LOAD(ci + 1);
        const bool doOut = (ci >= 2) || (l == 0);
        if (doOut) {
            bf16x8 bq[4];
#pragma unroll
            for (int s = 0; s < 4; ++s) bq[s] = *(const LAS bf16x8*)(lds + RT_QS + (32 * I + c) * RT_QP + (16 * s + 8 * h) * 2);
            f32x16 at[4];
#pragma unroll
            for (int J = 0; J < 4; ++J) {
#pragma unroll
                for (int i = 0; i < 16; ++i) at[J][i] = 0.f;
                if (J <= I) {
#pragma unroll
                    for (int s = 0; s < 4; ++s) { const bf16x8 a = *(const LAS bf16x8*)(lds + RT_KS + (32 * J + c) * RT_QP + (16 * s + 8 * h) * 2); at[J] = MFMA32(a, bq[s], at[J]); }
                    if (J == I) {
#pragma unroll
                        for (int r = 0; r < 16; ++r) { const int kr = (r & 3) + 8 * (r >> 2) + 4 * h; if (kr > c) at[J][r] = 0.f; }
                    }
                }
            }
            f32x16 o;
#pragma unroll
            for (int i = 0; i < 16; ++i) o[i] = 0.f;
#pragma unroll
            for (int J = 0; J < 4; ++J) {
                if (J <= I) {
#pragma unroll
                    for (int s2 = 0; s2 < 2; ++s2) {
                        const bf16x8 pb = pack8(at[J], s2);
                        const LAS unsigned char* vb = lds + RT_VT + (32 * dt + c) * RT_TP + (32 * J + 16 * s2 + 4 * h) * 2;
                        const u32x2 lo = *(const LAS u32x2*)vb, hi = *(const LAS u32x2*)(vb + 16);
                        u32x4 av = {lo.x, lo.y, hi.x, hi.y};
                        o = MFMA32(__builtin_bit_cast(bf16x8, av), pb, o);
                    }
                }
            }
            f32x16 cr;
#pragma unroll
            for (int i = 0; i < 16; ++i) cr[i] = 0.f;
#pragma unroll
            for (int s = 0; s < 4; ++s) { const bf16x8 a = *(const LAS bf16x8*)(lds + RT_ST + (32 * dt + c) * RT_QP + (16 * s + 8 * h) * 2); cr = MFMA32(a, bq[s], cr); }
            bf16_t* dst = OUT + (size_t)ret_tok(b, dir, ci, 32 * I + c) * 256 + hh * 64 + 32 * dt;
#pragma unroll
            for (int g = 0; g < 4; ++g) { u32x2 w; w.x = pk_bf16(o[4 * g] + gam * cr[4 * g], o[4 * g + 1] + gam * cr[4 * g + 1]); w.y = pk_bf16(o[4 * g + 2] + gam * cr[4 * g + 2], o[4 * g + 3] + gam * cr[4 * g + 3]); *(u32x2*)(dst + 8 * g + 4 * h) = w; }
        }
        if (wid < 4) {
            const int dtl = wid & 1, kdt = wid >> 1;
            f32x16 upd;
#pragma unroll
            for (int i = 0; i < 16; ++i) upd[i] = 0.f;
#pragma unroll
            for (int s = 0; s < 8; ++s) { const bf16x8 a = *(const LAS bf16x8*)(lds + RT_VT + (32 * dtl + c) * RT_TP + (16 * s + 8 * h) * 2); const bf16x8 bk = *(const LAS bf16x8*)(lds + RT_KT + (32 * kdt + c) * RT_TP + (16 * s + 8 * h) * 2); upd = MFMA32(a, bk, upd); }
#pragma unroll
            for (int i = 0; i < 16; ++i) sacc[i] = g128 * sacc[i] + g127 * upd[i];
        }
        __syncthreads();
        if (wid < 4) {
            const int dtl = wid & 1, kdt = wid >> 1;
#pragma unroll
            for (int r = 0; r < 16; ++r) { const int d = 32 * dtl + (r & 3) + 8 * (r >> 2) + 4 * h; *(LAS bf16_t*)(lds + RT_ST + d * RT_QP + (32 * kdt + c) * 2) = f2bf(sacc[r]); }
        }
        if (ci + 1 < 18) RT_STORE();
        __syncthreads();
    }
#undef RT_LOAD
#undef RT_STORE
}
DI void phase_ret(CPARAMS p, int l, LAS unsigned char* lds) { const int u = blockIdx.x; if (u < 256) ret_unit(p, l, u >> 3, (u >> 1) & 3, u & 1, lds); }


constexpr int HP_PITCH = 1032;
DI void hyprep_tile(CPARAMS p, int l, int tokbase, int L, int t0, bf16_t* dstS  , int b, LAS unsigned char* lds) {
    const int tid = ltid(), lane = tid & 63, wid = tid >> 6;
    const bf16_t* Z = (const bf16_t*)(p.ws + WS_Z); const float* cw = p.in[I_HCW] + (size_t)l * 3 * 768; const float* cb = p.in[I_HCB] + l * 768;
    __syncthreads();
    for (int pi = tid; pi < 66 * 64; pi += 512) {
        const int r = pi >> 6, pc = pi & 63; const int t = t0 - 1 + r;
        u32x4 v = {0u, 0u, 0u, 0u};
        if (t >= 0 && t < L) v = *(const u32x4*)(Z + (size_t)(tokbase + t) * ZW + ZC_HX1 + pc * 8);
        LAS unsigned char* d = lds + r * HP_PITCH + pc * 16; u32x2 lo = {v.x, v.y}, hi = {v.z, v.w}; *(LAS u32x2*)d = lo; *(LAS u32x2*)(d + 8) = hi;
    }
    __syncthreads();
    for (int k = 0; k < 32; ++k) {
        const int ch = wid * 32 + k;
        float x1 = cb[256 + ch], vv = cb[512 + ch];
#pragma unroll
        for (int j = 0; j < 3; ++j) {
            const float a = bf2f(*(const LAS bf16_t*)(lds + (lane + j) * HP_PITCH + ch * 2)), bq = bf2f(*(const LAS bf16_t*)(lds + (lane + j) * HP_PITCH + 512 + ch * 2));
            x1 += cw[j * 768 + 256 + ch] * a; vv += cw[j * 768 + 512 + ch] * bq;
        }
        dstS[((size_t)ch * NB + b) * L + t0 + lane] = f2bf(x1 * vv);
    }
}
DI void phase_hyprep(CPARAMS p, int l, LAS unsigned char* lds) {
    const int ntl = NB * (SEQ / 64), ntc = l == 0 ? NB * (CTXL / 64) : 0;
    for (int u = blockIdx.x; u < ntl + ntc; u += gridDim.x) {
        if (u < ntl) { const int b = u / (SEQ / 64), tt = u % (SEQ / 64); hyprep_tile(p, l, b * SEQ, SEQ, tt * 64, (bf16_t*)(p.ws + WS_SL), b, lds); }
        else { const int v = u - ntl, b = v / (CTXL / 64), tt = v % (CTXL / 64); hyprep_tile(p, l, TL + b * CTXL, CTXL, tt * 64, (bf16_t*)(p.ws + WS_SC), b, lds); }
    }
}
template <int L, int TPW>
DI void hyena_unit(const bf16_t* Sg, const bf16_t* Gg, bf16_t* Yg, LAS unsigned char* lds) {
    constexpr int PITCH = 2 * L + 16, NK = L / 16, GOFF = 32 * PITCH;
    const int tid = ltid(), lane = tid & 63, wid = tid >> 6, h = lane >> 5, c = lane & 31;
    __syncthreads();
    for (int pi = tid; pi < 32 * (L / 8); pi += 512) { const int b = pi / (L / 8), pc = pi % (L / 8); *(LAS u32x4*)(lds + b * PITCH + pc * 16) = *(const u32x4*)(Sg + (size_t)b * L + pc * 8); }
    for (int pi = tid; pi < (2 * L) / 8; pi += 512) *(LAS u32x4*)(lds + GOFF + pi * 16) = *(const u32x4*)(Gg + pi * 8);
    __syncthreads();
    f32x16 acc[TPW];
#pragma unroll
    for (int a = 0; a < TPW; ++a)
#pragma unroll
        for (int i = 0; i < 16; ++i) acc[a][i] = 0.f;
    const int a0 = wid * TPW;
    if (a0 * 32 < L) {
        for (int q = -2 * (a0 + TPW - 1); q <= NK - 1 - 2 * a0; ++q) {
            const int idx0 = L + 16 * q + 8 * h - c;
            const LAS bf16_t* gp_ = (const LAS bf16_t*)(lds + GOFF) + idx0;
            u32x4 bw;
            bw.x = (unsigned)gp_[0] | ((unsigned)gp_[1] << 16); bw.y = (unsigned)gp_[2] | ((unsigned)gp_[3] << 16); bw.z = (unsigned)gp_[4] | ((unsigned)gp_[5] << 16); bw.w = (unsigned)gp_[6] | ((unsigned)gp_[7] << 16);
            const bf16x8 bfrag = __builtin_bit_cast(bf16x8, bw);
#pragma unroll
            for (int ai = 0; ai < TPW; ++ai) {
                const int ks = q + 2 * (a0 + ai);
                if (ks >= 0 && ks < NK) { const bf16x8 a = *(const LAS bf16x8*)(lds + c * PITCH + (16 * ks + 8 * h) * 2); acc[ai] = MFMA32(a, bfrag, acc[ai]); }
            }
        }
    }
    __syncthreads();
    if (a0 * 32 < L) {
#pragma unroll
        for (int ai = 0; ai < TPW; ++ai)
#pragma unroll
            for (int r = 0; r < 16; ++r) { const int bb = (r & 3) + 8 * (r >> 2) + 4 * h; *(LAS bf16_t*)(lds + bb * PITCH + (32 * (a0 + ai) + c) * 2) = f2bf(acc[ai][r]); }
    }
    __syncthreads();
    for (int pi = tid; pi < 32 * (L / 8); pi += 512) { const int b = pi / (L / 8), pc = pi % (L / 8); *(u32x4*)(Yg + (size_t)b * L + pc * 8) = *(const LAS u32x4*)(lds + b * PITCH + pc * 16); }
}
DI void phase_hyena(CPARAMS p, int l, LAS unsigned char* lds) {
    const int ch = blockIdx.x; if (ch >= 256) return;
    hyena_unit<SEQ, 8>((const bf16_t*)(p.ws + WS_SL) + (size_t)ch * NB * SEQ, (const bf16_t*)(p.ws + WS_G2048) + (size_t)ch * 2 * SEQ, (bf16_t*)(p.ws + WS_YT) + (size_t)ch * NB * SEQ, lds);
    if (l == 0) hyena_unit<CTXL, 1>((const bf16_t*)(p.ws + WS_SC) + (size_t)ch * NB * CTXL, (const bf16_t*)(p.ws + WS_G256) + (size_t)ch * 2 * CTXL, (bf16_t*)(p.ws + WS_YTC) + (size_t)ch * NB * CTXL, lds);
}


constexpr int LR_XP = 144, LR_XT = 0, LR_XTB = 256 * LR_XP, LR_COMP = 2 * LR_XTB, LR_CARRY = LR_COMP + 8 * 64 * 8, LR_CW = LR_CARRY + 2 * 64 * 4, LR_W = LR_CW + 5 * 64 * 4, LR_END = LR_W + 2 * 64 * LR_XP;
DI void lru_unit(CPARAMS p, int l, int b, int blk, int dir, LAS unsigned char* lds) {
    const int tid = ltid(), lane = tid & 63, wid = tid >> 6, h = lane >> 5, c = lane & 31;
    const bf16_t* Z = (const bf16_t*)(p.ws + WS_Z);
    const bf16_t* WT = (const bf16_t*)(p.ws + WS_LRUW_T);
    bf16_t* OUT = (bf16_t*)(p.ws + (dir ? WS_HB : WS_HF));
    __syncthreads();
    for (int i = tid; i < 5 * 64; i += 512) { const int jj = i >> 6, e = i & 63; ((LAS float*)(lds + LR_CW))[i] = jj < 4 ? p.in[I_LCW][((size_t)l * 4 + jj) * 256 + blk * 64 + e] : p.in[I_LCB][l * 256 + blk * 64 + e]; }
    if (tid < 64) ((LAS float*)(lds + LR_CARRY))[tid] = 0.f;
    for (int pi = tid; pi < 2 * 64 * 8; pi += 512) { const int gate = pi >> 9, e = (pi >> 3) & 63, pc = pi & 7;
        *(LAS u32x4*)(lds + LR_W + (gate * 64 + e) * LR_XP + pc * 16) = *(const u32x4*)(WT + (size_t)(((dir * 2 + gate) * 4 + blk) * 64 + e) * 64 + pc * 8); }
    float ba[2], bx[2], sp8[2];
#pragma unroll
    for (int et = 0; et < 2; ++et) {
        const int e = 32 * et + c;
        const int pi = (l * 2 + dir) * 256 + blk * 64 + e;
        ba[et] = p.in[I_LBA][pi]; bx[et] = p.in[I_LBX][pi]; sp8[et] = -8.f * 1.4426950408889634f * log1pf(expf(-p.in[I_LLAM][pi]));
    }
    const int tq = tid >> 3, cg = tid & 7;
    u32x4 xr[7];
#define LR_GEOM(t) const int _ctx = ((t) == 0); const int L_ = _ctx ? CTXL : SEQ; const int tokbase = _ctx ? TL + b * CTXL : b * SEQ; const int tt_ = _ctx ? 0 : (t) - 1; \
        const int pbase = 256 * tt_, pend = L_ - 1 - 256 * tt_;
#define LR_LOAD(t) do { LR_GEOM(t) const int plo = dir ? pend - 4 * tq - 3 : pbase + 4 * tq; \
        _Pragma("unroll") for (int r = 0; r < 7; ++r) { const int pp = plo - 2 + r; u32x4 v = {0u, 0u, 0u, 0u}; if (pp >= 0 && pp < L_) v = *(const u32x4*)(Z + (size_t)(tokbase + pp) * ZW + ZC_LX + blk * 64 + 8 * cg); xr[r] = v; } } while (0)
#define LR_CONV(t, buf) do { LR_GEOM(t) const int plo = dir ? pend - 4 * tq - 3 : pbase + 4 * tq; (void)L_; (void)tokbase; \
        const LAS float* cwl = (const LAS float*)(lds + LR_CW); \
        _Pragma("unroll") for (int i = 0; i < 4; ++i) { float acc8[8]; \
            _Pragma("unroll") for (int q = 0; q < 8; ++q) acc8[q] = cwl[4 * 64 + 8 * cg + q]; \
            _Pragma("unroll") for (int jj = 0; jj < 4; ++jj) { const u32x4 xv = xr[i + jj]; \
                _Pragma("unroll") for (int d4 = 0; d4 < 4; ++d4) { acc8[2 * d4] += cwl[jj * 64 + 8 * cg + 2 * d4] * __uint_as_float(xv[d4] << 16); acc8[2 * d4 + 1] += cwl[jj * 64 + 8 * cg + 2 * d4 + 1] * __uint_as_float(xv[d4] & 0xffff0000u); } } \
            const int pp = plo + i; const int j = dir ? pend - pp : pp - pbase; \
            u32x4 w; w.x = pk_bf16(acc8[0], acc8[1]); w.y = pk_bf16(acc8[2], acc8[3]); w.z = pk_bf16(acc8[4], acc8[5]); w.w = pk_bf16(acc8[6], acc8[7]); \
            *(LAS u32x4*)(lds + (buf) * LR_XTB + j * LR_XP + cg * 16) = w; } } while (0)
    __syncthreads();
    LR_LOAD(0); LR_CONV(0, 0);
    __syncthreads();
    for (int t = 0; t < 9; ++t) {
        if (t + 1 < 9) LR_LOAD(t + 1);
        LAS unsigned char* xb = lds + (t & 1) * LR_XTB;
        f32x16 ga[2], gx[2];
#pragma unroll
        for (int et = 0; et < 2; ++et)
#pragma unroll
            for (int i = 0; i < 16; ++i) { ga[et][i] = 0.f; gx[et][i] = 0.f; }
#pragma unroll
        for (int s2 = 0; s2 < 4; ++s2) {
            const bf16x8 a = *(const LAS bf16x8*)(xb + (32 * wid + c) * LR_XP + (16 * s2 + 8 * h) * 2);
#pragma unroll
            for (int et = 0; et < 2; ++et) {
                const bf16x8 wa_ = *(const LAS bf16x8*)(lds + LR_W + (32 * et + c) * LR_XP + (16 * s2 + 8 * h) * 2), wx_ = *(const LAS bf16x8*)(lds + LR_W + (64 + 32 * et + c) * LR_XP + (16 * s2 + 8 * h) * 2);
                ga[et] = MFMA32(a, wa_, ga[et]); gx[et] = MFMA32(a, wx_, gx[et]); }
        }
#pragma unroll
        for (int et = 0; et < 2; ++et)
#pragma unroll
            for (int r = 0; r < 16; ++r) {
                const int j = 32 * wid + (r & 3) + 8 * (r >> 2) + 4 * h;
                const float xv = bf2f(*(const LAS bf16_t*)(xb + j * LR_XP + (32 * et + c) * 2));
                const float rr = __builtin_amdgcn_rcpf(1.f + __builtin_amdgcn_exp2f(-1.4426950408889634f * (ga[et][r] + ba[et])));
                const float ig = __builtin_amdgcn_rcpf(1.f + __builtin_amdgcn_exp2f(-1.4426950408889634f * (gx[et][r] + bx[et])));
                const float av = __builtin_amdgcn_exp2f(sp8[et] * rr);
                ga[et][r] = av; gx[et][r] = __builtin_amdgcn_sqrtf(fmaxf(1.f - av * av, 0.f)) * (ig * xv);
            }
        float PA[2][4], PB[2][4], A0[2][4], B0[2][4];
#pragma unroll
        for (int et = 0; et < 2; ++et) {
            float WA = 1.f, WB = 0.f;
#pragma unroll
            for (int g = 0; g < 4; ++g) {
                float Ag = ga[et][4 * g], Bg = gx[et][4 * g];
#pragma unroll
                for (int i = 1; i < 4; ++i) { Bg = Bg * ga[et][4 * g + i] + gx[et][4 * g + i]; Ag *= ga[et][4 * g + i]; }
                const float oA = __shfl_xor(Ag, 32), oB = __shfl_xor(Bg, 32);
                const float a0 = h ? oA : Ag, b0 = h ? oB : Bg, a1 = h ? Ag : oA, b1 = h ? Bg : oB;
                A0[et][g] = a0; B0[et][g] = b0; PA[et][g] = a0 * a1; PB[et][g] = b0 * a1 + b1;
                WB = WB * PA[et][g] + PB[et][g]; WA *= PA[et][g];
            }
            if (h == 0) { LAS float* cp = (LAS float*)(lds + LR_COMP) + (wid * 64 + 32 * et + c) * 2; cp[0] = WA; cp[1] = WB; }
        }
        if (t + 1 < 9) LR_CONV(t + 1, (t + 1) & 1);
        __syncthreads();
        {
            LR_GEOM(t) (void)pbase; (void)pend;
#pragma unroll
            for (int et = 0; et < 2; ++et) {
                const int e = 32 * et + c;
                float hin = ((const LAS float*)(lds + LR_CARRY))[(t & 1) * 64 + e];
                float wa7 = 1.f, wb7 = 0.f;
                for (int w2 = 0; w2 < 8; ++w2) { const LAS float* cp = (const LAS float*)(lds + LR_COMP) + (w2 * 64 + e) * 2; const float ca = cp[0], cb2 = cp[1]; if (w2 < wid) hin = hin * ca + cb2; if (w2 == wid) { wa7 = ca; wb7 = cb2; } }
                if (wid == 7 && h == 0) ((LAS float*)(lds + LR_CARRY))[((t + 1) & 1) * 64 + e] = hin * wa7 + wb7;
                float sg = hin;
#pragma unroll
                for (int g = 0; g < 4; ++g) {
                    float hh = h ? sg * A0[et][g] + B0[et][g] : sg;
#pragma unroll
                    for (int i = 0; i < 4; ++i) {
                        hh = ga[et][4 * g + i] * hh + gx[et][4 * g + i];
                        const int j = 32 * wid + 8 * g + 4 * h + i; const int pp = dir ? (L_ - 1 - 256 * tt_) - j : 256 * tt_ + j;
                        OUT[(size_t)(tokbase + pp) * 256 + blk * 64 + e] = f2bf(hh);
                    }
                    sg = sg * PA[et][g] + PB[et][g];
                }
            }
        }
        __syncthreads();
    }
#undef LR_GEOM
#undef LR_LOAD
#undef LR_CONV
}
DI void phase_lru(CPARAMS p, int l, LAS unsigned char* lds) { const int u = blockIdx.x; if (u < 256) lru_unit(p, l, u >> 3, (u >> 1) & 3, u & 1, lds); }


DI float sq8(const bf16x8& v) { float s = 0.f;
#pragma unroll
    for (int i = 0; i < 8; ++i) { const float f = __uint_as_float(((unsigned)(unsigned short)v[i]) << 16); s += f * f; }
    return s; }
DI void mprep_task(CPARAMS p, int l, int tt, int hh) {
    const int lane = ltid() & 63, h = lane >> 5, c = lane & 31;
    const bf16_t* Z = (const bf16_t*)(p.ws + WS_Z); const bf16_t* WUQ_T = (const bf16_t*)(p.ws + WS_WUQ_T); const bf16_t* WUKV_T = (const bf16_t*)(p.ws + WS_WUKV_T);
    const int tok0 = tt * 32, tok = tok0 + c; const bool lat = tok0 < TL;
    const int b = lat ? tok0 / SEQ : (tok0 - TL) / CTXL; const int pos = lat ? tok % SEQ : SEQ + (tok - TL) % CTXL;
    const bf16_t* row = Z + (size_t)tok * ZW;
    const float* qng = p.in[I_QN] + l * 96; const float* kng = p.in[I_KN] + l * 96;
    float cs[2][4], sn[2][4];
    if (lat) {
        const int t = tok % SEQ; const float pa[2] = {(float)(t >> 6), (float)(t & 63)};
#pragma unroll
        for (int a = 0; a < 2; ++a)
#pragma unroll
            for (int i = 0; i < 4; ++i) { const float invf = __builtin_amdgcn_exp2f(-(float)(4 * h + i) * (13.287712379549449f / 8.f)) * 0.15915494309189535f; float rev = pa[a] * invf; rev -= floorf(rev); cs[a][i] = __builtin_amdgcn_cosf(rev); sn[a][i] = __builtin_amdgcn_sinf(rev); }
    }
    const size_t obase = ((size_t)b * 4 + hh) * PALL + pos;
    if (lat || l == 0) {
        float ssq = 0.f;
#pragma unroll 4
        for (int s2 = 0; s2 < 12; ++s2) { const bf16x8 xv = *(const bf16x8*)(row + ZC_CQ + 16 * s2 + 8 * h); ssq += sq8(xv); }
        ssq += __shfl_xor(ssq, 32); const float rq = rsqrtf(ssq * (1.f / 192.f) + EPS);
        f32x16 acc[3];
#pragma unroll
        for (int j = 0; j < 3; ++j) {
#pragma unroll
            for (int i = 0; i < 16; ++i) acc[j][i] = 0.f;
            const bf16_t* wr = WUQ_T + (size_t)(hh * 96 + 32 * j + c) * 192 + 8 * h; const bf16_t* xr_ = row + ZC_CQ + 8 * h;
#pragma unroll 2
            for (int s2 = 0; s2 < 12; ++s2) { const bf16x8 a = *(const bf16x8*)(wr + 16 * s2); const bf16x8 xv = *(const bf16x8*)(xr_ + 16 * s2); acc[j] = MFMA32(a, xv, acc[j]); }
        }
        float ss = 0.f;
#pragma unroll
        for (int j = 0; j < 3; ++j)
#pragma unroll
            for (int i = 0; i < 16; ++i) { acc[j][i] *= rq; ss += acc[j][i] * acc[j][i]; }
        ss += __shfl_xor(ss, 32); const float rs = rsqrtf(ss * (1.f / 96.f) + EPS);
#pragma unroll
        for (int j = 0; j < 3; ++j)
#pragma unroll
            for (int g = 0; g < 4; ++g) { const f32x4 gv = *(const f32x4*)(qng + 32 * j + 8 * g + 4 * h);
#pragma unroll
                for (int i = 0; i < 4; ++i) acc[j][4 * g + i] *= rs * gv[i]; }
        if (lat) {
#pragma unroll
            for (int a = 0; a < 2; ++a)
#pragma unroll
                for (int i = 0; i < 4; ++i) { const int r0 = 8 * a + i, r1 = r0 + 4; const float x1 = acc[2][r0], x2 = acc[2][r1]; acc[2][r0] = x1 * cs[a][i] - x2 * sn[a][i]; acc[2][r1] = x2 * cs[a][i] + x1 * sn[a][i]; }
        }
        const float qsc = 0.10206207261596575f * 1.4426950408889634f;
        bf16_t* dst = (bf16_t*)(p.ws + WS_Q) + obase * 96;
#pragma unroll
        for (int j = 0; j < 3; ++j)
#pragma unroll
            for (int g = 0; g < 4; ++g) { u32x2 w; w.x = pk_bf16(acc[j][4 * g] * qsc, acc[j][4 * g + 1] * qsc); w.y = pk_bf16(acc[j][4 * g + 2] * qsc, acc[j][4 * g + 3] * qsc); *(u32x2*)(dst + 32 * j + 8 * g + 4 * h) = w; }
    }
    {
        float ssk = 0.f;
#pragma unroll 4
        for (int s2 = 0; s2 < 8; ++s2) { const bf16x8 xv = *(const bf16x8*)(row + ZC_CKV + 16 * s2 + 8 * h); ssk += sq8(xv); }
        ssk += __shfl_xor(ssk, 32); const float rkv = rsqrtf(ssk * (1.f / 128.f) + EPS);
        f32x16 acc[4];
#pragma unroll
        for (int j = 0; j < 4; ++j) {
#pragma unroll
            for (int i = 0; i < 16; ++i) acc[j][i] = 0.f;
            const bf16_t* wr = WUKV_T + (size_t)(hh * 128 + 32 * j + c) * 128 + 8 * h; const bf16_t* xr_ = row + ZC_CKV + 8 * h;
#pragma unroll 2
            for (int s2 = 0; s2 < 8; ++s2) { const bf16x8 a = *(const bf16x8*)(wr + 16 * s2); const bf16x8 xv = *(const bf16x8*)(xr_ + 16 * s2); acc[j] = MFMA32(a, xv, acc[j]); }
        }
        float kr[16];
#pragma unroll
        for (int g = 0; g < 4; ++g) { const u32x2 w = *(const u32x2*)(row + ZC_KR + 8 * g + 4 * h); kr[4 * g] = __uint_as_float(w.x << 16); kr[4 * g + 1] = __uint_as_float(w.x & 0xffff0000u); kr[4 * g + 2] = __uint_as_float(w.y << 16); kr[4 * g + 3] = __uint_as_float(w.y & 0xffff0000u); }
        float ss = 0.f;
#pragma unroll
        for (int j = 0; j < 4; ++j)
#pragma unroll
            for (int i = 0; i < 16; ++i) { acc[j][i] *= rkv; if (j < 2) ss += acc[j][i] * acc[j][i]; }
#pragma unroll
        for (int i = 0; i < 16; ++i) ss += kr[i] * kr[i];
        ss += __shfl_xor(ss, 32); const float rs = rsqrtf(ss * (1.f / 96.f) + EPS);
#pragma unroll
        for (int g = 0; g < 4; ++g) {
            const f32x4 g0 = *(const f32x4*)(kng + 8 * g + 4 * h), g1 = *(const f32x4*)(kng + 32 + 8 * g + 4 * h), g2 = *(const f32x4*)(kng + 64 + 8 * g + 4 * h);
#pragma unroll
            for (int i = 0; i < 4; ++i) { acc[0][4 * g + i] *= rs * g0[i]; acc[1][4 * g + i] *= rs * g1[i]; kr[4 * g + i] *= rs * g2[i]; }
        }
        if (lat) {
#pragma unroll
            for (int a = 0; a < 2; ++a)
#pragma unroll
                for (int i = 0; i < 4; ++i) { const int r0 = 8 * a + i, r1 = r0 + 4; const float x1 = kr[r0], x2 = kr[r1]; kr[r0] = x1 * cs[a][i] - x2 * sn[a][i]; kr[r1] = x2 * cs[a][i] + x1 * sn[a][i]; }
        }
        bf16_t* dst = (bf16_t*)(p.ws + WS_K) + obase * 96;
#pragma unroll
        for (int g = 0; g < 4; ++g) {
            u32x2 w; w.x = pk_bf16(acc[0][4 * g], acc[0][4 * g + 1]); w.y = pk_bf16(acc[0][4 * g + 2], acc[0][4 * g + 3]); *(u32x2*)(dst + 8 * g + 4 * h) = w;
            w.x = pk_bf16(acc[1][4 * g], acc[1][4 * g + 1]); w.y = pk_bf16(acc[1][4 * g + 2], acc[1][4 * g + 3]); *(u32x2*)(dst + 32 + 8 * g + 4 * h) = w;
            w.x = pk_bf16(kr[4 * g], kr[4 * g + 1]); w.y = pk_bf16(kr[4 * g + 2], kr[4 * g + 3]); *(u32x2*)(dst + 64 + 8 * g + 4 * h) = w;
        }
        bf16_t* vt = (bf16_t*)(p.ws + WS_VT) + ((size_t)b * 4 + hh) * 64 * PALL + pos;
#pragma unroll
        for (int j = 2; j < 4; ++j)
#pragma unroll
            for (int r = 0; r < 16; ++r) { const int d = 32 * (j - 2) + (r & 3) + 8 * (r >> 2) + 4 * h; vt[(size_t)d * PALL] = f2bf(acc[j][r]); }
    }
}
DI void phase_mprep(CPARAMS p, int l) {
    const int wg = blockIdx.x * 8 + (ltid() >> 6), nw = gridDim.x * 8;
    for (int task = wg; task < (T / 32) * 4; task += nw) mprep_task(p, l, task >> 2, task & 3);
}


#define XB_TMO      128
#define XB_XCNT(j)  (256  + 64 * (j))
#define XB_XSUB(j)  (1280 + 64 * (j))
#define XB_XGEN(j)  (2304 + 64 * (j))
#define XB_TOP      3328
#define XB_TOPGEN   3392
#define XCD_BAR_WORDS 3456
#define XB_SPIN_CAP (1u << 18)
__device__ __forceinline__ unsigned xb_ld(unsigned* p)              { return __hip_atomic_load(p, __ATOMIC_RELAXED, __HIP_MEMORY_SCOPE_AGENT); }
__device__ __forceinline__ unsigned xb_add(unsigned* p, unsigned v) { return __hip_atomic_fetch_add(p, v, __ATOMIC_RELAXED, __HIP_MEMORY_SCOPE_AGENT); }
__device__ __forceinline__ unsigned xb_xcc_id() { return (unsigned)__builtin_amdgcn_s_getreg((3 << 11) | 20) & 0xFu; }
#define XB_SPIN(cond, bar) do { unsigned _sp = 0; while (cond) { __builtin_amdgcn_s_sleep(1); \
    if ((++_sp & 255u) == 0u) { if (xb_ld(&(bar)[XB_TMO])) break; if (_sp > XB_SPIN_CAP) { atomicAdd(&(bar)[XB_TMO], 1u); break; } } } } while (0)
struct XcdBarrier { unsigned* bar; unsigned x; volatile LAS unsigned* st; };
__device__ __forceinline__ XcdBarrier xcd_barrier_post(unsigned* bar, volatile LAS unsigned* st) {
    XcdBarrier b; b.bar = bar; b.x = xb_xcc_id(); b.st = st;
    if (threadIdx.x == 0) (void)xb_add(&bar[XB_XCNT(b.x)], 1u);
    return b;
}
__device__ __forceinline__ void xcd_barrier_complete(unsigned* bar, unsigned x, unsigned& nloc, unsigned& nx) {
    const unsigned G = gridDim.x * gridDim.y * gridDim.z;
    unsigned sum, cnt, mine, sp = 0u;
    for (;;) {
        sum = 0u; cnt = 0u; mine = 0u;
#pragma unroll
        for (unsigned j = 0; j < 16; ++j) { const unsigned c = xb_ld(&bar[XB_XCNT(j)]); sum += c; cnt += (c > 0u) ? 1u : 0u; mine = (j == x) ? c : mine; }
        if (sum == G) break;
        __builtin_amdgcn_s_sleep(1);
        if ((++sp & 255u) == 0u) { if (xb_ld(&bar[XB_TMO])) break; if (sp > XB_SPIN_CAP) { atomicAdd(&bar[XB_TMO], 1u); break; } }
    }
    nloc = mine > 0u ? mine : 1u; nx = cnt > 0u ? cnt : 1u;
}
__device__ __forceinline__ void xcd_barrier(const XcdBarrier& b) {
    asm volatile("s_waitcnt vmcnt(0)" ::: "memory");
    __syncthreads();
    if (threadIdx.x == 0) {
        unsigned* bar = b.bar;
        __builtin_amdgcn_s_waitcnt(0);
        unsigned nloc = b.st[0], nx = b.st[1];
        if (nloc == 0u) { xcd_barrier_complete(bar, b.x, nloc, nx); b.st[0] = nloc; b.st[1] = nx; }
        const unsigned old = xb_add(&bar[XB_XSUB(b.x)], 1u);
        const unsigned gen = old / nloc;
        if (old + 1u == (gen + 1u) * nloc) {
            __builtin_amdgcn_fence(__ATOMIC_RELEASE, "agent");
            asm volatile("s_waitcnt vmcnt(0)" ::: "memory");
            const unsigned og = xb_add(&bar[XB_TOP], 1u);
            const unsigned tg = og / nx;
            if (og + 1u == (tg + 1u) * nx) xb_add(&bar[XB_TOPGEN], 1u);
            else XB_SPIN(xb_ld(&bar[XB_TOPGEN]) == tg, bar);
            __builtin_amdgcn_fence(__ATOMIC_ACQUIRE, "agent");
            xb_add(&bar[XB_XGEN(b.x)], 1u);
            asm volatile("s_waitcnt vmcnt(0)" ::: "memory");
        } else {
            XB_SPIN(xb_ld(&bar[XB_XGEN(b.x)]) == gen, bar);
            __builtin_amdgcn_fence(__ATOMIC_ACQUIRE, "agent");
            asm volatile("s_waitcnt vmcnt(0)" ::: "memory");
        }
    }
    __syncthreads();
}

constexpr int CW_BAR = 8192;
constexpr int N_PHASES = 20;
__global__ void __launch_bounds__(512, 2) fwd(Params p_unused) {
    extern __shared__ __attribute__((aligned(16))) unsigned char dynlds[];
    LAS unsigned char* lds = (LAS unsigned char*)dynlds;
    volatile LAS unsigned* st = (volatile LAS unsigned*)(lds + LDS_BYTES - 16);
    if (threadIdx.x == 0) { st[0] = 0u; st[1] = 0u; st[2] = 0u; st[3] = 0u; }
    __syncthreads();
    #define PP (*launder_kp((KP)__builtin_amdgcn_kernarg_segment_ptr()))
    (void)xcd_barrier_post((unsigned*)(PP.ws + WS_CTL) + CW_BAR, st);
#define IN(k) (PP.ph_lo <= (k) && (k) < PP.ph_hi)
#define SEAM(k) do { if (IN(k) && IN((k) + 1)) { XcdBarrier bar_; bar_.bar = (unsigned*)(PP.ws + WS_CTL) + CW_BAR; bar_.x = xb_xcc_id(); bar_.st = (volatile LAS unsigned*)(lds + LDS_BYTES - 16); xcd_barrier(bar_); } } while (0)
    if (IN(0)) { phase_mod(PP, (LAS float*)lds); phase_convert(PP, 0, (LAS float*)lds); phase_filter(PP, 0, (LAS float*)lds); }
    SEAM(0);
    if (IN(1)) phase_norm1(PP, 0);
    SEAM(1);
    for (int l = 0; l < 2; ++l) {
        const int pb = 2 + 9 * l;
        if (IN(pb + 0)) phase_inproj(PP, lds);
        SEAM(pb + 0);
        if (IN(pb + 1)) { phase_mprep(PP, l); phase_hyprep(PP, l, lds); }
        SEAM(pb + 1);
        if (IN(pb + 2)) { phase_attn(PP, l, lds); phase_ret(PP, l, lds); phase_hyena(PP, l, lds); phase_lru(PP, l, lds); }
        SEAM(pb + 2);
        if (IN(pb + 3)) phase_merge(PP, l);
        SEAM(pb + 3);
        if (IN(pb + 4)) phase_outproj(PP, l, lds);
        SEAM(pb + 4);
        if (IN(pb + 5)) phase_norm2(PP, l);
        SEAM(pb + 5);
        if (IN(pb + 6)) phase_moe1(PP, l, lds);
        SEAM(pb + 6);
        if (IN(pb + 7)) phase_moe2(PP, l, lds);
        SEAM(pb + 7);
        if (IN(pb + 8)) { phase_combine(PP, l); if (l == 0) { phase_convert(PP, 1, (LAS float*)lds); phase_filter(PP, 1, (LAS float*)lds); } }
        if (l == 0) SEAM(pb + 8);
    }
#undef IN
#undef SEAM
}

#ifndef MK_PER_PHASE
#define MK_PER_PHASE 0
#endif
extern "C" void kernel_launch(void* const* d_in, const int* in_sizes, int n_in, void* d_out, int out_size, void* d_ws, size_t ws_size, hipStream_t stream) {
    static int grid = 0;
    if (grid == 0) {
        if (ws_size < WS_END) fprintf(stderr, "kernel_launch: workspace too small: %zu < %zu\n", ws_size, (size_t)WS_END);
        int dev = 0, cus = 0, per_cu = 0;
        (void)hipGetDevice(&dev); (void)hipDeviceGetAttribute(&cus, hipDeviceAttributeMultiprocessorCount, dev);
        (void)hipFuncSetAttribute((const void*)fwd, hipFuncAttributeMaxDynamicSharedMemorySize, LDS_BYTES);
        if (hipOccupancyMaxActiveBlocksPerMultiprocessor(&per_cu, (const void*)fwd, 512, LDS_BYTES) != hipSuccess || per_cu < 1) { fprintf(stderr, "kernel_launch: occupancy query says %d\n", per_cu); per_cu = 1; }
        (void)hipGetLastError();
        grid = cus > 0 ? cus : 256;
    }
    Params p{};
    for (int i = 0; i < N_IN; ++i) p.in[i] = (const float*)d_in[i];
    p.out = (float*)d_out; p.ws = (unsigned char*)d_ws;
    (void)hipMemsetAsync((char*)d_ws + WS_CTL, 0, 1 * MiB, stream);
#if MK_PER_PHASE
    for (int ph = 0; ph < N_PHASES; ++ph) { p.ph_lo = ph; p.ph_hi = ph + 1; hipLaunchKernelGGL(fwd, dim3(grid), dim3(512), LDS_BYTES, stream, p); }
#else
    p.ph_lo = 0; p.ph_hi = N_PHASES; hipLaunchKernelGGL(fwd, dim3(grid), dim3(512), LDS_BYTES, stream, p);
#endif
}
```

```cpp
#include <hip/hip_runtime.h>
#include <cstdio>
#include <cstdint>

#define DI __device__ __forceinline__
#define LAS __attribute__((address_space(3)))
typedef unsigned short bf16_t;
typedef short bf16x8 __attribute__((ext_vector_type(8)));
typedef float f32x4 __attribute__((ext_vector_type(4)));
typedef float f32x16 __attribute__((ext_vector_type(16)));
typedef unsigned u32x4 __attribute__((ext_vector_type(4)));
typedef unsigned u32x2 __attribute__((ext_vector_type(2)));

constexpr int D = 1024, NB = 32, SEQ = 2048, CTXL = 256, PALL = SEQ + CTXL;
constexpr int TL = NB * SEQ, TC = NB * CTXL, T = TL + TC;
constexpr int ZW = 2816, INC = 2656;
constexpr int ZC_CQ = 0, ZC_CKV = 256, ZC_KR = 384, ZC_RQ = 512, ZC_RK = 768, ZC_RV = 1024, ZC_RG = 1280,
              ZC_HX0 = 1536, ZC_HX1 = 1792, ZC_HV = 2048, ZC_LX = 2304, ZC_LG = 2560;
__host__ __device__ __forceinline__ size_t zoff(int tok, int col) { return ((size_t)(col >> 8) * (32 * 2048 + 32 * 256) + tok) * 256 + (col & 255); }
__host__ __device__ __forceinline__ int zmap(int c) { return c < 192 ? c : (c < 352 ? c + 64 : c + 160); }
constexpr float EPS = 1e-6f;
constexpr int NEXP = 32, EFF = 512, CAPE = T;
constexpr int MAXSLOT = 155648;

enum { I_X = 0, I_C, I_CTX, I_CCTX, I_WMOD, I_BMOD, I_N1G, I_N2G, I_WIN, I_QNG, I_WUQ, I_KVNG, I_WUKV, I_QN, I_KN, I_RLG, I_RNG,
       I_HCW, I_HCB, I_HW1, I_HB1, I_HW2, I_HB2, I_HW3, I_HFREQ, I_HD, I_LCW, I_LCB, I_LWA, I_LBA, I_LWX, I_LBX, I_LLAM, I_GNG, I_WOUT,
       I_MWG, I_MWE, I_MW1, I_MW3, I_MW2, N_IN };

constexpr size_t MiB = 1024ull * 1024ull;
constexpr size_t WS_CTL = 0;
constexpr size_t WS_MOD = 1 * MiB;
constexpr size_t WS_G2048 = 3 * MiB;
constexpr size_t WS_G256 = 5 * MiB;
constexpr size_t WS_WUP_T = 6 * MiB;
constexpr size_t WS_LRUW_T = 6 * MiB + 512 * 1024;
constexpr size_t WS_WIN_T = 7 * MiB;
constexpr size_t WS_WOUT_T = 13 * MiB;
constexpr size_t WS_W13_T = 15 * MiB;
constexpr size_t WS_W2_T = 79 * MiB;
constexpr size_t WS_ETOK = 111 * MiB;
constexpr size_t WS_EW = 120 * MiB;
constexpr size_t WS_XC = 129 * MiB;
constexpr size_t WS_ACT = 161 * MiB;
constexpr size_t WS_Q = WS_ACT;
constexpr size_t WS_K = WS_Q + 56623104ull;
constexpr size_t WS_VT = WS_K + 56623104ull;
constexpr size_t WS_RAW = 305 * MiB;
constexpr size_t WS_XB1 = 305 * MiB;
constexpr size_t WS_YA = 305 * MiB;
constexpr size_t WS_OF = 341 * MiB;
constexpr size_t WS_OB = 377 * MiB;
constexpr size_t WS_HF = 413 * MiB;
constexpr size_t WS_HB = 449 * MiB;
constexpr size_t WS_Z = 485 * MiB;
constexpr size_t WS_SL = 881 * MiB;
constexpr size_t WS_SC = 913 * MiB;
constexpr size_t WS_YT = 917 * MiB;
constexpr size_t WS_YTC = 949 * MiB;
constexpr size_t WS_H = WS_Z;
constexpr size_t WS_YTOK = WS_Z + 152 * MiB;
constexpr size_t WS_XT = 953 * MiB;
constexpr size_t WS_END = 989 * MiB;
constexpr int CW_COUNT = 4096;

struct Params { const float* in[N_IN]; float* out; unsigned char* ws; int ph_lo, ph_hi; };
#define CPARAMS const __attribute__((address_space(4))) Params&
typedef const __attribute__((address_space(4))) Params* KP;
DI int ltid() { int t = threadIdx.x; asm volatile("" : "+v"(t)); return t; }
DI KP launder_kp(KP k) { asm volatile("" : "+s"(k)); return k; }

DI bf16_t f2bf(float f) { unsigned u = __float_as_uint(f); u += 0x7FFFu + ((u >> 16) & 1u); return (bf16_t)(u >> 16); }
typedef __bf16 bf16x2_t __attribute__((ext_vector_type(2)));
typedef float f32x2_t __attribute__((ext_vector_type(2)));
DI unsigned pk_bf16(float a, float b) { f32x2_t v = {a, b}; bf16x2_t r = __builtin_convertvector(v, bf16x2_t); return __builtin_bit_cast(unsigned, r); }
DI float bf2f(bf16_t b) { return __uint_as_float(((unsigned)b) << 16); }
DI float dpp_add(float v, const int ctrl_sel) {
    int r;
    if (ctrl_sel == 0) r = __builtin_amdgcn_update_dpp(0, __float_as_int(v), 0xB1, 0xF, 0xF, true);
    else if (ctrl_sel == 1) r = __builtin_amdgcn_update_dpp(0, __float_as_int(v), 0x4E, 0xF, 0xF, true);
    else if (ctrl_sel == 2) r = __builtin_amdgcn_update_dpp(0, __float_as_int(v), 0x141, 0xF, 0xF, true);
    else r = __builtin_amdgcn_update_dpp(0, __float_as_int(v), 0x140, 0xF, 0xF, true);
    return v + __int_as_float(r);
}
DI float row_sum16(float v) { v = dpp_add(v, 0); v = dpp_add(v, 1); v = dpp_add(v, 2); v = dpp_add(v, 3); return v; }
DI float wave_sum(float v) {
    v = row_sum16(v);
    const float s0 = __int_as_float(__builtin_amdgcn_readlane(__float_as_int(v), 0)), s1 = __int_as_float(__builtin_amdgcn_readlane(__float_as_int(v), 16));
    const float s2 = __int_as_float(__builtin_amdgcn_readlane(__float_as_int(v), 32)), s3 = __int_as_float(__builtin_amdgcn_readlane(__float_as_int(v), 48));
    return (s0 + s1) + (s2 + s3);
}
DI float hw_sin(float x) { float r = x * 0.15915494309189535f; r -= floorf(r); return __builtin_amdgcn_sinf(r); }
DI float siluf(float v) { return v / (1.f + expf(-v)); }
DI float gelu_tanh(float x) { const float u = 0.7978845608028654f * (x + 0.044715f * x * x * x); return 0.5f * x * (1.f + tanhf(u)); }
DI const float* modrow(CPARAMS p, int l, int r) { return (const float*)(p.ws + WS_MOD) + ((size_t)l * 33 + r) * 6144; }
DI int tok_batch(int tok) { return tok < TL ? tok / SEQ : (tok - TL) / CTXL; }

DI void phase_mod(CPARAMS p, LAS float* sm) {
  for (int vb = blockIdx.x; vb < 256; vb += gridDim.x) {
    __syncthreads();
    float* MOD = (float*)(p.ws + WS_MOD);
    const int tid = ltid();
    for (int i0 = tid; i0 < 33 * 1024; i0 += 512 * 6) { float cv[6];
#pragma unroll
        for (int u = 0; u < 6; ++u) { const int i = i0 + 512 * u, r = i >> 10, k = i & 1023; cv[u] = r < 32 ? p.in[I_C][r * 1024 + k] : p.in[I_CCTX][k]; }
#pragma unroll
        for (int u = 0; u < 6; ++u) sm[i0 + 512 * u] = siluf(cv[u]); }
    __syncthreads();
    const int col = tid % 48, ks = tid / 48;
    const int gcol = vb * 48 + col, l = gcol / 6144, n = gcol % 6144;
    float acc[33];
#pragma unroll
    for (int r = 0; r < 33; ++r) acc[r] = 0.f;
    if (ks < 8) {
        const float* w = p.in[I_WMOD] + (size_t)l * 1024 * 6144 + n;
#pragma unroll 4
        for (int k = ks * 128; k < ks * 128 + 128; ++k) {
            const float wv = w[(size_t)k * 6144];
#pragma unroll
            for (int r = 0; r < 33; ++r) acc[r] += sm[r * 1024 + k] * wv;
        }
    }
    __syncthreads();
    if (ks < 8) {
#pragma unroll
        for (int r = 0; r < 33; ++r) sm[(ks * 33 + r) * 48 + col] = acc[r];
    }
    __syncthreads();
    for (int i = tid; i < 33 * 48; i += 512) {
        const int r = i / 48, c = i % 48; float s = 0.f;
        for (int k2 = 0; k2 < 8; ++k2) s += sm[(k2 * 33 + r) * 48 + c];
        const int g = vb * 48 + c, l2 = g / 6144, n2 = g % 6144;
        MOD[((size_t)l2 * 33 + r) * 6144 + n2] = s + p.in[I_BMOD][l2 * 6144 + n2];
    }
  }
}

struct TcDesc { const float* src; const float* kscale; bf16_t* dst; int ld, K, N, ldd, k0, n0, drow0, remap; };
DI TcDesc tc_desc(CPARAMS p, int l, int t) {
    bf16_t* WIN_T = (bf16_t*)(p.ws + WS_WIN_T); bf16_t* WOUT_T = (bf16_t*)(p.ws + WS_WOUT_T); bf16_t* W13_T = (bf16_t*)(p.ws + WS_W13_T); bf16_t* W2_T = (bf16_t*)(p.ws + WS_W2_T);
    bf16_t* WUP_T = (bf16_t*)(p.ws + WS_WUP_T); bf16_t* LRUW_T = (bf16_t*)(p.ws + WS_LRUW_T);
    constexpr int N0 = 8 * 42, N1 = N0 + 128, N2 = N1 + 32 * 2 * 64, N3 = N2 + 32 * 64, N4 = N3 + 12, N5 = N4 + 8;
    TcDesc d; d.kscale = nullptr; d.remap = 0;
    if (t < N0) { const int kt = t / 42, nt = t % 42; d.src = p.in[I_WIN] + (size_t)l * 1024 * INC; d.ld = INC; d.K = 1024; d.N = INC; d.dst = WIN_T; d.ldd = 1024; d.k0 = kt * 128; d.n0 = nt * 64; d.drow0 = 0; d.remap = 1; }
    else if (t < N1) { const int u = t - N0, kt = u / 16, nt = u % 16; d.src = p.in[I_WOUT] + (size_t)l * 1024 * 1024; d.ld = 1024; d.K = 1024; d.N = 1024; d.dst = WOUT_T; d.ldd = 1024; d.k0 = kt * 128; d.n0 = nt * 64; d.drow0 = nt * 64; }
    else if (t < N2) { const int u = t - N1, e = u / 128, r = u % 128, bj = r / 64, q = r % 64, kt = q / 8, nt = q % 8; const int n0 = nt * 64;
        d.src = p.in[bj ? I_MW3 : I_MW1] + ((size_t)l * NEXP + e) * 1024 * 512; d.ld = 512; d.K = 1024; d.N = 512; d.dst = W13_T + (size_t)e * 1024 * 1024; d.ldd = 1024; d.k0 = kt * 128; d.n0 = n0; d.drow0 = 256 * (n0 / 128) + 128 * bj + (n0 % 128); }
    else if (t < N3) { const int u = t - N2, e = u / 64, q = u % 64, kt = q / 16, nt = q % 16;
        d.src = p.in[I_MW2] + ((size_t)l * NEXP + e) * 512 * 1024; d.ld = 1024; d.K = 512; d.N = 1024; d.dst = W2_T + (size_t)e * 1024 * 512; d.ldd = 512; d.k0 = kt * 128; d.n0 = nt * 64; d.drow0 = nt * 64; }
    else if (t < N4) { const int u = t - N3, kt = u / 6, nt = u % 6; d.src = p.in[I_WUQ] + (size_t)l * 192 * 384; d.ld = 384; d.K = 192; d.N = 384; d.dst = WUP_T; d.ldd = 256; d.k0 = kt * 128; d.n0 = nt * 64; d.drow0 = nt * 64; d.kscale = p.in[I_QNG] + l * 192; }
    else if (t < N5) { const int nt = t - N4; d.src = p.in[I_WUKV] + (size_t)l * 128 * 512; d.ld = 512; d.K = 128; d.N = 512; d.dst = WUP_T; d.ldd = 256; d.k0 = 0; d.n0 = nt * 64; d.drow0 = 512 + nt * 64; d.kscale = p.in[I_KVNG] + l * 128; }
    else { const int u = t - N5, dir = u / 8, gate = (u / 4) & 1, n = u % 4;
        d.src = p.in[gate ? I_LWX : I_LWA] + (((size_t)l * 2 + dir) * 4 + n) * 4096; d.ld = 64; d.K = 64; d.N = 64; d.dst = LRUW_T + (size_t)((dir * 2 + gate) * 4 + n) * 4096; d.ldd = 64; d.k0 = 0; d.n0 = 0; d.drow0 = 0; }
    return d;
}
DI void tc_load(const TcDesc& d, int tid, f32x4 (&v)[4]) {
#pragma unroll
    for (int i = 0; i < 4; ++i) { const int pi = tid + 512 * i, kk = pi >> 4, n4 = (pi & 15) * 4; v[i] = (f32x4){0.f, 0.f, 0.f, 0.f};
        if (d.k0 + kk < d.K && d.n0 + n4 < d.N) { v[i] = *(const f32x4*)(d.src + (size_t)(d.k0 + kk) * d.ld + d.n0 + n4); if (d.kscale) v[i] = v[i] * d.kscale[d.k0 + kk]; } }
}
__device__ __noinline__ void phase_convert(CPARAMS p, int l, LAS float* tile) {
    const int tid = ltid();
    constexpr int NT = 8 * 42 + 128 + 32 * 2 * 64 + 32 * 64 + 12 + 8 + 16;
    f32x4 v[4], v2[4];
    const int G = gridDim.x;
    int t = blockIdx.x;
    if (t < NT) { const TcDesc d0 = tc_desc(p, l, t); tc_load(d0, tid, v); }
    if (t + G < NT) { const TcDesc d1 = tc_desc(p, l, t + G); tc_load(d1, tid, v2); }
    LAS float* tile2 = tile + 128 * 68;
    for (; t < NT; t += 2 * G) {
        const bool has2 = t + G < NT;
        __syncthreads();
#pragma unroll
        for (int i = 0; i < 4; ++i) { const int pi = tid + 512 * i, kk = pi >> 4, n4 = (pi & 15) * 4; *(LAS f32x4*)(tile + kk * 68 + n4) = v[i]; if (has2) *(LAS f32x4*)(tile2 + kk * 68 + n4) = v2[i]; }
        __syncthreads();
        if (t + 2 * G < NT) { const TcDesc dn = tc_desc(p, l, t + 2 * G); tc_load(dn, tid, v); }
        if (t + 3 * G < NT) { const TcDesc dn = tc_desc(p, l, t + 3 * G); tc_load(dn, tid, v2); }
        for (int which = 0; which < (has2 ? 2 : 1); ++which) {
            const TcDesc cur = tc_desc(p, l, t + which * G); const LAS float* tl = which ? tile2 : tile;
#pragma unroll
            for (int j = 0; j < 2; ++j) { const int pi = tid + 512 * j, nn = pi & 63, kp = pi >> 6;
                if (cur.k0 + kp * 8 < cur.K && cur.n0 + nn < cur.N) {
                    float f[8];
#pragma unroll
                    for (int i = 0; i < 8; ++i) f[i] = tl[(kp * 8 + i) * 68 + nn];
                    u32x4 w; w.x = pk_bf16(f[0], f[1]); w.y = pk_bf16(f[2], f[3]); w.z = pk_bf16(f[4], f[5]); w.w = pk_bf16(f[6], f[7]);
                    const int drow = cur.remap ? zmap(cur.n0 + nn) : cur.drow0 + nn;
                    *(u32x4*)(cur.dst + (size_t)drow * cur.ldd + cur.k0 + kp * 8) = w; } }
        }
    }
    bf16_t* WIN_T = (bf16_t*)(p.ws + WS_WIN_T);
    for (int i = blockIdx.x * 512 + tid; i < 160 * 128; i += gridDim.x * 512) { const int rr_ = i >> 7, row = rr_ < 64 ? 192 + rr_ : 416 + (rr_ - 64); *(u32x4*)(WIN_T + (size_t)row * 1024 + (i & 127) * 8) = (u32x4){0u, 0u, 0u, 0u}; }
    bf16_t* WUP_T = (bf16_t*)(p.ws + WS_WUP_T);
    for (int i = blockIdx.x * 512 + tid; i < 15360; i += gridDim.x * 512) {
        int row, k;
        if (i < 3072) { row = i >> 3; k = 192 + (i & 7) * 8; } else if (i < 7168) { const int j = i - 3072; row = 384 + (j >> 5); k = (j & 31) * 8; } else { const int j = i - 7168; row = 512 + (j >> 4); k = 128 + (j & 15) * 8; }
        *(u32x4*)(WUP_T + (size_t)row * 256 + k) = (u32x4){0u, 0u, 0u, 0u};
    }
}

__device__ __noinline__ void phase_filter(CPARAMS p, int l, LAS float* fl) {
    LAS float* z = fl; LAS float* h1 = fl + 64; LAS float* h2 = fl + 128;
    const int tid = ltid();
    bf16_t* G2048 = (bf16_t*)(p.ws + WS_G2048); bf16_t* G256 = (bf16_t*)(p.ws + WS_G256);
    const float* w1 = p.in[I_HW1] + (size_t)l * 33 * 64; const float* b1 = p.in[I_HB1] + l * 64; const float* w2 = p.in[I_HW2] + (size_t)l * 64 * 64; const float* b2 = p.in[I_HB2] + l * 64;
    const float* w3 = p.in[I_HW3] + (size_t)l * 64 * 512; const float* fr = p.in[I_HFREQ] + l * 64; const float* hd = p.in[I_HD] + l * 256;
    LAS float* w1s = fl + 192; LAS float* w2s = fl + 192 + 33 * 64;
    __syncthreads();
    for (int q = tid; q < 33 * 64; q += 512) w1s[q] = w1[q];
    for (int q = tid; q < 64 * 64; q += 512) w2s[q] = w2[q];
    float w3r[64];
#pragma unroll
    for (int m = 0; m < 64; ++m) w3r[m] = w3[m * 512 + tid];
    const float b1v = tid < 64 ? b1[tid] : 0.f, b2v = tid < 64 ? b2[tid] : 0.f, frv = tid < 64 ? fr[tid] : 0.f;
    for (int pi = blockIdx.x; pi < 2048 + 256; pi += gridDim.x) {
        const int n = pi < 2048 ? 2048 : 256, i = pi < 2048 ? pi : pi - 2048;
        bf16_t* G = pi < 2048 ? G2048 : G256;
        const float tt = (float)i / (float)(n - 1);
        __syncthreads();
        if (tid < 33) {
            float v;
            if (tid == 0) v = tt;
            else { const int j = (tid - 1) & 15; const float band = 1e-4f + (15.f - 1e-4f) * (float)j / 15.f; float rev = band * ((float)i / (float)n); rev -= floorf(rev);
                v = tid <= 16 ? __builtin_amdgcn_cosf(rev) : -__builtin_amdgcn_sinf(rev); }
            z[tid] = v;
        }
        __syncthreads();
        if (tid < 64) { float s = b1v;
#pragma unroll
            for (int m = 0; m < 33; ++m) s += z[m] * w1s[m * 64 + tid]; h1[tid] = hw_sin(frv * s); }
        __syncthreads();
        if (tid < 64) { float s = b2v;
#pragma unroll
            for (int m = 0; m < 64; ++m) s += h1[m] * w2s[m * 64 + tid]; h2[tid] = hw_sin(frv * s); }
        __syncthreads();
        {
            const int j = tid; float s = 0.f;
#pragma unroll
            for (int m = 0; m < 64; ++m) s += h2[m] * w3r[m];
            const int c = j & 255; const float mind = logf(1e-2f) / 1.5f, maxd = logf(1e-2f) / 0.3f; const float delta = fabsf(mind + (maxd - mind) * (float)c / 255.f);
            float hv = s * expf(-tt * delta);
            if (j < 256) { if (i == 0) hv += hd[c]; G[(size_t)c * 2 * n + (n - i)] = f2bf(hv); if (i == 0) G[(size_t)c * 2 * n] = 0; }
            else if (i >= 1) G[(size_t)c * 2 * n + (n + i)] = f2bf(hv);
        }
    }
}

struct ModVec { float a[16], b[16]; };
DI void load_modvec(const float* g, const float* sh, const float* sc, int lane, ModVec& mv) {
#pragma unroll
    for (int j = 0; j < 4; ++j) { const int k = j * 256 + lane * 4; const f32x4 gv = *(const f32x4*)(g + k), sv = *(const f32x4*)(sc + k), hv = *(const f32x4*)(sh + k);
#pragma unroll
        for (int q = 0; q < 4; ++q) { mv.a[j * 4 + q] = gv[q] * (1.f + sv[q]); mv.b[j * 4 + q] = hv[q]; } }
}
DI void ld_row_bf(const bf16_t* xr, int lane, f32x4 (&v)[4]) {
#pragma unroll
    for (int j = 0; j < 4; ++j) { const u32x2 w = *(const u32x2*)(xr + j * 256 + lane * 4); v[j] = (f32x4){__uint_as_float(w.x << 16), __uint_as_float(w.x & 0xffff0000u), __uint_as_float(w.y << 16), __uint_as_float(w.y & 0xffff0000u)}; }
}
DI void ld_row(const float* xr, int lane, f32x4 (&v)[4]) {
#pragma unroll
    for (int j = 0; j < 4; ++j) v[j] = *(const f32x4*)(xr + j * 256 + lane * 4);
}
DI void norm_store(const f32x4 (&v)[4], const ModVec& mv, bf16_t* dst, int lane, float (&f)[16]) {
    float ss = 0.f;
#pragma unroll
    for (int j = 0; j < 4; ++j) ss += v[j][0] * v[j][0] + v[j][1] * v[j][1] + v[j][2] * v[j][2] + v[j][3] * v[j][3];
    ss = wave_sum(ss);
    const float rstd = rsqrtf(ss * (1.f / 1024.f) + EPS);
#pragma unroll
    for (int j = 0; j < 4; ++j) {
#pragma unroll
        for (int q = 0; q < 4; ++q) f[j * 4 + q] = v[j][q] * rstd * mv.a[j * 4 + q] + mv.b[j * 4 + q];
        u32x2 w; w.x = pk_bf16(f[j * 4], f[j * 4 + 1]); w.y = pk_bf16(f[j * 4 + 2], f[j * 4 + 3]);
        *(u32x2*)(dst + j * 256 + lane * 4) = w;
    }
}
__device__ __noinline__ void phase_norm1(CPARAMS p, int l) {
    const int lane = ltid() & 63; const int w = blockIdx.x * 8 + __builtin_amdgcn_readfirstlane(ltid() >> 6), nw = gridDim.x * 8;
    bf16_t* ACT = (bf16_t*)(p.ws + WS_ACT);
    const int per = (T + nw - 1) / nw; const int tA = w * per, tB = tA + per < T ? tA + per : T;
    ModVec mv; int curmr = -1; f32x4 cur[4], nx[4];
    if (tA < tB) ld_row(tA < TL ? p.in[I_X] + (size_t)tA * D : p.in[I_CTX] + (size_t)(tA - TL) * D, lane, cur);
    for (int tok = tA; tok < tB; ++tok) {
        if (tok + 1 < tB) { const int tn = tok + 1; ld_row(tn < TL ? p.in[I_X] + (size_t)tn * D : p.in[I_CTX] + (size_t)(tn - TL) * D, lane, nx); }
        const int mr = tok < TL ? tok / SEQ : 32;
        if (mr != curmr) { const float* m = modrow(p, l, mr); load_modvec(p.in[I_N1G] + l * D, m, m + 1024, lane, mv); curmr = mr; }
        float f[16];
        norm_store(cur, mv, ACT + (size_t)tok * D, lane, f);
#pragma unroll
        for (int j = 0; j < 4; ++j) cur[j] = nx[j];
    }
}

DI float conv3_at(const bf16_t* Z, int tokbase, int t, int L, int zcol, const float* cw, const float* cb, int ch768) {
    float s = cb[ch768];
#pragma unroll
    for (int j = 0; j < 3; ++j) { const int tt = t - 1 + j; if (tt >= 0 && tt < L) s += cw[j * 768 + ch768] * bf2f(Z[zoff(tokbase + tt, zcol)]); }
    return s;
}
DI void unpk4(const u32x2 w, float (&f)[4]) { f[0] = __uint_as_float(w.x << 16); f[1] = __uint_as_float(w.x & 0xffff0000u); f[2] = __uint_as_float(w.y << 16); f[3] = __uint_as_float(w.y & 0xffff0000u); }
DI u32x2 ld4(const bf16_t* p_) { return *(const u32x2*)p_; }
DI float fast_silu(float v) { return v * __builtin_amdgcn_rcpf(1.f + __builtin_amdgcn_exp2f(-1.4426950408889634f * v)); }
DI float fast_gelu_tanh(float x) { const float u = 0.7978845608028654f * (x + 0.044715f * x * x * x); const float e = __builtin_amdgcn_exp2f(-2.f * 1.4426950408889634f * u); return x * __builtin_amdgcn_rcpf(1.f + e); }
constexpr int MG_PITCH = 516;
DI void unpk8(const u32x4 w, float (&f)[8]) {
#pragma unroll
    for (int i = 0; i < 4; ++i) { f[2 * i] = __uint_as_float(w[i] << 16); f[2 * i + 1] = __uint_as_float(w[i] & 0xffff0000u); }
}
DI u32x4 ld8(const bf16_t* p_) { return *(const u32x4*)p_; }
DI float hsum32(float v) { v = row_sum16(v); v += __shfl_xor(v, 16); return v; }
DI void phase_merge(CPARAMS p, int l, LAS unsigned char* lds) {
    const int tid = ltid(), lane = tid & 63, wid = __builtin_amdgcn_readfirstlane(tid >> 6), half = lane >> 5, l5 = lane & 31;
    const bf16_t* Z = (const bf16_t*)(p.ws + WS_Z); bf16_t* ACT = (bf16_t*)(p.ws + WS_ACT);
    const bf16_t* YA = (const bf16_t*)(p.ws + WS_YA); const bf16_t* OF = (const bf16_t*)(p.ws + WS_OF); const bf16_t* OB = (const bf16_t*)(p.ws + WS_OB);
    const bf16_t* HF = (const bf16_t*)(p.ws + WS_HF); const bf16_t* HB = (const bf16_t*)(p.ws + WS_HB);
    const int ch0 = 8 * l5;
    float rng[8], cw[3][8], cb[8];
#pragma unroll
    for (int q = 0; q < 8; ++q) {
        rng[q] = p.in[I_RNG][l * 256 + ch0 + q]; cb[q] = p.in[I_HCB][l * 768 + ch0 + q];
#pragma unroll
        for (int j = 0; j < 3; ++j) cw[j][q] = p.in[I_HCW][((size_t)l * 3 + j) * 768 + ch0 + q];
    }
    const float* gng = p.in[I_GNG] + l * 1024;
    const int ntl = TL / 64, ntc = l == 0 ? TC / 64 : 0;
    for (int u = blockIdx.x; u < ntl + ntc; u += gridDim.x) {
        const bool lat = u < ntl; const int L = lat ? SEQ : CTXL; const int tok0 = lat ? u * 64 : TL + (u - ntl) * 64;
        const int b = lat ? tok0 / SEQ : (tok0 - TL) / CTXL; const int t0 = lat ? tok0 % SEQ : (tok0 - TL) % CTXL;
        const bf16_t* YT = (const bf16_t*)(p.ws + (lat ? WS_YT : WS_YTC));
        u32x4 cug[10], nxg[10];
#define MG_LOAD(i_, g_) do { const int tl_ = wid * 8 + (i_) * 2 + half, tok_ = tok0 + tl_, t_ = t0 + tl_; \
            g_[0] = ld8(YA + (size_t)tok_ * 256 + ch0); g_[1] = ld8(OF + (size_t)tok_ * 256 + ch0); g_[2] = ld8(OB + (size_t)tok_ * 256 + ch0); g_[3] = ld8(Z + zoff(tok_, ZC_RG + ch0)); \
            g_[4] = ld8(HF + (size_t)tok_ * 256 + ch0); g_[5] = ld8(HB + (size_t)tok_ * 256 + ch0); g_[6] = ld8(Z + zoff(tok_, ZC_LG + ch0)); \
            _Pragma("unroll") for (int j = 0; j < 3; ++j) { const int tt = t_ - 1 + j; g_[7 + j] = (u32x4){0u, 0u, 0u, 0u}; if (tt >= 0 && tt < L) g_[7 + j] = ld8(Z + zoff(tok_ - 1 + j, ZC_HX0 + ch0)); } } while (0)
        MG_LOAD(0, cug);
        __syncthreads();
#pragma unroll
        for (int j = 0; j < 4; ++j) { const int pi = tid + 512 * j, ch = pi >> 3, tp = pi & 7; const u32x4 v = *(const u32x4*)(YT + ((size_t)ch * NB + b) * L + t0 + tp * 8);
#pragma unroll
            for (int d4 = 0; d4 < 4; ++d4) { *(LAS bf16_t*)(lds + (tp * 8 + 2 * d4) * MG_PITCH + ch * 2) = (bf16_t)(v[d4] & 0xffffu); *(LAS bf16_t*)(lds + (tp * 8 + 2 * d4 + 1) * MG_PITCH + ch * 2) = (bf16_t)(v[d4] >> 16); } }
        __syncthreads();
        for (int i = 0; i < 4; ++i) {
            const int tl = wid * 8 + i * 2 + half, tok = tok0 + tl, t = t0 + tl;
            if (i + 1 < 4) MG_LOAD(i + 1, nxg);
            const u32x4 wya = cug[0], wof = cug[1], wob = cug[2], wrg = cug[3], whf = cug[4], whb = cug[5], wlg = cug[6];
            u32x4 wx[3] = {cug[7], cug[8], cug[9]};
            u32x4 wy;
#pragma unroll
            for (int d4 = 0; d4 < 4; ++d4) wy[d4] = *(const LAS unsigned*)(lds + tl * MG_PITCH + ch0 * 2 + d4 * 4);
            float v[4][8], a[8], c2[8], d2[8];
            unpk8(wya, v[0]);
            unpk8(wof, a); unpk8(wob, c2); unpk8(wrg, d2);
            float ssb = 0.f;
#pragma unroll
            for (int q = 0; q < 8; ++q) { a[q] += c2[q]; ssb += a[q] * a[q]; }
            ssb = dpp_add(ssb, 0); ssb = dpp_add(ssb, 1); ssb = dpp_add(ssb, 2);
            const float rsb = rsqrtf(ssb * (1.f / 64.f) + EPS);
#pragma unroll
            for (int q = 0; q < 8; ++q) v[1][q] = a[q] * rsb * rng[q] * fast_silu(d2[q]);
            {
                float x0[8], y[8];
#pragma unroll
                for (int q = 0; q < 8; ++q) x0[q] = cb[q];
#pragma unroll
                for (int j = 0; j < 3; ++j) { const int tt = t - 1 + j; float xz[8]; unpk8(wx[j], xz); if (tt >= 0 && tt < L) {
#pragma unroll
                        for (int q = 0; q < 8; ++q) x0[q] += cw[j][q] * xz[q]; } }
                unpk8(wy, y);
#pragma unroll
                for (int q = 0; q < 8; ++q) v[2][q] = x0[q] * y[q];
            }
            unpk8(whf, a); unpk8(whb, c2); unpk8(wlg, d2);
#pragma unroll
            for (int q = 0; q < 8; ++q) v[3][q] = (a[q] + c2[q]) * fast_gelu_tanh(d2[q]);
#pragma unroll
            for (int g = 0; g < 4; ++g) {
                float ss = 0.f;
#pragma unroll
                for (int q = 0; q < 8; ++q) ss += v[g][q] * v[g][q];
                ss = hsum32(ss); const float rs = rsqrtf(ss * (1.f / 256.f) + EPS);
                const f32x4 g0 = *(const f32x4*)(gng + g * 256 + ch0), g1 = *(const f32x4*)(gng + g * 256 + ch0 + 4);
                u32x4 w; w.x = pk_bf16(v[g][0] * rs * g0[0], v[g][1] * rs * g0[1]); w.y = pk_bf16(v[g][2] * rs * g0[2], v[g][3] * rs * g0[3]);
                w.z = pk_bf16(v[g][4] * rs * g1[0], v[g][5] * rs * g1[1]); w.w = pk_bf16(v[g][6] * rs * g1[2], v[g][7] * rs * g1[3]);
                *(u32x4*)(ACT + (size_t)tok * D + g * 256 + ch0) = w;
            }
#pragma unroll
            for (int j = 0; j < 10; ++j) cug[j] = nxg[j];
        }
#undef MG_LOAD
    }
}

DI float half_sum32(float v) { v = row_sum16(v); v += __shfl_xor(v, 16); return v; }
DI void phase_norm2(CPARAMS p, int l, LAS unsigned char* lds) {
    const int tid = ltid(), lane = tid & 63, wid = __builtin_amdgcn_readfirstlane(tid >> 6), half = lane >> 5, l5 = lane & 31; const int M = l == 0 ? T : TL;
    const int per = (M + (int)gridDim.x - 1) / (int)gridDim.x; const int tokA = blockIdx.x * per, tokB = (tokA + per < M) ? tokA + per : M;
    LAS unsigned* lcnt = (LAS unsigned*)(lds + 147456); LAS unsigned* lbase = lcnt + 32; LAS unsigned* info = lcnt + 64;
    __syncthreads();
    if (tid < 32) lcnt[tid] = 0u;
    {
        const float* weg = p.in[I_MWE] + (size_t)l * 1024 * 32; const float* wgg = p.in[I_MWG] + (size_t)l * 1024 * 4;
        for (int p0 = tid; p0 < 8192; p0 += 512 * 8) { f32x4 wv8[8];
#pragma unroll
            for (int u = 0; u < 8; ++u) { const int pi = p0 + 512 * u, k = pi >> 3, c = pi & 7; wv8[u] = *(const f32x4*)(weg + (size_t)k * 32 + c * 4); }
#pragma unroll
            for (int u = 0; u < 8; ++u) { const int pi = p0 + 512 * u, k = pi >> 3, c = pi & 7; *(LAS f32x4*)(lds + k * 128 + ((c ^ ((k >> 3) & 7)) * 16)) = wv8[u]; } }
        for (int k = tid; k < 1024; k += 512) { const int jj = k >> 8, ln = (k & 255) >> 3, i = k & 7; *(LAS f32x4*)(lds + 131072 + ((jj * 8 + i) * 32 + ln) * 16) = *(const f32x4*)(wgg + (size_t)k * 4); }
    }
    __syncthreads();
    bf16_t* ACT = (bf16_t*)(p.ws + WS_ACT); const float* XC = (const float*)(p.ws + WS_XC);
    unsigned* cnt = (unsigned*)(p.ws + WS_CTL) + CW_COUNT + l * 32; int* ETOK = (int*)(p.ws + WS_ETOK); float* EW = (float*)(p.ws + WS_EW);
    int wper = (tokB - tokA + 7) / 8; wper += wper & 1; const int wA = tokA + wid * wper, wB = wA + wper < tokB ? wA + wper : tokB;
    const bf16_t* XB1 = (const bf16_t*)(p.ws + WS_XB1);
    float ma[32], mb[32]; int curmr = -1;
    u32x4 nxr[4];
#define N2_LOADRAW(tk) do { _Pragma("unroll") for (int jj = 0; jj < 4; ++jj) nxr[jj] = *(const u32x4*)(XB1 + (size_t)(tk) * D + jj * 256 + l5 * 8); } while (0)
    if (wA < wB && wA < TL) N2_LOADRAW(wA + half);
    for (int tok0 = wA; tok0 < wB; tok0 += 2) {
        const int tok = tok0 + half;
        float x[32];
        if (tok0 < TL) {
#pragma unroll
            for (int jj = 0; jj < 4; ++jj) { float t8[8]; unpk8(nxr[jj], t8);
#pragma unroll
                for (int i = 0; i < 8; ++i) x[jj * 8 + i] = t8[i]; }
            if (tok0 + 2 < wB) N2_LOADRAW(tok + 2);
        } else {
#pragma unroll
            for (int jj = 0; jj < 4; ++jj) { const f32x4 a0 = *(const f32x4*)(XC + (size_t)(tok - TL) * D + jj * 256 + l5 * 8), a1 = *(const f32x4*)(XC + (size_t)(tok - TL) * D + jj * 256 + l5 * 8 + 4);
                x[jj * 8] = a0[0]; x[jj * 8 + 1] = a0[1]; x[jj * 8 + 2] = a0[2]; x[jj * 8 + 3] = a0[3]; x[jj * 8 + 4] = a1[0]; x[jj * 8 + 5] = a1[1]; x[jj * 8 + 6] = a1[2]; x[jj * 8 + 7] = a1[3]; }
        }
        const int mr = tok0 < TL ? tok0 / SEQ : 32;
        if (mr != curmr) { const float* m = modrow(p, l, mr); const float* g = p.in[I_N2G] + l * D;
#pragma unroll
            for (int jj = 0; jj < 4; ++jj)
#pragma unroll
                for (int q = 0; q < 2; ++q) { const int k = jj * 256 + l5 * 8 + 4 * q; const f32x4 gv = *(const f32x4*)(g + k), sv = *(const f32x4*)(m + 4096 + k), hv = *(const f32x4*)(m + 3072 + k);
#pragma unroll
                    for (int e = 0; e < 4; ++e) { ma[jj * 8 + 4 * q + e] = gv[e] * (1.f + sv[e]); mb[jj * 8 + 4 * q + e] = hv[e]; } }
            curmr = mr; }
        float ss = 0.f;
#pragma unroll
        for (int i = 0; i < 32; ++i) ss += x[i] * x[i];
        ss = half_sum32(ss);
        const float rstd = rsqrtf(ss * (1.f / 1024.f) + EPS);
#pragma unroll
        for (int i = 0; i < 32; ++i) x[i] = x[i] * rstd * ma[i] + mb[i];
#pragma unroll
        for (int jj = 0; jj < 4; ++jj) { u32x4 w; w.x = pk_bf16(x[jj * 8], x[jj * 8 + 1]); w.y = pk_bf16(x[jj * 8 + 2], x[jj * 8 + 3]); w.z = pk_bf16(x[jj * 8 + 4], x[jj * 8 + 5]); w.w = pk_bf16(x[jj * 8 + 6], x[jj * 8 + 7]);
            *(u32x4*)(ACT + (size_t)tok * D + jj * 256 + l5 * 8) = w; }
        float lg[4] = {0.f, 0.f, 0.f, 0.f};
#pragma unroll
        for (int jj = 0; jj < 4; ++jj)
#pragma unroll
            for (int i = 0; i < 8; ++i) { const f32x4 wv = *(const LAS f32x4*)(lds + 131072 + ((jj * 8 + i) * 32 + l5) * 16); const float fv = x[jj * 8 + i]; lg[0] += fv * wv[0]; lg[1] += fv * wv[1]; lg[2] += fv * wv[2]; lg[3] += fv * wv[3]; }
#pragma unroll
        for (int j = 0; j < 4; ++j) lg[j] = half_sum32(lg[j]);
        int gi = 0; float gm = lg[0];
#pragma unroll
        for (int j = 1; j < 4; ++j) if (lg[j] > gm) { gm = lg[j]; gi = j; }
        float den = 0.f;
#pragma unroll
        for (int j = 0; j < 4; ++j) den += __builtin_amdgcn_exp2f((lg[j] - gm) * 1.4426950408889634f);
        const float gval = 1.f / den;
        float el[8] = {0.f, 0.f, 0.f, 0.f, 0.f, 0.f, 0.f, 0.f};
        const int c0 = ((gi * 2) ^ (l5 & 7)) * 16, c1 = ((gi * 2 + 1) ^ (l5 & 7)) * 16;
#pragma unroll
        for (int jj = 0; jj < 4; ++jj)
#pragma unroll
            for (int i = 0; i < 8; ++i) { const LAS unsigned char* wr = lds + (jj * 256 + l5 * 8 + i) * 128; const f32x4 w0 = *(const LAS f32x4*)(wr + c0), w1 = *(const LAS f32x4*)(wr + c1); const float fv = x[jj * 8 + i];
                el[0] += fv * w0[0]; el[1] += fv * w0[1]; el[2] += fv * w0[2]; el[3] += fv * w0[3]; el[4] += fv * w1[0]; el[5] += fv * w1[1]; el[6] += fv * w1[2]; el[7] += fv * w1[3]; }
#pragma unroll
        for (int j = 0; j < 8; ++j) el[j] = half_sum32(el[j]);
        int i1 = 0; float m1 = el[0];
#pragma unroll
        for (int j = 1; j < 8; ++j) if (el[j] > m1) { m1 = el[j]; i1 = j; }
        int i2 = -1; float m2 = -3.0e38f;
#pragma unroll
        for (int j = 0; j < 8; ++j) if (j != i1 && el[j] > m2) { m2 = el[j]; i2 = j; }
        const float e2 = __builtin_amdgcn_exp2f((m2 - m1) * 1.4426950408889634f); const float w1v = gval / (1.f + e2), w2v = gval * e2 / (1.f + e2);
        if (l5 == 0) {
            const int ea = gi * 8 + i1, eb = gi * 8 + i2;
            const unsigned ra = __hip_atomic_fetch_add(&lcnt[ea], 1u, __ATOMIC_RELAXED, __HIP_MEMORY_SCOPE_WORKGROUP), rb = __hip_atomic_fetch_add(&lcnt[eb], 1u, __ATOMIC_RELAXED, __HIP_MEMORY_SCOPE_WORKGROUP);
            info[(tok - tokA) * 2] = (unsigned)ea | (ra << 8); info[(tok - tokA) * 2 + 1] = (unsigned)eb | (rb << 8); EW[tok * 2] = w1v; EW[tok * 2 + 1] = w2v;
        }
    }
#undef N2_LOADRAW
    __syncthreads();
    if (tid < 32) lbase[tid] = __hip_atomic_fetch_add(&cnt[tid], lcnt[tid], __ATOMIC_RELAXED, __HIP_MEMORY_SCOPE_AGENT);
    __syncthreads();
    for (int idx = tid; idx < (tokB - tokA) * 2; idx += 512) { const unsigned inf = info[idx]; const unsigned e = inf & 0xffu, r = inf >> 8; ETOK[(size_t)e * CAPE + lbase[e] + r] = (tokA + (idx >> 1)) * 2 + (idx & 1); }
}

DI void phase_combine(CPARAMS p, int l) {
    const int lane = ltid() & 63; const int w = blockIdx.x * 8 + __builtin_amdgcn_readfirstlane(ltid() >> 6), nw = gridDim.x * 8; const int M = l == 0 ? T : TL;
    const bf16_t* Y = (const bf16_t*)(p.ws + WS_YTOK); bf16_t* ACT = (bf16_t*)(p.ws + WS_ACT); float* XC = (float*)(p.ws + WS_XC);
    const float* TW = (const float*)(p.ws + WS_EW);
    const int per = (M + nw - 1) / nw; const int tA = w * per, tB = tA + per < M ? tA + per : M;
    ModVec mv; float g2v[16]; int curmr = -1;
    f32x4 cur[4], nx[4]; u32x2 cy0[4], cy1[4], ny0[4], ny1[4];
#define CB_LOAD(tk, xv_, y0_, y1_) do { if ((tk) < TL) ld_row_bf((const bf16_t*)(p.ws + WS_XB1) + (size_t)(tk) * D, lane, xv_); else ld_row(XC + (size_t)((tk) - TL) * D, lane, xv_); \
        _Pragma("unroll") for (int j = 0; j < 4; ++j) { y0_[j] = *(const u32x2*)(Y + (size_t)((tk) * 2) * D + j * 256 + lane * 4); y1_[j] = *(const u32x2*)(Y + (size_t)((tk) * 2 + 1) * D + j * 256 + lane * 4); } } while (0)
    if (tA < tB) CB_LOAD(tA, cur, cy0, cy1);
    for (int tok = tA; tok < tB; ++tok) {
        if (tok + 1 < tB) CB_LOAD(tok + 1, nx, ny0, ny1);
        const int mr = tok < TL ? tok / SEQ : 32;
        if (mr != curmr) { const float* g2 = modrow(p, l, mr) + 5120;
#pragma unroll
            for (int j = 0; j < 4; ++j) { const f32x4 gv = *(const f32x4*)(g2 + j * 256 + lane * 4); g2v[j * 4] = gv[0]; g2v[j * 4 + 1] = gv[1]; g2v[j * 4 + 2] = gv[2]; g2v[j * 4 + 3] = gv[3]; }
            if (l == 0) { const float* m = modrow(p, 1, mr); load_modvec(p.in[I_N1G] + D, m, m + 1024, lane, mv); }
            curmr = mr; }
        const float tw0 = TW[tok * 2], tw1 = TW[tok * 2 + 1];
        f32x4 o[4];
#pragma unroll
        for (int j = 0; j < 4; ++j) {
            float ya[4], yb[4]; unpk4(cy0[j], ya); unpk4(cy1[j], yb);
#pragma unroll
            for (int q = 0; q < 4; ++q) o[j][q] = cur[j][q] + g2v[j * 4 + q] * (tw0 * ya[q] + tw1 * yb[q]);
            if (tok >= TL) *(f32x4*)(XC + (size_t)(tok - TL) * D + j * 256 + lane * 4) = o[j];
            else if (l == 1) *(f32x4*)(p.out + (size_t)tok * D + j * 256 + lane * 4) = o[j];
            else { u32x2 w; w.x = pk_bf16(o[j][0], o[j][1]); w.y = pk_bf16(o[j][2], o[j][3]); *(u32x2*)((bf16_t*)p.out + (size_t)tok * D + j * 256 + lane * 4) = w; }
        }
        if (l == 0) { float f[16]; norm_store(o, mv, ACT + (size_t)tok * D, lane, f); }
#pragma unroll
        for (int j = 0; j < 4; ++j) { cur[j] = nx[j]; cy0[j] = ny0[j]; cy1[j] = ny1[j]; }
    }
#undef CB_LOAD
}

namespace gp {
#define GP_LAS __attribute__((address_space(3)))
constexpr int BM = 256, BK = 64, HALF = 128, HTB = HALF * BK * 2, STAGE_BYTES = 8 * HTB, NXCD = 8, WGM = 8;
__host__ __device__ __forceinline__ int lds_byte(int r, int c) { const int st = (r >> 4) * 2 + (c >> 5), rr = r & 15, cc = c & 31, ob = rr * 64 + cc * 2; return st * 1024 + (ob ^ (((ob >> 9) & 1) << 5)); }
__host__ __device__ __forceinline__ void stage_rc(int b, int& R, int& C) { const int st = b / 1024, sb = b % 1024, swz = sb ^ (((sb >> 9) & 1) << 5); R = (st >> 1) * 16 + swz / 64; C = (st & 1) * 32 + (swz % 64) / 2; }
__host__ __device__ __forceinline__ int perm32(int rho) { const int n = rho >> 4, i = rho & 15; return 8 * (i >> 2) + 4 * n + (i & 3); }
__device__ __forceinline__ unsigned cvt_pk_bf16(float lo, float hi) { unsigned r; asm volatile("v_cvt_pk_bf16_f32 %0, %1, %2" : "=v"(r) : "v"(lo), "v"(hi)); return r; }

struct Unit { int pm, pn, e, pos0, nvalid; };

struct StaticOrder {
    int nM, nN, nwg, G, c;
    __device__ void init(int nM_, int nN_, int G_, int c_) { nM = nM_; nN = nN_; nwg = nM * nN; G = G_; c = c_; }
    __device__ bool next(int i, Unit& u) const {
        const long L = (long)i * G + c; if (L >= nwg) return false;
        int wgid = (int)L; { const int q = nwg / NXCD, r = nwg % NXCD, xcd = wgid % NXCD, off = wgid / NXCD; wgid = (xcd < r ? xcd * (q + 1) : r * (q + 1) + (xcd - r) * q) + off; }
        const int nig = WGM * nN, gid = wgid / nig, fm = gid * WGM, gsz = (nM - fm) < WGM ? (nM - fm) : WGM;
        u.pm = fm + ((wgid % nig) % gsz); u.pn = (wgid % nig) / gsz; u.e = 0; u.pos0 = 0; u.nvalid = 256; return true;
    }
};
struct CtxTrimOrder {
    StaticOrder so; int nlat, nct, ctxmask, nN, G, c;
    __device__ void init(int nN_, int ctxmask_, int G_, int c_) { nN = nN_; ctxmask = ctxmask_; nct = __popc(ctxmask_); G = G_; c = c_; so.init(TL / 256, nN_, G_, c_); nlat = (TL / 256) * nN_; }
    __device__ bool next(int i, Unit& u) const {
        const long L = (long)i * G + c;
        if (L < nlat) return so.next(i, u);
        const int r = (int)(L - nlat); if (r >= (TC / 256) * nct) return false;
        const int pmc = r / nct; int k = r % nct, pn = 0;
        for (int b = 0; b < nN; ++b) if ((ctxmask >> b) & 1) { if (k == 0) { pn = b; break; } --k; }
        u.pm = TL / 256 + pmc; u.pn = pn; u.e = 0; u.pos0 = 0; u.nvalid = 256; return true;
    }
};
struct MoeOrder {
    StaticOrder so; const LAS unsigned* tab;
    __device__ void init(const LAS unsigned* tab_, int nN, int G, int c) { tab = tab_; so.init(__builtin_amdgcn_readfirstlane((int)tab_[32]), nN, G, c); }
    __device__ bool next(int i, Unit& u) const {
        if (!so.next(i, u)) return false;
        const int lane = threadIdx.x & 63;
        const unsigned bs = tab[lane & 31];
        const unsigned long long m = __ballot(lane < 32 && bs <= (unsigned)u.pm);
        const int e = __popcll(m) - 1;
        const int b0 = __builtin_amdgcn_readfirstlane((int)tab[e]), cn = __builtin_amdgcn_readfirstlane((int)tab[64 + e]);
        u.e = e; u.pos0 = (u.pm - b0) * 256; const int rem = cn - u.pos0; u.nvalid = rem < 256 ? rem : 256; return true;
    }
};
DI void moe_table(const unsigned* cnt, LAS unsigned* tab) {
    const int tid = ltid();
    if (tid < 64) {
        const unsigned cv = tid < 32 ? cnt[tid] : 0u; unsigned nb = (cv + 255u) >> 8, incl = nb;
#pragma unroll
        for (int o = 1; o < 32; o <<= 1) { const unsigned t = __shfl_up(incl, o); if ((tid & 63) >= o) incl += t; }
        if (tid < 32) { tab[tid] = incl - nb; tab[64 + tid] = cv; }
        if (tid == 31) tab[32] = incl;
    }
}
struct SrcPlain {
    static constexpr bool GATHER = false;
    const bf16_t* A; const bf16_t* Bt; int lda, K;
    __device__ __forceinline__ const char* a_base(const Unit& u) const { return (const char*)A + (size_t)u.pm * 256 * lda * 2; }
    __device__ __forceinline__ const char* b_base(const Unit& u) const { return (const char*)Bt + (size_t)u.pn * 256 * K * 2; }
    __device__ __forceinline__ unsigned a_off(const Unit&, int, int) const { return 0u; }
    __device__ __forceinline__ int a_raw(const Unit&, int) const { return 0; }
    __device__ __forceinline__ unsigned a_fin(int, int) const { return 0u; }
};
struct SrcUp {
    static constexpr bool GATHER = false;
    const bf16_t* A; const bf16_t* Bt; int lda, K;
    __device__ __forceinline__ const char* a_base(const Unit& u) const { return (const char*)A + ((size_t)(u.pn >= 2 ? 1 : 0) * T + (size_t)u.pm * 256) * 256 * 2; }
    __device__ __forceinline__ const char* b_base(const Unit& u) const { return (const char*)Bt + (size_t)u.pn * 256 * K * 2; }
    __device__ __forceinline__ unsigned a_off(const Unit&, int, int) const { return 0u; }
    __device__ __forceinline__ int a_raw(const Unit&, int) const { return 0; }
    __device__ __forceinline__ unsigned a_fin(int, int) const { return 0u; }
};
struct SrcMoe2 {
    static constexpr bool GATHER = false;
    const bf16_t* A; const bf16_t* Bt; int lda, K;
    __device__ __forceinline__ const char* a_base(const Unit& u) const { return (const char*)A + (size_t)u.pm * 256 * lda * 2; }
    __device__ __forceinline__ const char* b_base(const Unit& u) const { return (const char*)Bt + ((size_t)u.e * 1024 + (size_t)u.pn * 256) * K * 2; }
    __device__ __forceinline__ unsigned a_off(const Unit&, int, int) const { return 0u; }
    __device__ __forceinline__ int a_raw(const Unit&, int) const { return 0; }
    __device__ __forceinline__ unsigned a_fin(int, int) const { return 0u; }
};
struct SrcMoe1 {
    static constexpr bool GATHER = true;
    const bf16_t* A; const bf16_t* Bt; int lda, K; const int* etok;
    __device__ __forceinline__ const char* a_base(const Unit&) const { return (const char*)A; }
    __device__ __forceinline__ const char* b_base(const Unit& u) const { return (const char*)Bt + ((size_t)u.e * 1024 + (size_t)u.pn * 256) * K * 2; }
    __device__ __forceinline__ unsigned a_off(const Unit& u, int r, int c) const {
        const int tok = r < u.nvalid ? (etok[(size_t)u.e * CAPE + u.pos0 + r] >> 1) : 0; return (unsigned)(tok * lda + c) * 2u; }
    __device__ __forceinline__ int a_raw(const Unit& u, int r) const { const int rr = r < u.nvalid ? r : u.nvalid - 1; return etok[(size_t)u.e * CAPE + u.pos0 + rr]; }
    __device__ __forceinline__ unsigned a_fin(int raw, int c) const { return (unsigned)((raw >> 1) * lda + c) * 2u; }
};

struct EpiBf16 {
    static constexpr bool PERM = true;
    bf16_t* O; int ldc;
    __device__ __forceinline__ void operator()(const f32x4 (&acc)[2][2][4][2], const Unit& u, int wr, int wc, int fr, int fq) const {
        const int row0 = u.pm * BM + wr * 64 + fr, col0 = u.pn * BM + wc * 32 + 8 * fq;
#pragma unroll
        for (int ai = 0; ai < 2; ++ai)
#pragma unroll
            for (int m = 0; m < 4; ++m) { bf16_t* rowp = O + (size_t)(row0 + ai * HALF + m * 16) * ldc + col0;
#pragma unroll
                for (int bj = 0; bj < 2; ++bj) { const f32x4 v0 = acc[ai][bj][m][0], v1 = acc[ai][bj][m][1];
                    u32x4 w; w.x = cvt_pk_bf16(v0[0], v0[1]); w.y = cvt_pk_bf16(v0[2], v0[3]); w.z = cvt_pk_bf16(v1[0], v1[1]); w.w = cvt_pk_bf16(v1[2], v1[3]);
                    *(u32x4*)(rowp + bj * HALF) = w; } }
    }
};
struct EpiZ {
    static constexpr bool PERM = true;
    bf16_t* O;
    __device__ __forceinline__ void operator()(const f32x4 (&acc)[2][2][4][2], const Unit& u, int wr, int wc, int fr, int fq) const {
        const int row0 = u.pm * BM + wr * 64 + fr, col0 = wc * 32 + 8 * fq; bf16_t* base = O + (size_t)u.pn * T * 256;
#pragma unroll
        for (int ai = 0; ai < 2; ++ai)
#pragma unroll
            for (int m = 0; m < 4; ++m) { bf16_t* rowp = base + (size_t)(row0 + ai * HALF + m * 16) * 256 + col0;
#pragma unroll
                for (int bj = 0; bj < 2; ++bj) { const f32x4 v0 = acc[ai][bj][m][0], v1 = acc[ai][bj][m][1];
                    u32x4 w; w.x = cvt_pk_bf16(v0[0], v0[1]); w.y = cvt_pk_bf16(v0[2], v0[3]); w.z = cvt_pk_bf16(v1[0], v1[1]); w.w = cvt_pk_bf16(v1[2], v1[3]);
                    *(u32x4*)(rowp + bj * HALF) = w; } }
    }
};
struct EpiResid {
    static constexpr bool PERM = true;
    const float* xinLf; const bf16_t* xinLb; bf16_t* outLb; const float* xinC; float* outC; const float* mod;
    template <int MODE>
    __device__ __forceinline__ void run(const f32x4 (&acc)[2][2][4][2], size_t ro0, const f32x4 (&gv)[2][2]) const {
#pragma unroll
        for (int ai = 0; ai < 2; ++ai) {
            if constexpr (MODE == 2) {
                u32x4 xw[4][2];
#pragma unroll
                for (int m = 0; m < 4; ++m)
#pragma unroll
                    for (int bj = 0; bj < 2; ++bj) xw[m][bj] = *(const u32x4*)(xinLb + ro0 + (size_t)(ai * HALF + m * 16) * D + bj * HALF);
#pragma unroll
                for (int m = 0; m < 4; ++m)
#pragma unroll
                    for (int bj = 0; bj < 2; ++bj) { const u32x4 w = xw[m][bj];
                        f32x4 x0 = (f32x4){__uint_as_float(w.x << 16), __uint_as_float(w.x & 0xffff0000u), __uint_as_float(w.y << 16), __uint_as_float(w.y & 0xffff0000u)};
                        f32x4 x1 = (f32x4){__uint_as_float(w.z << 16), __uint_as_float(w.z & 0xffff0000u), __uint_as_float(w.w << 16), __uint_as_float(w.w & 0xffff0000u)};
                        x0 = x0 + gv[bj][0] * acc[ai][bj][m][0]; x1 = x1 + gv[bj][1] * acc[ai][bj][m][1];
                        u32x4 o; o.x = cvt_pk_bf16(x0[0], x0[1]); o.y = cvt_pk_bf16(x0[2], x0[3]); o.z = cvt_pk_bf16(x1[0], x1[1]); o.w = cvt_pk_bf16(x1[2], x1[3]);
                        *(u32x4*)(outLb + ro0 + (size_t)(ai * HALF + m * 16) * D + bj * HALF) = o; }
            } else {
                const float* xin = MODE == 0 ? xinC : xinLf;
                f32x4 xv[4][2][2];
#pragma unroll
                for (int m = 0; m < 4; ++m)
#pragma unroll
                    for (int bj = 0; bj < 2; ++bj) { const float* src = xin + ro0 + (size_t)(ai * HALF + m * 16) * D + bj * HALF; xv[m][bj][0] = *(const f32x4*)src; xv[m][bj][1] = *(const f32x4*)(src + 4); }
#pragma unroll
                for (int m = 0; m < 4; ++m)
#pragma unroll
                    for (int bj = 0; bj < 2; ++bj) { const size_t ro = ro0 + (size_t)(ai * HALF + m * 16) * D + bj * HALF;
                        const f32x4 x0 = xv[m][bj][0] + gv[bj][0] * acc[ai][bj][m][0], x1 = xv[m][bj][1] + gv[bj][1] * acc[ai][bj][m][1];
                        if constexpr (MODE == 0) { *(f32x4*)(outC + ro) = x0; *(f32x4*)(outC + ro + 4) = x1; }
                        else { u32x4 o; o.x = cvt_pk_bf16(x0[0], x0[1]); o.y = cvt_pk_bf16(x0[2], x0[3]); o.z = cvt_pk_bf16(x1[0], x1[1]); o.w = cvt_pk_bf16(x1[2], x1[3]); *(u32x4*)(outLb + ro) = o; } }
            }
        }
    }
    __device__ __forceinline__ void operator()(const f32x4 (&acc)[2][2][4][2], const Unit& u, int wr, int wc, int fr, int fq) const {
        const int trow = u.pm * BM; const bool lat = trow < TL;
        const float* g1 = mod + (size_t)(lat ? trow / SEQ : 32) * 6144 + 2048;
        const int row0 = wr * 64 + fr, col0 = u.pn * BM + wc * 32 + 8 * fq;
        f32x4 gv[2][2];
#pragma unroll
        for (int bj = 0; bj < 2; ++bj)
#pragma unroll
            for (int n = 0; n < 2; ++n) gv[bj][n] = *(const f32x4*)(g1 + col0 + bj * HALF + 4 * n);
        const size_t ro0 = (size_t)(lat ? trow : trow - TL) * D + (size_t)row0 * D + col0;
        if (!lat) run<0>(acc, ro0, gv); else if (xinLf) run<1>(acc, ro0, gv); else run<2>(acc, ro0, gv);
    }
};
__device__ __forceinline__ float silu_fast(float v) { return v * __builtin_amdgcn_rcpf(1.f + __builtin_amdgcn_exp2f(-1.4426950408889634f * v)); }
struct EpiMoeH {
    static constexpr bool PERM = true;
    bf16_t* H;
    __device__ __forceinline__ void operator()(const f32x4 (&acc)[2][2][4][2], const Unit& u, int wr, int wc, int fr, int fq) const {
        const int row0 = u.pm * BM + wr * 64 + fr, col0 = u.pn * HALF + wc * 32 + 8 * fq;
#pragma unroll
        for (int ai = 0; ai < 2; ++ai)
#pragma unroll
            for (int m = 0; m < 4; ++m) {
                float h[8];
#pragma unroll
                for (int n = 0; n < 2; ++n)
#pragma unroll
                    for (int q = 0; q < 4; ++q) h[n * 4 + q] = silu_fast(acc[ai][0][m][n][q]) * acc[ai][1][m][n][q];
                u32x4 w; w.x = cvt_pk_bf16(h[0], h[1]); w.y = cvt_pk_bf16(h[2], h[3]); w.z = cvt_pk_bf16(h[4], h[5]); w.w = cvt_pk_bf16(h[6], h[7]);
                *(u32x4*)(H + (size_t)(row0 + ai * HALF + m * 16) * EFF + col0) = w; }
    }
};
struct EpiMoeY {
    static constexpr bool PERM = true;
    bf16_t* Y; const int* etok;
    __device__ __forceinline__ void operator()(const f32x4 (&acc)[2][2][4][2], const Unit& u, int wr, int wc, int fr, int fq) const {
        const int col0 = u.pn * BM + wc * 32 + 8 * fq;
        int dst[2][4];
#pragma unroll
        for (int ai = 0; ai < 2; ++ai)
#pragma unroll
            for (int m = 0; m < 4; ++m) { const int r = ai * HALF + wr * 64 + m * 16 + fr; const int rr = r < u.nvalid ? r : u.nvalid - 1; dst[ai][m] = etok[(size_t)u.e * CAPE + u.pos0 + rr]; }
#pragma unroll
        for (int ai = 0; ai < 2; ++ai)
#pragma unroll
            for (int m = 0; m < 4; ++m) {
                const int r = ai * HALF + wr * 64 + m * 16 + fr;
                if (r < u.nvalid) {
                    bf16_t* rowp = Y + (size_t)dst[ai][m] * D + col0;
#pragma unroll
                    for (int bj = 0; bj < 2; ++bj) { const f32x4 v0 = acc[ai][bj][m][0], v1 = acc[ai][bj][m][1];
                        u32x4 w; w.x = cvt_pk_bf16(v0[0], v0[1]); w.y = cvt_pk_bf16(v0[2], v0[3]); w.z = cvt_pk_bf16(v1[0], v1[1]); w.w = cvt_pk_bf16(v1[2], v1[3]);
                        *(u32x4*)(rowp + bj * HALF) = w; } } }
    }
};

template <class Epi, class Sched, class Src>
__device__ __forceinline__ void gemm_phase(GP_LAS unsigned char* lds, const Sched& S, const Src& src, const Epi& E) {
    const int tid = ltid(), wid = __builtin_amdgcn_readfirstlane(tid >> 6), lane = tid & 63, wr = wid >> 2, wc = wid & 3, fr = lane & 15, fq = lane >> 4;
    const int K = src.K, nt = K / BK;
    int sR[2], sC[2]; unsigned voffA[2], voffB[2];
#pragma unroll
    for (int i = 0; i < 2; ++i) { int R, C; stage_rc(tid * 16 + i * 8192, R, C); sR[i] = R; sC[i] = C; const int Rb = Epi::PERM ? ((R & ~31) + perm32(R & 31)) : R;
        voffA[i] = (unsigned)(R * src.lda + C) * 2u; voffB[i] = (unsigned)(Rb * K + C) * 2u; }
    const size_t kstep = (size_t)(BK * 2);
    const size_t hstepA = (size_t)HALF * src.lda * 2, hstepB = (size_t)HALF * K * 2;
    const unsigned ldsw = (unsigned)wid * 1024u;
    const int aoff = lds_byte(wr * 64 + fr, fq * 8), boff = lds_byte(wc * 32 + fr, fq * 8);
#define GP_SA(b, h) (((b) * 2 + (h)) * HTB)
#define GP_SB(b, h) ((4 + (b) * 2 + (h)) * HTB)
#define GP_STAGE_A(b, h, kb, nx) do { _Pragma("unroll") for (int _i = 0; _i < 2; ++_i) { const char* _g; \
        if constexpr (Src::GATHER) _g = cA + (kb) + ((nx) ? nofs[h][_i] : cofs[h][_i]); \
        else _g = ((nx) ? nA : cA) + (size_t)(h) * hstepA + (kb) + voffA[_i]; \
        __builtin_amdgcn_global_load_lds((const unsigned*)_g, (GP_LAS unsigned*)(lds + GP_SA(b, h) + ldsw + _i * 8192), 16, 0, 0); } } while (0)
#define GP_STAGE_B(b, h, kb, nx) do { _Pragma("unroll") for (int _i = 0; _i < 2; ++_i) { const char* _g = ((nx) ? nB : cB) + (size_t)(h) * hstepB + (kb) + voffB[_i]; \
        __builtin_amdgcn_global_load_lds((const unsigned*)_g, (GP_LAS unsigned*)(lds + GP_SB(b, h) + ldsw + _i * 8192), 16, 0, 0); } } while (0)
#define GP_LDA(dst, b, h) do { _Pragma("unroll") for (int m = 0; m < 4; ++m) _Pragma("unroll") for (int k = 0; k < 2; ++k) dst[m][k] = *(const GP_LAS bf16x8*)(lds + GP_SA(b, h) + aoff + m * 2048 + k * 1024); } while (0)
#define GP_LDB(dst, b, h) do { _Pragma("unroll") for (int n = 0; n < 2; ++n) _Pragma("unroll") for (int k = 0; k < 2; ++k) dst[n][k] = *(const GP_LAS bf16x8*)(lds + GP_SB(b, h) + boff + n * 2048 + k * 1024); } while (0)
#define GP_MMA(ai, bj, At, Bt) do { __builtin_amdgcn_s_setprio(1); _Pragma("unroll") for (int m = 0; m < 4; ++m) _Pragma("unroll") for (int n = 0; n < 2; ++n) _Pragma("unroll") for (int k = 0; k < 2; ++k) \
        acc[ai][bj][m][n] = __builtin_amdgcn_mfma_f32_16x16x32_bf16(Bt[n][k], At[m][k], acc[ai][bj][m][n], 0, 0, 0); __builtin_amdgcn_s_setprio(0); } while (0)
#define GP_WAIT_V(n) asm volatile("s_waitcnt vmcnt(" #n ")" ::: "memory")
#define GP_WAIT_L(n) asm volatile("s_waitcnt lgkmcnt(" #n ")" ::: "memory")
#define GP_BAR __builtin_amdgcn_s_barrier()
#define GP_SCHED __builtin_amdgcn_sched_barrier(0)
    Unit cur, nxt; int ui = 0;
    if (!S.next(0, cur)) return;
    f32x4 acc[2][2][4][2];
#pragma unroll
    for (int a = 0; a < 2; ++a)
#pragma unroll
        for (int b = 0; b < 2; ++b)
#pragma unroll
            for (int m = 0; m < 4; ++m)
#pragma unroll
                for (int n = 0; n < 2; ++n) acc[a][b][m][n] = (f32x4){0.f, 0.f, 0.f, 0.f};
    bf16x8 At[4][2], B0[2][2], B1[2][2];
    const char* cA = src.a_base(cur); const char* cB = src.b_base(cur);
    const char* nA = cA; const char* nB = cB;
    unsigned cofs[2][2], nofs[2][2]; int nraw[2][2] = {{0, 0}, {0, 0}};
#pragma unroll
    for (int h = 0; h < 2; ++h)
#pragma unroll
        for (int i = 0; i < 2; ++i) { cofs[h][i] = Src::GATHER ? src.a_off(cur, h * HALF + sR[i], sC[i]) : 0u; nofs[h][i] = cofs[h][i]; }
    GP_STAGE_B(0, 0, 0, false); GP_STAGE_B(0, 1, 0, false); GP_STAGE_A(0, 0, 0, false); GP_STAGE_A(0, 1, 0, false);
    if (wr == 1) GP_BAR;
    GP_WAIT_V(2); GP_BAR;
    GP_STAGE_B(1, 0, kstep, false); GP_STAGE_A(1, 0, kstep, false); GP_STAGE_B(1, 1, kstep, false);
    GP_WAIT_V(6); GP_BAR;
    for (;;) {
        const bool has_next = S.next(ui + 1, nxt);
        if (has_next) { nA = src.a_base(nxt); nB = src.b_base(nxt);
            if constexpr (Src::GATHER) { const int t2 = ltid();
#pragma unroll
                for (int i = 0; i < 2; ++i) { int R, C; stage_rc(t2 * 16 + i * 8192, R, C);
#pragma unroll
                    for (int h = 0; h < 2; ++h) nraw[h][i] = src.a_raw(nxt, h * HALF + R); } }
        } else { nA = cA; nB = cB;
#pragma unroll
            for (int h = 0; h < 2; ++h)
#pragma unroll
                for (int i = 0; i < 2; ++i) nofs[h][i] = cofs[h][i]; }
        for (int t = 0; t < nt; t += 2) {
            const bool last = (t == nt - 2);
            if constexpr (Src::GATHER) { if (last && has_next) { const int t2 = ltid();
#pragma unroll
                    for (int i = 0; i < 2; ++i) { int R, C; stage_rc(t2 * 16 + i * 8192, R, C);
#pragma unroll
                        for (int h = 0; h < 2; ++h) nofs[h][i] = src.a_fin(nraw[h][i], C); } } }
            const size_t k1 = (size_t)(t + 1) * kstep, k2 = last ? 0 : (size_t)(t + 2) * kstep, k3 = k2 + kstep;
            GP_LDB(B0, 0, 0); GP_LDB(B1, 0, 1); GP_SCHED; GP_LDA(At, 0, 0); GP_STAGE_A(1, 1, k1, false);
            GP_WAIT_V(8); GP_WAIT_L(0); GP_BAR; GP_MMA(0, 0, At, B0); GP_MMA(0, 1, At, B1); GP_BAR; GP_SCHED;
            GP_LDA(At, 0, 1); GP_STAGE_B(0, 0, k2, last); GP_STAGE_B(0, 1, k2, last); GP_STAGE_A(0, 0, k2, last);
            GP_WAIT_V(8); GP_WAIT_L(0); GP_BAR; GP_MMA(1, 0, At, B0); GP_MMA(1, 1, At, B1); GP_BAR; GP_SCHED;
            GP_LDB(B0, 1, 0); GP_LDB(B1, 1, 1); GP_SCHED; GP_LDA(At, 1, 0); GP_STAGE_A(0, 1, k2, last);
            GP_WAIT_V(8); GP_WAIT_L(0); GP_BAR; GP_MMA(0, 0, At, B0); GP_MMA(0, 1, At, B1); GP_BAR; GP_SCHED;
            GP_LDA(At, 1, 1); GP_STAGE_B(1, 0, k3, last); GP_STAGE_B(1, 1, k3, last); GP_STAGE_A(1, 0, k3, last);
            GP_WAIT_V(8); GP_WAIT_L(0); GP_BAR; GP_MMA(1, 0, At, B0); GP_MMA(1, 1, At, B1); GP_BAR; GP_SCHED;
        }
        if (wr == 0) GP_BAR;
        E(acc, cur, wr, wc, fr, fq);
        if (!has_next) break;
#pragma unroll
        for (int a = 0; a < 2; ++a)
#pragma unroll
            for (int b = 0; b < 2; ++b)
#pragma unroll
                for (int m = 0; m < 4; ++m)
#pragma unroll
                    for (int n = 0; n < 2; ++n) acc[a][b][m][n] = (f32x4){0.f, 0.f, 0.f, 0.f};
        cur = nxt; cA = nA; cB = nB; ++ui;
#pragma unroll
        for (int h = 0; h < 2; ++h)
#pragma unroll
            for (int i = 0; i < 2; ++i) cofs[h][i] = nofs[h][i];
        if (wr == 1) GP_BAR;
    }
    GP_WAIT_V(0);
    GP_BAR;
#undef GP_SA
#undef GP_SB
#undef GP_STAGE_A
#undef GP_STAGE_B
#undef GP_LDA
#undef GP_LDB
#undef GP_MMA
#undef GP_WAIT_V
#undef GP_WAIT_L
#undef GP_BAR
#undef GP_SCHED
}
}

constexpr int LDS_BYTES = 163840;

DI void phase_inproj(CPARAMS p, int l, LAS unsigned char* lds) {
    gp::CtxTrimOrder S; S.init(ZW / 256, l == 0 ? 0x7ff : ((1 << 1) | (1 << 3) | (1 << 4) | (1 << 9)), gridDim.x, blockIdx.x);
    gp::SrcPlain src{(const bf16_t*)(p.ws + WS_ACT), (const bf16_t*)(p.ws + WS_WIN_T), D, D};
    gp::EpiZ E{(bf16_t*)(p.ws + WS_Z)};
    gp::gemm_phase(lds, S, src, E);
}
DI void phase_up(CPARAMS p, int l, LAS unsigned char* lds) {
    gp::CtxTrimOrder S; S.init(4, l == 0 ? 0xf : 0xc, gridDim.x, blockIdx.x);
    gp::SrcUp src{(const bf16_t*)(p.ws + WS_Z), (const bf16_t*)(p.ws + WS_WUP_T), 256, 256};
    gp::EpiBf16 E{(bf16_t*)(p.ws + WS_RAW), 1024};
    gp::gemm_phase(lds, S, src, E);
}
DI void phase_outproj(CPARAMS p, int l, LAS unsigned char* lds) {
    gp::StaticOrder S; S.init((l == 0 ? T : TL) / 256, D / 256, gridDim.x, blockIdx.x);
    gp::SrcPlain src{(const bf16_t*)(p.ws + WS_ACT), (const bf16_t*)(p.ws + WS_WOUT_T), D, D};
    gp::EpiResid E{l == 0 ? p.in[I_X] : nullptr, (const bf16_t*)p.out, (bf16_t*)(p.ws + WS_XB1), p.in[I_CTX], (float*)(p.ws + WS_XC), (const float*)(p.ws + WS_MOD) + (size_t)l * 33 * 6144};
    gp::gemm_phase(lds, S, src, E);
}
DI void phase_moe1(CPARAMS p, int l, LAS unsigned char* lds) {
    LAS unsigned* tab = (LAS unsigned*)(lds + gp::STAGE_BYTES);
    __syncthreads(); gp::moe_table((const unsigned*)(p.ws + WS_CTL) + CW_COUNT + l * 32, tab); __syncthreads();
    gp::MoeOrder S; S.init(tab, 4, gridDim.x, blockIdx.x);
    gp::SrcMoe1 src{(const bf16_t*)(p.ws + WS_ACT), (const bf16_t*)(p.ws + WS_W13_T), D, D, (const int*)(p.ws + WS_ETOK)};
    gp::EpiMoeH E{(bf16_t*)(p.ws + WS_H)};
    gp::gemm_phase(lds, S, src, E);
}
DI void phase_moe2(CPARAMS p, int l, LAS unsigned char* lds) {
    LAS unsigned* tab = (LAS unsigned*)(lds + gp::STAGE_BYTES);
    __syncthreads(); gp::moe_table((const unsigned*)(p.ws + WS_CTL) + CW_COUNT + l * 32, tab); __syncthreads();
    gp::MoeOrder S; S.init(tab, 4, gridDim.x, blockIdx.x);
    gp::SrcMoe2 src{(const bf16_t*)(p.ws + WS_H), (const bf16_t*)(p.ws + WS_W2_T), EFF, EFF};
    gp::EpiMoeY E{(bf16_t*)(p.ws + WS_YTOK), (const int*)(p.ws + WS_ETOK)};
    gp::gemm_phase(lds, S, src, E);
}


DI bf16x8 pack8(const f32x16& x, int s) { u32x4 p; p.x = pk_bf16(x[8 * s], x[8 * s + 1]); p.y = pk_bf16(x[8 * s + 2], x[8 * s + 3]); p.z = pk_bf16(x[8 * s + 4], x[8 * s + 5]); p.w = pk_bf16(x[8 * s + 6], x[8 * s + 7]); return __builtin_bit_cast(bf16x8, p); }
#define MFMA32(a, b, c) __builtin_amdgcn_mfma_f32_32x32x16_bf16((a), (b), (c), 0, 0, 0)
constexpr int AT_KP = 208, AT_VP = 264, AT_KBYTES = 128 * AT_KP, AT_VBYTES = 64 * AT_VP, AT_BUF = AT_KBYTES + AT_VBYTES;

DI void attn_unit(CPARAMS p, int bh, int q0, int key0, int nkt, LAS unsigned char* lds) {
    const int tid = ltid(), lane = tid & 63, wid = __builtin_amdgcn_readfirstlane(tid >> 6), h = lane >> 5, c = lane & 31;
    const bf16_t* Qg = (const bf16_t*)(p.ws + WS_Q) + ((size_t)bh * PALL + q0 + wid * 32 + c) * 96;
    const bf16_t* Kg = (const bf16_t*)(p.ws + WS_K) + ((size_t)bh * PALL + key0) * 96;
    const bf16_t* Vg = (const bf16_t*)(p.ws + WS_VT) + (size_t)bh * 64 * PALL + key0;
    bf16x8 qf[6];
#pragma unroll
    for (int s = 0; s < 6; ++s) qf[s] = *(const bf16x8*)(Qg + 16 * s + 8 * h);
    f32x16 o[2];
#pragma unroll
    for (int i = 0; i < 16; ++i) { o[0][i] = 0.f; o[1][i] = 0.f; }
    float m = 0.f, lsum = 0.f;
    u32x4 kreg[3], vreg[2];
    int krow[3], kpc[3], vd[2], vpc[2];
#pragma unroll
    for (int j = 0; j < 3; ++j) { const int pi = tid + 512 * j; krow[j] = pi / 12; kpc[j] = pi % 12; }
#pragma unroll
    for (int j = 0; j < 2; ++j) { const int pi = tid + 512 * j; vd[j] = pi >> 4; vpc[j] = pi & 15; }
#define AT_LOAD(t) do { _Pragma("unroll") for (int j = 0; j < 3; ++j) kreg[j] = *(const u32x4*)(Kg + (size_t)(128 * (t) + krow[j]) * 96 + kpc[j] * 8); \
        _Pragma("unroll") for (int j = 0; j < 2; ++j) vreg[j] = *(const u32x4*)(Vg + (size_t)vd[j] * PALL + 128 * (t) + vpc[j] * 8); } while (0)
#define AT_STORE(bs) do { LAS unsigned char* _b = lds + (bs) * AT_BUF; \
        _Pragma("unroll") for (int j = 0; j < 3; ++j) *(LAS u32x4*)(_b + krow[j] * AT_KP + kpc[j] * 16) = kreg[j]; \
        _Pragma("unroll") for (int j = 0; j < 2; ++j) { LAS unsigned char* _v = _b + AT_KBYTES + vd[j] * AT_VP + vpc[j] * 16; u32x2 lo = {vreg[j].x, vreg[j].y}, hi = {vreg[j].z, vreg[j].w}; *(LAS u32x2*)_v = lo; *(LAS u32x2*)(_v + 8) = hi; } } while (0)
    f32x16 st0, st1, NM;
    bf16x8 kf[6];
    u32x4 vf[4], pp[2];
#pragma unroll
    for (int j = 0; j < 4; ++j) vf[j] = u32x4{0u, 0u, 0u, 0u};
    pp[0] = u32x4{0u, 0u, 0u, 0u}; pp[1] = pp[0];
#define AT_SB() __builtin_amdgcn_sched_barrier(0)
#define AT_KLDP(ptr) do { _Pragma("unroll") for (int s = 0; s < 6; ++s) kf[s] = *(const LAS bf16x8*)((ptr) + 32 * s); } while (0)
#define AT_VLD(kt) do { _Pragma("unroll") for (int q = 0; q < 4; ++q) { \
            const LAS unsigned char* _v = vb0 + 32 * (q & 1) * AT_VP + (32 * (kt) + 16 * (q >> 1)) * 2; const u32x2 lo = *(const LAS u32x2*)_v, hi = *(const LAS u32x2*)(_v + 16); \
            vf[q] = u32x4{lo.x, lo.y, hi.x, hi.y}; } } while (0)
#define AT_PVQ(q) o[(q) & 1] = MFMA32(__builtin_bit_cast(bf16x8, vf[q]), __builtin_bit_cast(bf16x8, pp[(q) >> 1]), o[(q) & 1])
#define AT_STEP(i, SC, SN, KPTR) do { \
        AT_KLDP(KPTR); \
        AT_SB(); \
        _Pragma("unroll") for (int q = 0; q < 4; ++q) { \
            AT_PVQ(q); AT_SB(); \
            _Pragma("unroll") for (int j = 4 * q; j < 4 * q + 4; ++j) tmx = fmaxf(tmx, SC[j]); \
            AT_SB(); } \
        AT_VLD(i); \
        AT_SB(); \
        _Pragma("unroll") for (int s = 0; s < 6; ++s) { \
            SN = MFMA32(kf[s], qf[s], s == 0 ? NM : SN); AT_SB(); \
            constexpr int e0_[7] = {0, 3, 6, 9, 12, 14, 16}; \
            _Pragma("unroll") for (int j = e0_[s]; j < e0_[s + 1]; ++j) { const float e = __builtin_amdgcn_exp2f(SC[j]); SC[j] = e; lsum += e; } \
            _Pragma("unroll") for (int pr = e0_[s] / 2; pr < e0_[s + 1] / 2; ++pr) pp[pr >> 2][pr & 3] = pk_bf16(SC[2 * pr], SC[2 * pr + 1]); \
            AT_SB(); } \
    } while (0)
    __syncthreads();
    AT_LOAD(0); AT_STORE(0);
    if (nkt > 1) AT_LOAD(1);
    __syncthreads();
    {
        const LAS unsigned char* kb0 = lds + c * AT_KP + 16 * h;
        AT_KLDP(kb0);
#pragma unroll
        for (int j = 0; j < 16; ++j) st0[j] = 0.f;
#pragma unroll
        for (int s = 0; s < 6; ++s) st0 = MFMA32(kf[s], qf[s], st0);
        float mx = st0[0];
#pragma unroll
        for (int j = 1; j < 16; ++j) mx = fmaxf(mx, st0[j]);
        m = fmaxf(mx, __shfl_xor(mx, 32));
#pragma unroll
        for (int j = 0; j < 16; ++j) { st0[j] -= m; NM[j] = -m; }
    }
    int cb = 0;
    for (int t = 0; t < nkt; ++t) {
        const int nb = cb == 2 ? 0 : cb + 1;
        const LAS unsigned char* base = lds + cb * AT_BUF;
        const LAS unsigned char* kb0 = base + c * AT_KP + 16 * h;
        const LAS unsigned char* vb0 = base + AT_KBYTES + c * AT_VP + 8 * h;
        const LAS unsigned char* nkb0 = lds + nb * AT_BUF + c * AT_KP + 16 * h;
        float tmx = st0[0];
        AT_SB();
        AT_STEP(0, st0, st1, kb0 + 32 * 1 * AT_KP);
        AT_STEP(1, st1, st0, kb0 + 32 * 2 * AT_KP);
        if (t + 1 < nkt) { AT_STORE(nb); if (t + 2 < nkt) AT_LOAD(t + 2); }
        AT_SB();
        AT_STEP(2, st0, st1, kb0 + 32 * 3 * AT_KP);
        __syncthreads();
        AT_STEP(3, st1, st0, nkb0);
        if (__builtin_expect(!__all(tmx <= 8.0f), 0)) {
            AT_PVQ(0); AT_PVQ(1); AT_PVQ(2); AT_PVQ(3);
            pp[0] = u32x4{0u, 0u, 0u, 0u}; pp[1] = pp[0];
            tmx = fmaxf(tmx, __shfl_xor(tmx, 32));
            const float d = fmaxf(tmx, 0.f), alpha = __builtin_amdgcn_exp2f(-d);
            m += d; lsum *= alpha;
#pragma unroll
            for (int j = 0; j < 16; ++j) { o[0][j] *= alpha; o[1][j] *= alpha; NM[j] = -m; st0[j] -= d; }
        }
        cb = nb;
    }
    AT_PVQ(0); AT_PVQ(1); AT_PVQ(2); AT_PVQ(3);
#undef AT_LOAD
#undef AT_STORE
#undef AT_KLDP
#undef AT_VLD
#undef AT_STEP
#undef AT_SB
#undef AT_PVQ
    const float inv = 1.f / (lsum + __shfl_xor(lsum, 32));
    const int b = bh >> 2, hh = bh & 3, qpos = q0 + wid * 32 + c;
    const int tok = qpos < SEQ ? b * SEQ + qpos : TL + b * CTXL + (qpos - SEQ);
    bf16_t* YA = (bf16_t*)(p.ws + WS_YA) + (size_t)tok * 256 + hh * 64;
#pragma unroll
    for (int dt = 0; dt < 2; ++dt)
#pragma unroll
        for (int g = 0; g < 4; ++g) { u32x2 w; w.x = pk_bf16(o[dt][4 * g] * inv, o[dt][4 * g + 1] * inv); w.y = pk_bf16(o[dt][4 * g + 2] * inv, o[dt][4 * g + 3] * inv); *(u32x2*)(YA + 32 * dt + 8 * g + 4 * h) = w; }
}
DI void phase_attn(CPARAMS p, int l, LAS unsigned char* lds) {
    const int cI = blockIdx.x, xcd = cI & 7, j = cI >> 3;
    for (int r = 0; r < 4; ++r) { const int bh = r * 32 + xcd * 4 + (j >> 3), qb = j & 7; attn_unit(p, bh, qb * 256, 0, 18, lds); }
    if (l == 0 && cI < 128) attn_unit(p, cI, SEQ, SEQ, 2, lds);
}


constexpr int RT_QP = 144, RT_TP = 272;
constexpr int RT_QS = 0, RT_KS = 128 * RT_QP, RT_KT = 2 * 128 * RT_QP, RT_VT = RT_KT + 64 * RT_TP, RT_ST = RT_VT + 64 * RT_TP, RT_END = RT_ST + 64 * RT_QP;
DI int ret_tok(int b, int dir, int ci, int j) {
    if (ci < 2) { const int cp = 128 * ci + j; return TL + b * CTXL + (dir ? CTXL - 1 - cp : cp); }
    const int tp = 128 * (ci - 2) + j; return b * SEQ + (dir ? SEQ - 1 - tp : tp);
}
DI void ret_unit(CPARAMS p, int l, int b, int hh, int dir, LAS unsigned char* lds) {
    const int tid = ltid(), lane = tid & 63, wid = __builtin_amdgcn_readfirstlane(tid >> 6), h = lane >> 5, c = lane & 31;
    const float lg = p.in[I_RLG][(l * 2 + dir) * 4 + hh];
    const int jp = lane, dg = wid;
    const float qs[2] = {expf(lg * (float)(2 * jp)), expf(lg * (float)(2 * jp + 1))};
    const float ks[2] = {expf(-lg * (float)(2 * jp)) * 0.125f, expf(-lg * (float)(2 * jp + 1)) * 0.125f};
    const float gam = expf(lg), g127 = expf(lg * 127.f), g128 = expf(lg * 128.f);
    const bf16_t* Z = (const bf16_t*)(p.ws + WS_Z);
    bf16_t* OUT = (bf16_t*)(p.ws + (dir ? WS_OB : WS_OF));
    __syncthreads();
    for (int i = tid; i < 64 * RT_QP / 4; i += 512) ((LAS unsigned*)(lds + RT_ST))[i] = 0u;
    f32x16 sacc;
#pragma unroll
    for (int i = 0; i < 16; ++i) sacc[i] = 0.f;
    u32x4 rq2[2][2], rk2[2][2], rv2[2][2];
#define RT_LOAD(ci, rq, rk, rv) do { _Pragma("unroll") for (int r = 0; r < 2; ++r) { const size_t ro_ = zoff(ret_tok(b, dir, (ci), 2 * jp + r), ZC_RQ + hh * 64 + 8 * dg); \
        rq[r] = *(const u32x4*)(Z + ro_); rk[r] = *(const u32x4*)(Z + ro_ + (size_t)T * 256); rv[r] = *(const u32x4*)(Z + ro_ + (size_t)2 * T * 256); } } while (0)
#define RT_STORE(rq, rk, rv) do { u32x4 nk[2]; \
        _Pragma("unroll") for (int r = 0; r < 2; ++r) { u32x4 nq; \
            _Pragma("unroll") for (int d4 = 0; d4 < 4; ++d4) { const unsigned wq = rq[r][d4], wk = rk[r][d4]; \
                nq[d4] = pk_bf16(__uint_as_float(wq << 16) * qs[r], __uint_as_float(wq & 0xffff0000u) * qs[r]); \
                nk[r][d4] = pk_bf16(__uint_as_float(wk << 16) * ks[r], __uint_as_float(wk & 0xffff0000u) * ks[r]); } \
            *(LAS u32x4*)(lds + RT_QS + (2 * jp + r) * RT_QP + dg * 16) = nq; *(LAS u32x4*)(lds + RT_KS + (2 * jp + r) * RT_QP + dg * 16) = nk[r]; } \
        _Pragma("unroll") for (int d4 = 0; d4 < 4; ++d4) { \
            *(LAS unsigned*)(lds + RT_KT + (8 * dg + 2 * d4) * RT_TP + jp * 4) = (nk[0][d4] & 0xffffu) | (nk[1][d4] << 16); \
            *(LAS unsigned*)(lds + RT_KT + (8 * dg + 2 * d4 + 1) * RT_TP + jp * 4) = (nk[0][d4] >> 16) | (nk[1][d4] & 0xffff0000u); \
            *(LAS unsigned*)(lds + RT_VT + (8 * dg + 2 * d4) * RT_TP + jp * 4) = (rv[0][d4] & 0xffffu) | (rv[1][d4] << 16); \
            *(LAS unsigned*)(lds + RT_VT + (8 * dg + 2 * d4 + 1) * RT_TP + jp * 4) = (rv[0][d4] >> 16) | (rv[1][d4] & 0xffff0000u); } } while (0)
    RT_LOAD(0, rq2[0], rk2[0], rv2[0]); RT_STORE(rq2[0], rk2[0], rv2[0]); RT_LOAD(1, rq2[1], rk2[1], rv2[1]);
    __syncthreads();
    const int I = wid < 4 ? (wid >> 1) : 5 - (wid >> 1), dt = wid & 1;
#pragma unroll 2
    for (int ci = 0; ci < 18; ++ci) {
        RT_LOAD((ci + 2 < 18 ? ci + 2 : 17), rq2[ci & 1], rk2[ci & 1], rv2[ci & 1]);
        const bool doOut = (ci >= 2) || (l == 0);
        if (doOut) {
            bf16x8 bq[4];
#pragma unroll
            for (int s = 0; s < 4; ++s) bq[s] = *(const LAS bf16x8*)(lds + RT_QS + (32 * I + c) * RT_QP + (16 * s + 8 * h) * 2);
            f32x16 at[4];
#pragma unroll
            for (int J = 0; J < 4; ++J) {
#pragma unroll
                for (int i = 0; i < 16; ++i) at[J][i] = 0.f;
                if (J <= I) {
#pragma unroll
                    for (int s = 0; s < 4; ++s) { const bf16x8 a = *(const LAS bf16x8*)(lds + RT_KS + (32 * J + c) * RT_QP + (16 * s + 8 * h) * 2); at[J] = MFMA32(a, bq[s], at[J]); }
                    if (J == I) {
#pragma unroll
                        for (int r = 0; r < 16; ++r) { const int kr = (r & 3) + 8 * (r >> 2) + 4 * h; if (kr > c) at[J][r] = 0.f; }
                    }
                }
            }
            f32x16 o;
#pragma unroll
            for (int i = 0; i < 16; ++i) o[i] = 0.f;
#pragma unroll
            for (int J = 0; J < 4; ++J) {
                if (J <= I) {
#pragma unroll
                    for (int s2 = 0; s2 < 2; ++s2) {
                        const bf16x8 pb = pack8(at[J], s2);
                        const LAS unsigned char* vb = lds + RT_VT + (32 * dt + c) * RT_TP + (32 * J + 16 * s2 + 4 * h) * 2;
                        const u32x2 lo = *(const LAS u32x2*)vb, hi = *(const LAS u32x2*)(vb + 16);
                        u32x4 av = {lo.x, lo.y, hi.x, hi.y};
                        o = MFMA32(__builtin_bit_cast(bf16x8, av), pb, o);
                    }
                }
            }
            f32x16 cr;
#pragma unroll
            for (int i = 0; i < 16; ++i) cr[i] = 0.f;
#pragma unroll
            for (int s = 0; s < 4; ++s) { const bf16x8 a = *(const LAS bf16x8*)(lds + RT_ST + (32 * dt + c) * RT_QP + (16 * s + 8 * h) * 2); cr = MFMA32(a, bq[s], cr); }
            bf16_t* dst = OUT + (size_t)ret_tok(b, dir, ci, 32 * I + c) * 256 + hh * 64 + 32 * dt;
#pragma unroll
            for (int g = 0; g < 4; ++g) { u32x2 w; w.x = pk_bf16(o[4 * g] + gam * cr[4 * g], o[4 * g + 1] + gam * cr[4 * g + 1]); w.y = pk_bf16(o[4 * g + 2] + gam * cr[4 * g + 2], o[4 * g + 3] + gam * cr[4 * g + 3]); *(u32x2*)(dst + 8 * g + 4 * h) = w; }
        }
        if (wid < 4) {
            const int dtl = wid & 1, kdt = wid >> 1;
            f32x16 upd;
#pragma unroll
            for (int i = 0; i < 16; ++i) upd[i] = 0.f;
#pragma unroll
            for (int s = 0; s < 8; ++s) { const bf16x8 a = *(const LAS bf16x8*)(lds + RT_VT + (32 * dtl + c) * RT_TP + (16 * s + 8 * h) * 2); const bf16x8 bk = *(const LAS bf16x8*)(lds + RT_KT + (32 * kdt + c) * RT_TP + (16 * s + 8 * h) * 2); upd = MFMA32(a, bk, upd); }
#pragma unroll
            for (int i = 0; i < 16; ++i) sacc[i] = g128 * sacc[i] + g127 * upd[i];
        }
        __syncthreads();
        if (wid < 4) {
            const int dtl = wid & 1, kdt = wid >> 1;
#pragma unroll
            for (int r = 0; r < 16; ++r) { const int d = 32 * dtl + (r & 3) + 8 * (r >> 2) + 4 * h; *(LAS bf16_t*)(lds + RT_ST + d * RT_QP + (32 * kdt + c) * 2) = f2bf(sacc[r]); }
        }
        if (ci + 1 < 18) RT_STORE(rq2[(ci + 1) & 1], rk2[(ci + 1) & 1], rv2[(ci + 1) & 1]);
        __syncthreads();
    }
#undef RT_LOAD
#undef RT_STORE
}
DI void phase_ret(CPARAMS p, int l, LAS unsigned char* lds) { const int u = blockIdx.x; if (u < 256) ret_unit(p, l, u >> 3, (u >> 1) & 3, u & 1, lds); }


constexpr int HP_PITCH = 1032;
DI void hyprep_tile(CPARAMS p, int l, int tokbase, int L, int t0, bf16_t* dstS  , int b, LAS unsigned char* lds) {
    const int tid = ltid(), lane = tid & 63, wid = __builtin_amdgcn_readfirstlane(tid >> 6);
    const bf16_t* Z = (const bf16_t*)(p.ws + WS_Z); const float* cw = p.in[I_HCW] + (size_t)l * 3 * 768; const float* cb = p.in[I_HCB] + l * 768;
    __syncthreads();
    {
        u32x4 hv[9];
#pragma unroll
        for (int u = 0; u < 9; ++u) { const int pi = tid + 512 * u, r = pi >> 6, pc = pi & 63, t = t0 - 1 + r; hv[u] = (u32x4){0u, 0u, 0u, 0u};
            if (pi < 66 * 64 && t >= 0 && t < L) hv[u] = *(const u32x4*)(Z + zoff(tokbase + t, (pc < 32 ? ZC_HX1 : ZC_HV) + (pc & 31) * 8)); }
#pragma unroll
        for (int u = 0; u < 9; ++u) { const int pi = tid + 512 * u, r = pi >> 6, pc = pi & 63;
            if (pi < 66 * 64) { LAS unsigned char* d = lds + r * HP_PITCH + pc * 16; u32x2 lo = {hv[u].x, hv[u].y}, hi = {hv[u].z, hv[u].w}; *(LAS u32x2*)d = lo; *(LAS u32x2*)(d + 8) = hi; } }
    }
    __syncthreads();
#pragma unroll 2
    for (int k = 0; k < 8; ++k) {
        const int ch = wid * 32 + k * 4;
        float x1[4], vv[4];
        { const f32x4 b1 = *(const f32x4*)(cb + 256 + ch), b2 = *(const f32x4*)(cb + 512 + ch); x1[0] = b1[0]; x1[1] = b1[1]; x1[2] = b1[2]; x1[3] = b1[3]; vv[0] = b2[0]; vv[1] = b2[1]; vv[2] = b2[2]; vv[3] = b2[3]; }
#pragma unroll
        for (int j = 0; j < 3; ++j) {
            float a[4], bq[4]; unpk4(*(const LAS u32x2*)(lds + (lane + j) * HP_PITCH + ch * 2), a); unpk4(*(const LAS u32x2*)(lds + (lane + j) * HP_PITCH + 512 + ch * 2), bq);
            const f32x4 w1 = *(const f32x4*)(cw + j * 768 + 256 + ch), w2 = *(const f32x4*)(cw + j * 768 + 512 + ch);
#pragma unroll
            for (int q = 0; q < 4; ++q) { x1[q] += w1[q] * a[q]; vv[q] += w2[q] * bq[q]; }
        }
#pragma unroll
        for (int q = 0; q < 4; ++q) dstS[((size_t)(ch + q) * NB + b) * L + t0 + lane] = f2bf(x1[q] * vv[q]);
    }
}
DI void phase_hyprep(CPARAMS p, int l, LAS unsigned char* lds) {
    const int ntl = NB * (SEQ / 64), ntc = l == 0 ? NB * (CTXL / 64) : 0;
    for (int u = blockIdx.x; u < ntl + ntc; u += gridDim.x) {
        if (u < ntl) { const int b = u / (SEQ / 64), tt = u % (SEQ / 64); hyprep_tile(p, l, b * SEQ, SEQ, tt * 64, (bf16_t*)(p.ws + WS_SL), b, lds); }
        else { const int v = u - ntl, b = v / (CTXL / 64), tt = v % (CTXL / 64); hyprep_tile(p, l, TL + b * CTXL, CTXL, tt * 64, (bf16_t*)(p.ws + WS_SC), b, lds); }
    }
}
template <int L, int TPW>
DI void hyena_unit(const bf16_t* Sg, const bf16_t* Gg, bf16_t* Yg, LAS unsigned char* lds) {
    constexpr int PITCH = 2 * L + 16, NK = L / 16, GOFF = 32 * PITCH;
    const int tid = ltid(), lane = tid & 63, wid = __builtin_amdgcn_readfirstlane(tid >> 6), h = lane >> 5, c = lane & 31;
    __syncthreads();
    { constexpr int NPT = 32 * (L / 8) / 512, UB = NPT < 8 ? NPT : 8;
      for (int p0 = 0; p0 < NPT; p0 += UB) { u32x4 sv[UB];
#pragma unroll
        for (int u = 0; u < UB; ++u) { const int pi = tid + 512 * (p0 + u), b = pi / (L / 8), pc = pi % (L / 8); sv[u] = *(const u32x4*)(Sg + (size_t)b * L + pc * 8); }
#pragma unroll
        for (int u = 0; u < UB; ++u) { const int pi = tid + 512 * (p0 + u), b = pi / (L / 8), pc = pi % (L / 8); *(LAS u32x4*)(lds + b * PITCH + pc * 16) = sv[u]; } } }
    for (int pi = tid; pi < (2 * L) / 8; pi += 512) *(LAS u32x4*)(lds + GOFF + pi * 16) = *(const u32x4*)(Gg + pi * 8);
    __syncthreads();
    f32x16 acc[TPW];
#pragma unroll
    for (int a = 0; a < TPW; ++a)
#pragma unroll
        for (int i = 0; i < 16; ++i) acc[a][i] = 0.f;
    const int a0 = (TPW == 8 ? (wid < 4 ? wid : 11 - wid) : wid) * TPW;
    if (a0 * 32 < L) {
        const LAS bf16_t* gbase = (const LAS bf16_t*)(lds + GOFF) + L + 8 * h - c;
        const LAS unsigned char* arow = lds + c * PITCH + 16 * h;
#define HY_BFRAG(q_, out_) do { const LAS bf16_t* gp_ = gbase + 16 * (q_); u32x4 bw_; \
            bw_.x = (unsigned)gp_[0] | ((unsigned)gp_[1] << 16); bw_.y = (unsigned)gp_[2] | ((unsigned)gp_[3] << 16); bw_.z = (unsigned)gp_[4] | ((unsigned)gp_[5] << 16); bw_.w = (unsigned)gp_[6] | ((unsigned)gp_[7] << 16); \
            out_ = __builtin_bit_cast(bf16x8, bw_); } while (0)
        const int qlo = -2 * (a0 + TPW - 1), qhi = NK - 1 - 2 * a0;
        const int ilo = -2 * a0, ihi = NK - 1 - 2 * (a0 + TPW - 1);
        int q = qlo;
        for (; q < ilo && q <= qhi; ++q) {
            bf16x8 bfrag; HY_BFRAG(q, bfrag);
#pragma unroll
            for (int ai = 0; ai < TPW; ++ai) { const int ks = q + 2 * (a0 + ai); if (ks >= 0 && ks < NK) { const bf16x8 a = *(const LAS bf16x8*)(arow + 32 * ks); acc[ai] = MFMA32(a, bfrag, acc[ai]); } }
        }
        if (ilo <= ihi) {
            bf16x8 bnext; HY_BFRAG(q, bnext);
            for (; q <= ihi; ++q) {
                const bf16x8 bfrag = bnext;
                bf16x8 av[TPW];
#pragma unroll
                for (int ai = 0; ai < TPW; ++ai) av[ai] = *(const LAS bf16x8*)(arow + 32 * (q + 2 * (a0 + ai)));
                if (q + 1 <= qhi) HY_BFRAG(q + 1, bnext);
#pragma unroll
                for (int ai = 0; ai < TPW; ++ai) acc[ai] = MFMA32(av[ai], bfrag, acc[ai]);
            }
        }
        for (; q <= qhi; ++q) {
            bf16x8 bfrag; HY_BFRAG(q, bfrag);
#pragma unroll
            for (int ai = 0; ai < TPW; ++ai) { const int ks = q + 2 * (a0 + ai); if (ks >= 0 && ks < NK) { const bf16x8 a = *(const LAS bf16x8*)(arow + 32 * ks); acc[ai] = MFMA32(a, bfrag, acc[ai]); } }
        }
#undef HY_BFRAG
    }
    __syncthreads();
    if (a0 * 32 < L) {
#pragma unroll
        for (int ai = 0; ai < TPW; ++ai)
#pragma unroll
            for (int r = 0; r < 16; ++r) { const int bb = (r & 3) + 8 * (r >> 2) + 4 * h; *(LAS bf16_t*)(lds + bb * PITCH + (32 * (a0 + ai) + c) * 2) = f2bf(acc[ai][r]); }
    }
    __syncthreads();
#pragma unroll 8
    for (int pi = tid; pi < 32 * (L / 8); pi += 512) { const int b = pi / (L / 8), pc = pi % (L / 8); *(u32x4*)(Yg + (size_t)b * L + pc * 8) = *(const LAS u32x4*)(lds + b * PITCH + pc * 16); }
}
DI void phase_hyena(CPARAMS p, int l, LAS unsigned char* lds) {
    const int ch = blockIdx.x; if (ch >= 256) return;
    hyena_unit<SEQ, 8>((const bf16_t*)(p.ws + WS_SL) + (size_t)ch * NB * SEQ, (const bf16_t*)(p.ws + WS_G2048) + (size_t)ch * 2 * SEQ, (bf16_t*)(p.ws + WS_YT) + (size_t)ch * NB * SEQ, lds);
    if (l == 0) hyena_unit<CTXL, 1>((const bf16_t*)(p.ws + WS_SC) + (size_t)ch * NB * CTXL, (const bf16_t*)(p.ws + WS_G256) + (size_t)ch * 2 * CTXL, (bf16_t*)(p.ws + WS_YTC) + (size_t)ch * NB * CTXL, lds);
}


constexpr int LR_XP = 144, LR_XT = 0, LR_XTB = 256 * LR_XP, LR_COMP = 2 * LR_XTB, LR_CARRY = LR_COMP + 8 * 64 * 8, LR_CW = LR_CARRY + 2 * 64 * 4, LR_W = LR_CW + 5 * 64 * 4, LR_END = LR_W + 2 * 64 * LR_XP;
DI void lru_unit(CPARAMS p, int l, int b, int blk, int dir, LAS unsigned char* lds) {
    const int tid = ltid(), lane = tid & 63, wid = __builtin_amdgcn_readfirstlane(tid >> 6), h = lane >> 5, c = lane & 31;
    const bf16_t* Z = (const bf16_t*)(p.ws + WS_Z);
    const bf16_t* WT = (const bf16_t*)(p.ws + WS_LRUW_T);
    bf16_t* OUT = (bf16_t*)(p.ws + (dir ? WS_HB : WS_HF));
    __syncthreads();
    for (int i = tid; i < 5 * 64; i += 512) { const int jj = i >> 6, e = i & 63; ((LAS float*)(lds + LR_CW))[i] = jj < 4 ? p.in[I_LCW][((size_t)l * 4 + jj) * 256 + blk * 64 + e] : p.in[I_LCB][l * 256 + blk * 64 + e]; }
    if (tid < 64) ((LAS float*)(lds + LR_CARRY))[tid] = 0.f;
    for (int pi = tid; pi < 2 * 64 * 8; pi += 512) { const int gate = pi >> 9, e = (pi >> 3) & 63, pc = pi & 7;
        *(LAS u32x4*)(lds + LR_W + (gate * 64 + e) * LR_XP + pc * 16) = *(const u32x4*)(WT + (size_t)(((dir * 2 + gate) * 4 + blk) * 64 + e) * 64 + pc * 8); }
    float ba[2], bx[2], sp8[2];
#pragma unroll
    for (int et = 0; et < 2; ++et) {
        const int e = 32 * et + c;
        const int pi = (l * 2 + dir) * 256 + blk * 64 + e;
        ba[et] = p.in[I_LBA][pi]; bx[et] = p.in[I_LBX][pi]; sp8[et] = -8.f * 1.4426950408889634f * log1pf(expf(-p.in[I_LLAM][pi]));
    }
    const int tq = tid >> 3, cg = tid & 7;
    u32x4 xr[7];
#define LR_GEOM(t) const int _ctx = ((t) == 0); const int L_ = _ctx ? CTXL : SEQ; const int tokbase = _ctx ? TL + b * CTXL : b * SEQ; const int tt_ = _ctx ? 0 : (t) - 1; \
        const int pbase = 256 * tt_, pend = L_ - 1 - 256 * tt_;
#define LR_LOAD(t) do { LR_GEOM(t) const int plo = dir ? pend - 4 * tq - 3 : pbase + 4 * tq; \
        _Pragma("unroll") for (int r = 0; r < 7; ++r) { const int pp = plo - 2 + r; u32x4 v = {0u, 0u, 0u, 0u}; if (pp >= 0 && pp < L_) v = *(const u32x4*)(Z + zoff(tokbase + pp, ZC_LX + blk * 64 + 8 * cg)); xr[r] = v; } } while (0)
#define LR_CONV(t, buf) do { LR_GEOM(t) const int plo = dir ? pend - 4 * tq - 3 : pbase + 4 * tq; (void)L_; (void)tokbase; \
        const LAS float* cwl = (const LAS float*)(lds + LR_CW); \
        _Pragma("unroll") for (int i = 0; i < 4; ++i) { float acc8[8]; \
            _Pragma("unroll") for (int q = 0; q < 8; ++q) acc8[q] = cwl[4 * 64 + 8 * cg + q]; \
            _Pragma("unroll") for (int jj = 0; jj < 4; ++jj) { const u32x4 xv = xr[i + jj]; \
                _Pragma("unroll") for (int d4 = 0; d4 < 4; ++d4) { acc8[2 * d4] += cwl[jj * 64 + 8 * cg + 2 * d4] * __uint_as_float(xv[d4] << 16); acc8[2 * d4 + 1] += cwl[jj * 64 + 8 * cg + 2 * d4 + 1] * __uint_as_float(xv[d4] & 0xffff0000u); } } \
            const int pp = plo + i; const int j = dir ? pend - pp : pp - pbase; \
            u32x4 w; w.x = pk_bf16(acc8[0], acc8[1]); w.y = pk_bf16(acc8[2], acc8[3]); w.z = pk_bf16(acc8[4], acc8[5]); w.w = pk_bf16(acc8[6], acc8[7]); \
            *(LAS u32x4*)(lds + (buf) * LR_XTB + j * LR_XP + cg * 16) = w; } } while (0)
    __syncthreads();
    LR_LOAD(0); LR_CONV(0, 0);
    __syncthreads();
    for (int t = 0; t < 9; ++t) {
        if (t + 1 < 9) LR_LOAD(t + 1);
        LAS unsigned char* xb = lds + (t & 1) * LR_XTB;
        f32x16 ga[2], gx[2];
#pragma unroll
        for (int et = 0; et < 2; ++et)
#pragma unroll
            for (int i = 0; i < 16; ++i) { ga[et][i] = 0.f; gx[et][i] = 0.f; }
#pragma unroll
        for (int s2 = 0; s2 < 4; ++s2) {
            const bf16x8 a = *(const LAS bf16x8*)(xb + (32 * wid + c) * LR_XP + (16 * s2 + 8 * h) * 2);
#pragma unroll
            for (int et = 0; et < 2; ++et) {
                const bf16x8 wa_ = *(const LAS bf16x8*)(lds + LR_W + (32 * et + c) * LR_XP + (16 * s2 + 8 * h) * 2), wx_ = *(const LAS bf16x8*)(lds + LR_W + (64 + 32 * et + c) * LR_XP + (16 * s2 + 8 * h) * 2);
                ga[et] = MFMA32(a, wa_, ga[et]); gx[et] = MFMA32(a, wx_, gx[et]); }
        }
#pragma unroll
        for (int et = 0; et < 2; ++et)
#pragma unroll
            for (int r = 0; r < 16; ++r) {
                const int j = 32 * wid + (r & 3) + 8 * (r >> 2) + 4 * h;
                const float xv = bf2f(*(const LAS bf16_t*)(xb + j * LR_XP + (32 * et + c) * 2));
                const float rr = __builtin_amdgcn_rcpf(1.f + __builtin_amdgcn_exp2f(-1.4426950408889634f * (ga[et][r] + ba[et])));
                const float ig = __builtin_amdgcn_rcpf(1.f + __builtin_amdgcn_exp2f(-1.4426950408889634f * (gx[et][r] + bx[et])));
                const float av = __builtin_amdgcn_exp2f(sp8[et] * rr);
                ga[et][r] = av; gx[et][r] = __builtin_amdgcn_sqrtf(fmaxf(1.f - av * av, 0.f)) * (ig * xv);
            }
        float PA[2][4], PB[2][4], A0[2][4], B0[2][4];
#pragma unroll
        for (int et = 0; et < 2; ++et) {
            float WA = 1.f, WB = 0.f;
#pragma unroll
            for (int g = 0; g < 4; ++g) {
                float Ag = ga[et][4 * g], Bg = gx[et][4 * g];
#pragma unroll
                for (int i = 1; i < 4; ++i) { Bg = Bg * ga[et][4 * g + i] + gx[et][4 * g + i]; Ag *= ga[et][4 * g + i]; }
                const float oA = __shfl_xor(Ag, 32), oB = __shfl_xor(Bg, 32);
                const float a0 = h ? oA : Ag, b0 = h ? oB : Bg, a1 = h ? Ag : oA, b1 = h ? Bg : oB;
                A0[et][g] = a0; B0[et][g] = b0; PA[et][g] = a0 * a1; PB[et][g] = b0 * a1 + b1;
                WB = WB * PA[et][g] + PB[et][g]; WA *= PA[et][g];
            }
            if (h == 0) { LAS float* cp = (LAS float*)(lds + LR_COMP) + (wid * 64 + 32 * et + c) * 2; cp[0] = WA; cp[1] = WB; }
        }
        if (t + 1 < 9) LR_CONV(t + 1, (t + 1) & 1);
        __syncthreads();
        {
            LR_GEOM(t) (void)pbase; (void)pend;
#pragma unroll
            for (int et = 0; et < 2; ++et) {
                const int e = 32 * et + c;
                float hin = ((const LAS float*)(lds + LR_CARRY))[(t & 1) * 64 + e];
                float wa7 = 1.f, wb7 = 0.f;
                for (int w2 = 0; w2 < 8; ++w2) { const LAS float* cp = (const LAS float*)(lds + LR_COMP) + (w2 * 64 + e) * 2; const float ca = cp[0], cb2 = cp[1]; if (w2 < wid) hin = hin * ca + cb2; if (w2 == wid) { wa7 = ca; wb7 = cb2; } }
                if (wid == 7 && h == 0) ((LAS float*)(lds + LR_CARRY))[((t + 1) & 1) * 64 + e] = hin * wa7 + wb7;
                float sg = hin;
#pragma unroll
                for (int g = 0; g < 4; ++g) {
                    float hh = h ? sg * A0[et][g] + B0[et][g] : sg;
#pragma unroll
                    for (int i = 0; i < 4; ++i) {
                        hh = ga[et][4 * g + i] * hh + gx[et][4 * g + i];
                        const int j = 32 * wid + 8 * g + 4 * h + i; const int pp = dir ? (L_ - 1 - 256 * tt_) - j : 256 * tt_ + j;
                        OUT[(size_t)(tokbase + pp) * 256 + blk * 64 + e] = f2bf(hh);
                    }
                    sg = sg * PA[et][g] + PB[et][g];
                }
            }
        }
        __syncthreads();
    }
#undef LR_GEOM
#undef LR_LOAD
#undef LR_CONV
}
DI void phase_lru(CPARAMS p, int l, LAS unsigned char* lds) { const int u = blockIdx.x; if (u < 256) lru_unit(p, l, u >> 3, (u >> 1) & 3, u & 1, lds); }


constexpr int QP_PITCH = 516;
DI float red16(float v) { return row_sum16(v); }
DI void phase_qkvpost(CPARAMS p, int l, LAS unsigned char* lds) {
    const int tid = ltid(), lane = tid & 63, wid = __builtin_amdgcn_readfirstlane(tid >> 6), tq = lane >> 4, li = lane & 15;
    const bf16_t* Z = (const bf16_t*)(p.ws + WS_Z); const bf16_t* RAW = (const bf16_t*)(p.ws + WS_RAW);
    bf16_t* Qo = (bf16_t*)(p.ws + WS_Q); bf16_t* Ko = (bf16_t*)(p.ws + WS_K); bf16_t* VT = (bf16_t*)(p.ws + WS_VT);
    const int d4 = 4 * li, ra = li >> 3, ri = li & 7, dr = 64 + 16 * ra + ri;
    float qg[4], kg[4], qgr[2], kgr[2];
#pragma unroll
    for (int q = 0; q < 4; ++q) { qg[q] = p.in[I_QN][l * 96 + d4 + q]; kg[q] = p.in[I_KN][l * 96 + d4 + q]; }
    qgr[0] = p.in[I_QN][l * 96 + dr]; qgr[1] = p.in[I_QN][l * 96 + dr + 8];
    kgr[0] = p.in[I_KN][l * 96 + dr]; kgr[1] = p.in[I_KN][l * 96 + dr + 8];
    const float invf = __builtin_amdgcn_exp2f(-(float)ri * (13.287712379549449f / 8.f)) * 0.15915494309189535f;
    const float qsc = 0.10206207261596575f * 1.4426950408889634f;
    const int ntl = TL / 64, ntc = TC / 64;
    for (int u = blockIdx.x; u < ntl + ntc; u += gridDim.x) {
        const bool lat = u < ntl; const int tok0 = lat ? u * 64 : TL + (u - ntl) * 64;
        const int b = lat ? tok0 / SEQ : (tok0 - TL) / CTXL; const int pos0 = lat ? tok0 % SEQ : SEQ + (tok0 - TL) % CTXL;
        const bool doq = lat || l == 0;
        __syncthreads();
        for (int it = 0; it < 2; ++it) {
            const int tl = wid * 8 + it * 4 + tq, tok = tok0 + tl, pos = pos0 + tl;
            const bf16_t* rr = RAW + (size_t)tok * 1024;
            u32x2 wcq[3];
#pragma unroll
            for (int j = 0; j < 3; ++j) wcq[j] = ld4(Z + zoff(tok, ZC_CQ + 12 * li + 4 * j));
            const u32x4 wckv = ld8(Z + zoff(tok, ZC_CKV + 8 * li));
            const bf16_t kr0 = Z[zoff(tok, ZC_KR + 16 * ra + ri)], kr1 = Z[zoff(tok, ZC_KR + 8 + 16 * ra + ri)];
            u32x2 wq[4], wk[4], wv[4]; bf16_t q0[4], q1[4];
#pragma unroll
            for (int hh = 0; hh < 4; ++hh) {
                if (doq) { wq[hh] = ld4(rr + hh * 96 + d4); q0[hh] = rr[hh * 96 + dr]; q1[hh] = rr[hh * 96 + dr + 8]; } else { wq[hh] = (u32x2){0u, 0u}; q0[hh] = 0; q1[hh] = 0; }
                wk[hh] = ld4(rr + 512 + hh * 128 + d4); wv[hh] = ld4(rr + 512 + hh * 128 + 64 + d4);
            }
            float sq = 0.f, skv = 0.f;
#pragma unroll
            for (int j = 0; j < 3; ++j) { float f[4]; unpk4(wcq[j], f); sq += f[0] * f[0] + f[1] * f[1] + f[2] * f[2] + f[3] * f[3]; }
            { float f[8]; unpk8(wckv, f);
#pragma unroll
              for (int q = 0; q < 8; ++q) skv += f[q] * f[q]; }
            sq = red16(sq); skv = red16(skv);
            const float rq = rsqrtf(sq * (1.f / 192.f) + EPS), rkv = rsqrtf(skv * (1.f / 128.f) + EPS);
            float cs = 1.f, sn = 0.f;
            if (lat) { const float pa = ra == 0 ? (float)(pos >> 6) : (float)(pos & 63); float rev = pa * invf; rev -= floorf(rev); cs = __builtin_amdgcn_cosf(rev); sn = __builtin_amdgcn_sinf(rev); }
            const float kx1 = bf2f(kr0), kx2 = bf2f(kr1);
#pragma unroll
            for (int hh = 0; hh < 4; ++hh) {
                const size_t ob = (((size_t)b * 4 + hh) * PALL + pos) * 96;
                if (doq) {
                    float qn[4]; unpk4(wq[hh], qn); float x1 = bf2f(q0[hh]), x2 = bf2f(q1[hh]);
                    float ss = x1 * x1 + x2 * x2 + qn[0] * qn[0] + qn[1] * qn[1] + qn[2] * qn[2] + qn[3] * qn[3];
                    ss = red16(ss) * rq * rq;
                    const float rs = rsqrtf(ss * (1.f / 96.f) + EPS) * rq * qsc;
                    u32x2 w; w.x = pk_bf16(qn[0] * rs * qg[0], qn[1] * rs * qg[1]); w.y = pk_bf16(qn[2] * rs * qg[2], qn[3] * rs * qg[3]);
                    *(u32x2*)(Qo + ob + d4) = w;
                    x1 *= rs * qgr[0]; x2 *= rs * qgr[1];
                    Qo[ob + dr] = f2bf(x1 * cs - x2 * sn); Qo[ob + dr + 8] = f2bf(x2 * cs + x1 * sn);
                }
                {
                    float kn[4]; unpk4(wk[hh], kn);
                    float ss = 0.f;
#pragma unroll
                    for (int q = 0; q < 4; ++q) { kn[q] *= rkv; ss += kn[q] * kn[q]; }
                    ss += kx1 * kx1 + kx2 * kx2;
                    ss = red16(ss);
                    const float rs = rsqrtf(ss * (1.f / 96.f) + EPS);
                    u32x2 w; w.x = pk_bf16(kn[0] * rs * kg[0], kn[1] * rs * kg[1]); w.y = pk_bf16(kn[2] * rs * kg[2], kn[3] * rs * kg[3]);
                    *(u32x2*)(Ko + ob + d4) = w;
                    const float y1 = kx1 * rs * kgr[0], y2 = kx2 * rs * kgr[1];
                    Ko[ob + dr] = f2bf(y1 * cs - y2 * sn); Ko[ob + dr + 8] = f2bf(y2 * cs + y1 * sn);
                    float vv[4]; unpk4(wv[hh], vv);
                    u32x2 wv2; wv2.x = pk_bf16(vv[0] * rkv, vv[1] * rkv); wv2.y = pk_bf16(vv[2] * rkv, vv[3] * rkv);
                    LAS unsigned* vl = (LAS unsigned*)(lds + tl * QP_PITCH + (hh * 64 + d4) * 2); vl[0] = wv2.x; vl[1] = wv2.y;
                }
            }
        }
        __syncthreads();
#pragma unroll
        for (int j = 0; j < 4; ++j) {
            const int pi = tid + 512 * j, r = pi >> 3, tp = pi & 7;
            unsigned short e[8];
#pragma unroll
            for (int q = 0; q < 8; ++q) e[q] = *(const LAS bf16_t*)(lds + (tp * 8 + q) * QP_PITCH + r * 2);
            u32x4 w; w.x = (unsigned)e[0] | ((unsigned)e[1] << 16); w.y = (unsigned)e[2] | ((unsigned)e[3] << 16); w.z = (unsigned)e[4] | ((unsigned)e[5] << 16); w.w = (unsigned)e[6] | ((unsigned)e[7] << 16);
            *(u32x4*)(VT + (((size_t)b * 4 + (r >> 6)) * 64 + (r & 63)) * PALL + pos0 + tp * 8) = w;
        }
    }
}

#define XB_TMO      128
#define XB_XCNT(j)  (256  + 64 * (j))
#define XB_XSUB(j)  (1280 + 64 * (j))
#define XB_XGEN(j)  (2304 + 64 * (j))
#define XB_TOP      3328
#define XB_TOPGEN   3392
#define XCD_BAR_WORDS 3456
#define XB_SPIN_CAP (1u << 18)
__device__ __forceinline__ unsigned xb_ld(unsigned* p)              { return __hip_atomic_load(p, __ATOMIC_RELAXED, __HIP_MEMORY_SCOPE_AGENT); }
__device__ __forceinline__ unsigned xb_add(unsigned* p, unsigned v) { return __hip_atomic_fetch_add(p, v, __ATOMIC_RELAXED, __HIP_MEMORY_SCOPE_AGENT); }
__device__ __forceinline__ unsigned xb_xcc_id() { return (unsigned)__builtin_amdgcn_s_getreg((3 << 11) | 20) & 0xFu; }
#define XB_SPIN(cond, bar) do { unsigned _sp = 0; while (cond) { __builtin_amdgcn_s_sleep(1); \
    if ((++_sp & 255u) == 0u) { if (xb_ld(&(bar)[XB_TMO])) break; if (_sp > XB_SPIN_CAP) { atomicAdd(&(bar)[XB_TMO], 1u); break; } } } } while (0)
struct XcdBarrier { unsigned* bar; unsigned x; volatile LAS unsigned* st; };
__device__ __forceinline__ XcdBarrier xcd_barrier_post(unsigned* bar, volatile LAS unsigned* st) {
    XcdBarrier b; b.bar = bar; b.x = xb_xcc_id(); b.st = st;
    if (threadIdx.x == 0) (void)xb_add(&bar[XB_XCNT(b.x)], 1u);
    return b;
}
__device__ __forceinline__ void xcd_barrier_complete(unsigned* bar, unsigned x, unsigned& nloc, unsigned& nx) {
    const unsigned G = gridDim.x * gridDim.y * gridDim.z;
    unsigned sum, cnt, mine, sp = 0u;
    for (;;) {
        sum = 0u; cnt = 0u; mine = 0u;
#pragma unroll
        for (unsigned j = 0; j < 16; ++j) { const unsigned c = xb_ld(&bar[XB_XCNT(j)]); sum += c; cnt += (c > 0u) ? 1u : 0u; mine = (j == x) ? c : mine; }
        if (sum == G) break;
        __builtin_amdgcn_s_sleep(1);
        if ((++sp & 255u) == 0u) { if (xb_ld(&bar[XB_TMO])) break; if (sp > XB_SPIN_CAP) { atomicAdd(&bar[XB_TMO], 1u); break; } }
    }
    nloc = mine > 0u ? mine : 1u; nx = cnt > 0u ? cnt : 1u;
}
__device__ __forceinline__ void xcd_barrier(const XcdBarrier& b) {
    asm volatile("s_waitcnt vmcnt(0)" ::: "memory");
    __syncthreads();
    if (threadIdx.x == 0) {
        unsigned* bar = b.bar;
        __builtin_amdgcn_s_waitcnt(0);
        unsigned nloc = b.st[0], nx = b.st[1];
        if (nloc == 0u) { xcd_barrier_complete(bar, b.x, nloc, nx); b.st[0] = nloc; b.st[1] = nx; }
        const unsigned old = xb_add(&bar[XB_XSUB(b.x)], 1u);
        const unsigned gen = old / nloc;
        if (old + 1u == (gen + 1u) * nloc) {
            __builtin_amdgcn_fence(__ATOMIC_RELEASE, "agent");
            asm volatile("s_waitcnt vmcnt(0)" ::: "memory");
            const unsigned og = xb_add(&bar[XB_TOP], 1u);
            const unsigned tg = og / nx;
            if (og + 1u == (tg + 1u) * nx) xb_add(&bar[XB_TOPGEN], 1u);
            else XB_SPIN(xb_ld(&bar[XB_TOPGEN]) == tg, bar);
            __builtin_amdgcn_fence(__ATOMIC_ACQUIRE, "agent");
            xb_add(&bar[XB_XGEN(b.x)], 1u);
            asm volatile("s_waitcnt vmcnt(0)" ::: "memory");
        } else {
            XB_SPIN(xb_ld(&bar[XB_XGEN(b.x)]) == gen, bar);
            __builtin_amdgcn_fence(__ATOMIC_ACQUIRE, "agent");
            asm volatile("s_waitcnt vmcnt(0)" ::: "memory");
        }
    }
    __syncthreads();
}

constexpr int CW_BAR = 8192;
constexpr int N_PHASES = 22;
__global__ void __launch_bounds__(512, 2) fwd(Params p_unused) {
    extern __shared__ __attribute__((aligned(16))) unsigned char dynlds[];
    LAS unsigned char* lds = (LAS unsigned char*)dynlds;
    volatile LAS unsigned* st = (volatile LAS unsigned*)(lds + LDS_BYTES - 16);
    if (threadIdx.x == 0) { st[0] = 0u; st[1] = 0u; st[2] = 0u; st[3] = 0u; }
    __syncthreads();
    #define PP (*launder_kp((KP)__builtin_amdgcn_kernarg_segment_ptr()))
    (void)xcd_barrier_post((unsigned*)(PP.ws + WS_CTL) + CW_BAR, st);
#define IN(k) (PP.ph_lo <= (k) && (k) < PP.ph_hi)
#define SEAM(k) do { if (IN(k) && IN((k) + 1)) { XcdBarrier bar_; bar_.bar = (unsigned*)(PP.ws + WS_CTL) + CW_BAR; bar_.x = xb_xcc_id(); bar_.st = (volatile LAS unsigned*)(lds + LDS_BYTES - 16); for (int rb_ = 0; rb_ < 1 + PROBE_BAR; ++rb_) xcd_barrier(bar_); } } while (0)
#ifndef PROBE_PH
#define PROBE_PH -1
#endif
#ifndef PROBE_BAR
#define PROBE_BAR 0
#endif
#ifndef PROBE_DUP
#define PROBE_DUP 0
#endif
#define RUN(bit, call) do { for (int rep_ = 0; rep_ < 1 + ((PROBE_DUP >> (bit)) & 1); ++rep_) { call; } } while (0)
#define PSTART(id) do { if (PROBE_PH == (id) && ltid() == 0) { *(volatile LAS unsigned long long*)(lds + LDS_BYTES - 48) = wall_clock64(); } } while (0)
#define PEND(id) do { if (PROBE_PH == (id) && ltid() == 0) { volatile LAS unsigned long long* q_ = (volatile LAS unsigned long long*)(lds + LDS_BYTES - 48); q_[1] = wall_clock64() - q_[0]; } } while (0)
    PSTART(777); PEND(777);
    PSTART(0);
    if (IN(0)) { phase_mod(PP, (LAS float*)lds); phase_convert(PP, 0, (LAS float*)lds); phase_filter(PP, 0, (LAS float*)lds); }
    SEAM(0); PEND(0);
    PSTART(1);
    if (IN(1)) phase_norm1(PP, 0);
    SEAM(1); PEND(1);
    for (int l = 0; l < 2; ++l) {
        const int pb = 2 + 10 * l;
        PSTART(pb + 0);
        if (IN(pb + 0)) phase_inproj(PP, l, lds);
        SEAM(pb + 0); PEND(pb + 0);
        PSTART(pb + 1);
        if (IN(pb + 1)) { RUN(0, phase_up(PP, l, lds)); RUN(1, phase_hyprep(PP, l, lds)); }
        SEAM(pb + 1); PEND(pb + 1);
        PSTART(pb + 2);
        if (IN(pb + 2)) RUN(2, phase_qkvpost(PP, l, lds));
        SEAM(pb + 2); PEND(pb + 2);
        PSTART(pb + 3);
        if (IN(pb + 3)) { PSTART(200 + pb); phase_attn(PP, l, lds); PEND(200 + pb); PSTART(300 + pb); RUN(3, phase_ret(PP, l, lds)); PEND(300 + pb); PSTART(400 + pb); RUN(4, phase_hyena(PP, l, lds)); PEND(400 + pb); PSTART(500 + pb); RUN(5, phase_lru(PP, l, lds)); PEND(500 + pb); }
        SEAM(pb + 3); PEND(pb + 3);
        PSTART(pb + 4);
        if (IN(pb + 4)) RUN(6, phase_merge(PP, l, lds));
        SEAM(pb + 4); PEND(pb + 4);
        PSTART(pb + 5);
        if (IN(pb + 5)) phase_outproj(PP, l, lds);
        SEAM(pb + 5); PEND(pb + 5);
        PSTART(pb + 6);
        if (IN(pb + 6)) phase_norm2(PP, l, lds);
        SEAM(pb + 6); PEND(pb + 6);
        PSTART(pb + 7);
        if (IN(pb + 7)) phase_moe1(PP, l, lds);
        SEAM(pb + 7); PEND(pb + 7);
        PSTART(pb + 8);
        if (IN(pb + 8)) phase_moe2(PP, l, lds);
        SEAM(pb + 8); PEND(pb + 8);
        PSTART(pb + 9);
        if (IN(pb + 9)) { phase_combine(PP, l); if (l == 0) { phase_convert(PP, 1, (LAS float*)lds); phase_filter(PP, 1, (LAS float*)lds); } }
        if (l == 0) SEAM(pb + 9);
        PEND(pb + 9);
    }
    if (PROBE_PH >= 0) { __syncthreads(); if (ltid() == 0) { const unsigned long long dt_ = ((volatile LAS unsigned long long*)(lds + LDS_BYTES - 48))[1]; const unsigned long long t_ = wall_clock64(); while (wall_clock64() - t_ < dt_) __builtin_amdgcn_s_sleep(8); } }
#undef IN
#undef SEAM
}

#ifndef MK_PER_PHASE
#define MK_PER_PHASE 0
#endif
extern "C" void kernel_launch(void* const* d_in, const int* in_sizes, int n_in, void* d_out, int out_size, void* d_ws, size_t ws_size, hipStream_t stream) {
    static int grid = 0;
    if (grid == 0) {
        if (ws_size < WS_END) fprintf(stderr, "kernel_launch: workspace too small: %zu < %zu\n", ws_size, (size_t)WS_END);
        int dev = 0, cus = 0, per_cu = 0;
        (void)hipGetDevice(&dev); (void)hipDeviceGetAttribute(&cus, hipDeviceAttributeMultiprocessorCount, dev);
        (void)hipFuncSetAttribute((const void*)fwd, hipFuncAttributeMaxDynamicSharedMemorySize, LDS_BYTES);
        if (hipOccupancyMaxActiveBlocksPerMultiprocessor(&per_cu, (const void*)fwd, 512, LDS_BYTES) != hipSuccess || per_cu < 1) { fprintf(stderr, "kernel_launch: occupancy query says %d\n", per_cu); per_cu = 1; }
        (void)hipGetLastError();
        grid = cus > 0 ? cus : 256;
    }
    Params p{};
    for (int i = 0; i < N_IN; ++i) p.in[i] = (const float*)d_in[i];
    p.out = (float*)d_out; p.ws = (unsigned char*)d_ws;
    (void)hipMemsetAsync((char*)d_ws + WS_CTL, 0, 1 * MiB, stream);
#if MK_PER_PHASE
    for (int ph = 0; ph < N_PHASES; ++ph) { p.ph_lo = ph; p.ph_hi = ph + 1; hipLaunchKernelGGL(fwd, dim3(grid), dim3(512), LDS_BYTES, stream, p); }
#else
    p.ph_lo = 0; p.ph_hi = N_PHASES; hipLaunchKernelGGL(fwd, dim3(grid), dim3(512), LDS_BYTES, stream, p);
#endif
}
```

```cpp
#include <hip/hip_runtime.h>
#include <cstdio>
#include <cstdint>

#define DI __device__ __forceinline__
#define LAS __attribute__((address_space(3)))
typedef unsigned short bf16_t;
typedef short bf16x8 __attribute__((ext_vector_type(8)));
typedef float f32x4 __attribute__((ext_vector_type(4)));
typedef float f32x16 __attribute__((ext_vector_type(16)));
typedef unsigned u32x4 __attribute__((ext_vector_type(4)));
typedef unsigned u32x2 __attribute__((ext_vector_type(2)));

constexpr int D = 1024, NB = 32, SEQ = 2048, CTXL = 256, PALL = SEQ + CTXL;
constexpr int TL = NB * SEQ, TC = NB * CTXL, T = TL + TC;
constexpr int ZW = 2816, INC = 2656;
constexpr int ZC_CQ = 0, ZC_CKV = 256, ZC_KR = 384, ZC_RQ = 512, ZC_RK = 768, ZC_RV = 1024, ZC_RG = 1280,
              ZC_HX0 = 1536, ZC_HX1 = 1792, ZC_HV = 2048, ZC_LX = 2304, ZC_LG = 2560;
__host__ __device__ __forceinline__ size_t zoff(int tok, int col) { return ((size_t)(col >> 8) * (32 * 2048 + 32 * 256) + tok) * 256 + (col & 255); }
__host__ __device__ __forceinline__ int zmap(int c) { return c < 192 ? c : (c < 352 ? c + 64 : c + 160); }
constexpr float EPS = 1e-6f;
constexpr int NEXP = 32, EFF = 512, CAPE = T;
constexpr int MAXSLOT = 155648;

enum { I_X = 0, I_C, I_CTX, I_CCTX, I_WMOD, I_BMOD, I_N1G, I_N2G, I_WIN, I_QNG, I_WUQ, I_KVNG, I_WUKV, I_QN, I_KN, I_RLG, I_RNG,
       I_HCW, I_HCB, I_HW1, I_HB1, I_HW2, I_HB2, I_HW3, I_HFREQ, I_HD, I_LCW, I_LCB, I_LWA, I_LBA, I_LWX, I_LBX, I_LLAM, I_GNG, I_WOUT,
       I_MWG, I_MWE, I_MW1, I_MW3, I_MW2, N_IN };

constexpr size_t MiB = 1024ull * 1024ull;
constexpr size_t WS_CTL = 0;
constexpr size_t WS_MOD = 1 * MiB;
constexpr size_t WS_G2048 = 3 * MiB;
constexpr size_t WS_G256 = 5 * MiB;
constexpr size_t WS_WUP_T = 6 * MiB;
constexpr size_t WS_LRUW_T = 6 * MiB + 512 * 1024;
constexpr size_t WS_WIN_T = 7 * MiB;
constexpr size_t WS_WOUT_T = 13 * MiB;
constexpr size_t WS_W13_T = 15 * MiB;
constexpr size_t WS_W2_T = 79 * MiB;
constexpr size_t WS_ETOK = 111 * MiB;
constexpr size_t WS_EW = 120 * MiB;
constexpr size_t WS_XC = 129 * MiB;
constexpr size_t WS_ACT = 161 * MiB;
constexpr size_t WS_Q = WS_ACT;
constexpr size_t WS_K = WS_Q + 56623104ull;
constexpr size_t WS_VT = WS_K + 56623104ull;
constexpr size_t WS_RAW = 305 * MiB;
constexpr size_t WS_XB1 = 305 * MiB;
constexpr size_t WS_YA = 305 * MiB;
constexpr size_t WS_OF = 341 * MiB;
constexpr size_t WS_OB = 377 * MiB;
constexpr size_t WS_HF = 413 * MiB;
constexpr size_t WS_HB = 449 * MiB;
constexpr size_t WS_Z = 485 * MiB;
constexpr size_t WS_SL = 881 * MiB;
constexpr size_t WS_SC = 913 * MiB;
constexpr size_t WS_YT = 917 * MiB;
constexpr size_t WS_YTC = 949 * MiB;
constexpr size_t WS_H = WS_Z;
constexpr size_t WS_YTOK = WS_Z + 152 * MiB;
constexpr size_t WS_XT = 953 * MiB;
constexpr size_t WS_END = 989 * MiB;
constexpr int CW_COUNT = 4096;

struct Params { const float* in[N_IN]; float* out; unsigned char* ws; int ph_lo, ph_hi; };
#define CPARAMS const __attribute__((address_space(4))) Params&
typedef const __attribute__((address_space(4))) Params* KP;
DI int ltid() { int t = threadIdx.x; asm volatile("" : "+v"(t)); return t; }
DI KP launder_kp(KP k) { asm volatile("" : "+s"(k)); return k; }

DI bf16_t f2bf(float f) { unsigned u = __float_as_uint(f); u += 0x7FFFu + ((u >> 16) & 1u); return (bf16_t)(u >> 16); }
typedef __bf16 bf16x2_t __attribute__((ext_vector_type(2)));
typedef float f32x2_t __attribute__((ext_vector_type(2)));
DI unsigned pk_bf16(float a, float b) { f32x2_t v = {a, b}; bf16x2_t r = __builtin_convertvector(v, bf16x2_t); return __builtin_bit_cast(unsigned, r); }
DI float bf2f(bf16_t b) { return __uint_as_float(((unsigned)b) << 16); }
DI float dpp_add(float v, const int ctrl_sel) {
    int r;
    if (ctrl_sel == 0) r = __builtin_amdgcn_update_dpp(0, __float_as_int(v), 0xB1, 0xF, 0xF, true);
    else if (ctrl_sel == 1) r = __builtin_amdgcn_update_dpp(0, __float_as_int(v), 0x4E, 0xF, 0xF, true);
    else if (ctrl_sel == 2) r = __builtin_amdgcn_update_dpp(0, __float_as_int(v), 0x141, 0xF, 0xF, true);
    else r = __builtin_amdgcn_update_dpp(0, __float_as_int(v), 0x140, 0xF, 0xF, true);
    return v + __int_as_float(r);
}
DI float row_sum16(float v) { v = dpp_add(v, 0); v = dpp_add(v, 1); v = dpp_add(v, 2); v = dpp_add(v, 3); return v; }
DI float wave_sum(float v) {
    v = row_sum16(v);
    const float s0 = __int_as_float(__builtin_amdgcn_readlane(__float_as_int(v), 0)), s1 = __int_as_float(__builtin_amdgcn_readlane(__float_as_int(v), 16));
    const float s2 = __int_as_float(__builtin_amdgcn_readlane(__float_as_int(v), 32)), s3 = __int_as_float(__builtin_amdgcn_readlane(__float_as_int(v), 48));
    return (s0 + s1) + (s2 + s3);
}
DI float hw_sin(float x) { float r = x * 0.15915494309189535f; r -= floorf(r); return __builtin_amdgcn_sinf(r); }
DI float siluf(float v) { return v / (1.f + expf(-v)); }
DI float gelu_tanh(float x) { const float u = 0.7978845608028654f * (x + 0.044715f * x * x * x); return 0.5f * x * (1.f + tanhf(u)); }
DI const float* modrow(CPARAMS p, int l, int r) { return (const float*)(p.ws + WS_MOD) + ((size_t)l * 33 + r) * 6144; }
DI int tok_batch(int tok) { return tok < TL ? tok / SEQ : (tok - TL) / CTXL; }

DI void phase_mod(CPARAMS p, LAS float* sm) {
  for (int vb = blockIdx.x; vb < 256; vb += gridDim.x) {
    __syncthreads();
    float* MOD = (float*)(p.ws + WS_MOD);
    const int tid = ltid();
    for (int i0 = tid; i0 < 33 * 1024; i0 += 512 * 6) { float cv[6];
#pragma unroll
        for (int u = 0; u < 6; ++u) { const int i = i0 + 512 * u, r = i >> 10, k = i & 1023; cv[u] = r < 32 ? p.in[I_C][r * 1024 + k] : p.in[I_CCTX][k]; }
#pragma unroll
        for (int u = 0; u < 6; ++u) sm[i0 + 512 * u] = siluf(cv[u]); }
    __syncthreads();
    const int col = tid % 48, ks = tid / 48;
    const int gcol = vb * 48 + col, l = gcol / 6144, n = gcol % 6144;
    float acc[33];
#pragma unroll
    for (int r = 0; r < 33; ++r) acc[r] = 0.f;
    if (ks < 8) {
        const float* w = p.in[I_WMOD] + (size_t)l * 1024 * 6144 + n;
#pragma unroll 4
        for (int k = ks * 128; k < ks * 128 + 128; ++k) {
            const float wv = w[(size_t)k * 6144];
#pragma unroll
            for (int r = 0; r < 33; ++r) acc[r] += sm[r * 1024 + k] * wv;
        }
    }
    __syncthreads();
    if (ks < 8) {
#pragma unroll
        for (int r = 0; r < 33; ++r) sm[(ks * 33 + r) * 48 + col] = acc[r];
    }
    __syncthreads();
    for (int i = tid; i < 33 * 48; i += 512) {
        const int r = i / 48, c = i % 48; float s = 0.f;
        for (int k2 = 0; k2 < 8; ++k2) s += sm[(k2 * 33 + r) * 48 + c];
        const int g = vb * 48 + c, l2 = g / 6144, n2 = g % 6144;
        MOD[((size_t)l2 * 33 + r) * 6144 + n2] = s + p.in[I_BMOD][l2 * 6144 + n2];
    }
  }
}

struct TcDesc { const float* src; const float* kscale; bf16_t* dst; int ld, K, N, ldd, k0, n0, drow0, remap; };
DI TcDesc tc_desc(CPARAMS p, int l, int t) {
    bf16_t* WIN_T = (bf16_t*)(p.ws + WS_WIN_T); bf16_t* WOUT_T = (bf16_t*)(p.ws + WS_WOUT_T); bf16_t* W13_T = (bf16_t*)(p.ws + WS_W13_T); bf16_t* W2_T = (bf16_t*)(p.ws + WS_W2_T);
    bf16_t* WUP_T = (bf16_t*)(p.ws + WS_WUP_T); bf16_t* LRUW_T = (bf16_t*)(p.ws + WS_LRUW_T);
    constexpr int N0 = 8 * 42, N1 = N0 + 128, N2 = N1 + 32 * 2 * 64, N3 = N2 + 32 * 64, N4 = N3 + 12, N5 = N4 + 8;
    TcDesc d; d.kscale = nullptr; d.remap = 0;
    if (t < N0) { const int kt = t / 42, nt = t % 42; d.src = p.in[I_WIN] + (size_t)l * 1024 * INC; d.ld = INC; d.K = 1024; d.N = INC; d.dst = WIN_T; d.ldd = 1024; d.k0 = kt * 128; d.n0 = nt * 64; d.drow0 = 0; d.remap = 1; }
    else if (t < N1) { const int u = t - N0, kt = u / 16, nt = u % 16; d.src = p.in[I_WOUT] + (size_t)l * 1024 * 1024; d.ld = 1024; d.K = 1024; d.N = 1024; d.dst = WOUT_T; d.ldd = 1024; d.k0 = kt * 128; d.n0 = nt * 64; d.drow0 = nt * 64; }
    else if (t < N2) { const int u = t - N1, e = u / 128, r = u % 128, bj = r / 64, q = r % 64, kt = q / 8, nt = q % 8; const int n0 = nt * 64;
        d.src = p.in[bj ? I_MW3 : I_MW1] + ((size_t)l * NEXP + e) * 1024 * 512; d.ld = 512; d.K = 1024; d.N = 512; d.dst = W13_T + (size_t)e * 1024 * 1024; d.ldd = 1024; d.k0 = kt * 128; d.n0 = n0; d.drow0 = 256 * (n0 / 128) + 128 * bj + (n0 % 128); }
    else if (t < N3) { const int u = t - N2, e = u / 64, q = u % 64, kt = q / 16, nt = q % 16;
        d.src = p.in[I_MW2] + ((size_t)l * NEXP + e) * 512 * 1024; d.ld = 1024; d.K = 512; d.N = 1024; d.dst = W2_T + (size_t)e * 1024 * 512; d.ldd = 512; d.k0 = kt * 128; d.n0 = nt * 64; d.drow0 = nt * 64; }
    else if (t < N4) { const int u = t - N3, kt = u / 6, nt = u % 6; d.src = p.in[I_WUQ] + (size_t)l * 192 * 384; d.ld = 384; d.K = 192; d.N = 384; d.dst = WUP_T; d.ldd = 256; d.k0 = kt * 128; d.n0 = nt * 64; d.drow0 = nt * 64; d.kscale = p.in[I_QNG] + l * 192; }
    else if (t < N5) { const int nt = t - N4; d.src = p.in[I_WUKV] + (size_t)l * 128 * 512; d.ld = 512; d.K = 128; d.N = 512; d.dst = WUP_T; d.ldd = 256; d.k0 = 0; d.n0 = nt * 64; d.drow0 = 512 + nt * 64; d.kscale = p.in[I_KVNG] + l * 128; }
    else { const int u = t - N5, dir = u / 8, gate = (u / 4) & 1, n = u % 4;
        d.src = p.in[gate ? I_LWX : I_LWA] + (((size_t)l * 2 + dir) * 4 + n) * 4096; d.ld = 64; d.K = 64; d.N = 64; d.dst = LRUW_T + (size_t)((dir * 2 + gate) * 4 + n) * 4096; d.ldd = 64; d.k0 = 0; d.n0 = 0; d.drow0 = 0; }
    return d;
}
DI void tc_load(const TcDesc& d, int tid, f32x4 (&v)[4]) {
#pragma unroll
    for (int i = 0; i < 4; ++i) { const int pi = tid + 512 * i, kk = pi >> 4, n4 = (pi & 15) * 4; v[i] = (f32x4){0.f, 0.f, 0.f, 0.f};
        if (d.k0 + kk < d.K && d.n0 + n4 < d.N) { v[i] = *(const f32x4*)(d.src + (size_t)(d.k0 + kk) * d.ld + d.n0 + n4); if (d.kscale) v[i] = v[i] * d.kscale[d.k0 + kk]; } }
}
__device__ __noinline__ void phase_convert(CPARAMS p, int l, LAS float* tile) {
    const int tid = ltid();
    constexpr int NT = 8 * 42 + 128 + 32 * 2 * 64 + 32 * 64 + 12 + 8 + 16;
    f32x4 v[4], v2[4];
    const int G = gridDim.x;
    int t = blockIdx.x;
    if (t < NT) { const TcDesc d0 = tc_desc(p, l, t); tc_load(d0, tid, v); }
    if (t + G < NT) { const TcDesc d1 = tc_desc(p, l, t + G); tc_load(d1, tid, v2); }
    LAS float* tile2 = tile + 128 * 68;
    for (; t < NT; t += 2 * G) {
        const bool has2 = t + G < NT;
        __syncthreads();
#pragma unroll
        for (int i = 0; i < 4; ++i) { const int pi = tid + 512 * i, kk = pi >> 4, n4 = (pi & 15) * 4; *(LAS f32x4*)(tile + kk * 68 + n4) = v[i]; if (has2) *(LAS f32x4*)(tile2 + kk * 68 + n4) = v2[i]; }
        __syncthreads();
        if (t + 2 * G < NT) { const TcDesc dn = tc_desc(p, l, t + 2 * G); tc_load(dn, tid, v); }
        if (t + 3 * G < NT) { const TcDesc dn = tc_desc(p, l, t + 3 * G); tc_load(dn, tid, v2); }
        for (int which = 0; which < (has2 ? 2 : 1); ++which) {
            const TcDesc cur = tc_desc(p, l, t + which * G); const LAS float* tl = which ? tile2 : tile;
#pragma unroll
            for (int j = 0; j < 2; ++j) { const int pi = tid + 512 * j, nn = pi & 63, kp = pi >> 6;
                if (cur.k0 + kp * 8 < cur.K && cur.n0 + nn < cur.N) {
                    float f[8];
#pragma unroll
                    for (int i = 0; i < 8; ++i) f[i] = tl[(kp * 8 + i) * 68 + nn];
                    u32x4 w; w.x = pk_bf16(f[0], f[1]); w.y = pk_bf16(f[2], f[3]); w.z = pk_bf16(f[4], f[5]); w.w = pk_bf16(f[6], f[7]);
                    const int drow = cur.remap ? zmap(cur.n0 + nn) : cur.drow0 + nn;
                    *(u32x4*)(cur.dst + (size_t)drow * cur.ldd + cur.k0 + kp * 8) = w; } }
        }
    }
    bf16_t* WIN_T = (bf16_t*)(p.ws + WS_WIN_T);
    for (int i = blockIdx.x * 512 + tid; i < 160 * 128; i += gridDim.x * 512) { const int rr_ = i >> 7, row = rr_ < 64 ? 192 + rr_ : 416 + (rr_ - 64); *(u32x4*)(WIN_T + (size_t)row * 1024 + (i & 127) * 8) = (u32x4){0u, 0u, 0u, 0u}; }
    bf16_t* WUP_T = (bf16_t*)(p.ws + WS_WUP_T);
    for (int i = blockIdx.x * 512 + tid; i < 15360; i += gridDim.x * 512) {
        int row, k;
        if (i < 3072) { row = i >> 3; k = 192 + (i & 7) * 8; } else if (i < 7168) { const int j = i - 3072; row = 384 + (j >> 5); k = (j & 31) * 8; } else { const int j = i - 7168; row = 512 + (j >> 4); k = 128 + (j & 15) * 8; }
        *(u32x4*)(WUP_T + (size_t)row * 256 + k) = (u32x4){0u, 0u, 0u, 0u};
    }
}

__device__ __noinline__ void phase_filter(CPARAMS p, int l, LAS float* fl) {
    LAS float* z = fl; LAS float* h1 = fl + 64; LAS float* h2 = fl + 128;
    const int tid = ltid();
    bf16_t* G2048 = (bf16_t*)(p.ws + WS_G2048); bf16_t* G256 = (bf16_t*)(p.ws + WS_G256);
    const float* w1 = p.in[I_HW1] + (size_t)l * 33 * 64; const float* b1 = p.in[I_HB1] + l * 64; const float* w2 = p.in[I_HW2] + (size_t)l * 64 * 64; const float* b2 = p.in[I_HB2] + l * 64;
    const float* w3 = p.in[I_HW3] + (size_t)l * 64 * 512; const float* fr = p.in[I_HFREQ] + l * 64; const float* hd = p.in[I_HD] + l * 256;
    LAS float* w1s = fl + 192; LAS float* w2s = fl + 192 + 33 * 64;
    __syncthreads();
    for (int q = tid; q < 33 * 64; q += 512) w1s[q] = w1[q];
    for (int q = tid; q < 64 * 64; q += 512) w2s[q] = w2[q];
    float w3r[64];
#pragma unroll
    for (int m = 0; m < 64; ++m) w3r[m] = w3[m * 512 + tid];
    const float b1v = tid < 64 ? b1[tid] : 0.f, b2v = tid < 64 ? b2[tid] : 0.f, frv = tid < 64 ? fr[tid] : 0.f;
    for (int pi = blockIdx.x; pi < 2048 + 256; pi += gridDim.x) {
        const int n = pi < 2048 ? 2048 : 256, i = pi < 2048 ? pi : pi - 2048;
        bf16_t* G = pi < 2048 ? G2048 : G256;
        const float tt = (float)i / (float)(n - 1);
        __syncthreads();
        if (tid < 33) {
            float v;
            if (tid == 0) v = tt;
            else { const int j = (tid - 1) & 15; const float band = 1e-4f + (15.f - 1e-4f) * (float)j / 15.f; float rev = band * ((float)i / (float)n); rev -= floorf(rev);
                v = tid <= 16 ? __builtin_amdgcn_cosf(rev) : -__builtin_amdgcn_sinf(rev); }
            z[tid] = v;
        }
        __syncthreads();
        if (tid < 64) { float s = b1v;
#pragma unroll
            for (int m = 0; m < 33; ++m) s += z[m] * w1s[m * 64 + tid]; h1[tid] = hw_sin(frv * s); }
        __syncthreads();
        if (tid < 64) { float s = b2v;
#pragma unroll
            for (int m = 0; m < 64; ++m) s += h1[m] * w2s[m * 64 + tid]; h2[tid] = hw_sin(frv * s); }
        __syncthreads();
        {
            const int j = tid; float s = 0.f;
#pragma unroll
            for (int m = 0; m < 64; ++m) s += h2[m] * w3r[m];
            const int c = j & 255; const float mind = logf(1e-2f) / 1.5f, maxd = logf(1e-2f) / 0.3f; const float delta = fabsf(mind + (maxd - mind) * (float)c / 255.f);
            float hv = s * expf(-tt * delta);
            if (j < 256) { if (i == 0) hv += hd[c]; G[(size_t)c * 2 * n + (n - i)] = f2bf(hv); if (i == 0) G[(size_t)c * 2 * n] = 0; }
            else if (i >= 1) G[(size_t)c * 2 * n + (n + i)] = f2bf(hv);
        }
    }
}

struct ModVec { float a[16], b[16]; };
DI void load_modvec(const float* g, const float* sh, const float* sc, int lane, ModVec& mv) {
#pragma unroll
    for (int j = 0; j < 4; ++j) { const int k = j * 256 + lane * 4; const f32x4 gv = *(const f32x4*)(g + k), sv = *(const f32x4*)(sc + k), hv = *(const f32x4*)(sh + k);
#pragma unroll
        for (int q = 0; q < 4; ++q) { mv.a[j * 4 + q] = gv[q] * (1.f + sv[q]); mv.b[j * 4 + q] = hv[q]; } }
}
DI void ld_row_bf(const bf16_t* xr, int lane, f32x4 (&v)[4]) {
#pragma unroll
    for (int j = 0; j < 4; ++j) { const u32x2 w = *(const u32x2*)(xr + j * 256 + lane * 4); v[j] = (f32x4){__uint_as_float(w.x << 16), __uint_as_float(w.x & 0xffff0000u), __uint_as_float(w.y << 16), __uint_as_float(w.y & 0xffff0000u)}; }
}
DI void ld_row_nt(const float* xr, int lane, f32x4 (&v)[4]) {
#pragma unroll
    for (int j = 0; j < 4; ++j) v[j] = __builtin_nontemporal_load((const f32x4*)(xr + j * 256 + lane * 4));
}
DI void ld_row(const float* xr, int lane, f32x4 (&v)[4]) {
#pragma unroll
    for (int j = 0; j < 4; ++j) v[j] = *(const f32x4*)(xr + j * 256 + lane * 4);
}
DI void norm_store(const f32x4 (&v)[4], const ModVec& mv, bf16_t* dst, int lane, float (&f)[16]) {
    float ss = 0.f;
#pragma unroll
    for (int j = 0; j < 4; ++j) ss += v[j][0] * v[j][0] + v[j][1] * v[j][1] + v[j][2] * v[j][2] + v[j][3] * v[j][3];
    ss = wave_sum(ss);
    const float rstd = rsqrtf(ss * (1.f / 1024.f) + EPS);
#pragma unroll
    for (int j = 0; j < 4; ++j) {
#pragma unroll
        for (int q = 0; q < 4; ++q) f[j * 4 + q] = v[j][q] * rstd * mv.a[j * 4 + q] + mv.b[j * 4 + q];
        u32x2 w; w.x = pk_bf16(f[j * 4], f[j * 4 + 1]); w.y = pk_bf16(f[j * 4 + 2], f[j * 4 + 3]);
        *(u32x2*)(dst + j * 256 + lane * 4) = w;
    }
}
__device__ __noinline__ void phase_norm1(CPARAMS p, int l) {
    const int lane = ltid() & 63; const int w = blockIdx.x * 8 + __builtin_amdgcn_readfirstlane(ltid() >> 6), nw = gridDim.x * 8;
    bf16_t* ACT = (bf16_t*)(p.ws + WS_ACT);
    const int per = (T + nw - 1) / nw; const int tA = w * per, tB = tA + per < T ? tA + per : T;
    ModVec mv; int curmr = -1; f32x4 cur[4], nx[4];
    if (tA < tB) ld_row_nt(tA < TL ? p.in[I_X] + (size_t)tA * D : p.in[I_CTX] + (size_t)(tA - TL) * D, lane, cur);
    for (int tok = tA; tok < tB; ++tok) {
        if (tok + 1 < tB) { const int tn = tok + 1; ld_row_nt(tn < TL ? p.in[I_X] + (size_t)tn * D : p.in[I_CTX] + (size_t)(tn - TL) * D, lane, nx); }
        const int mr = tok < TL ? tok / SEQ : 32;
        if (mr != curmr) { const float* m = modrow(p, l, mr); load_modvec(p.in[I_N1G] + l * D, m, m + 1024, lane, mv); curmr = mr; }
        float f[16];
        norm_store(cur, mv, ACT + (size_t)tok * D, lane, f);
#pragma unroll
        for (int j = 0; j < 4; ++j) cur[j] = nx[j];
    }
}

DI float conv3_at(const bf16_t* Z, int tokbase, int t, int L, int zcol, const float* cw, const float* cb, int ch768) {
    float s = cb[ch768];
#pragma unroll
    for (int j = 0; j < 3; ++j) { const int tt = t - 1 + j; if (tt >= 0 && tt < L) s += cw[j * 768 + ch768] * bf2f(Z[zoff(tokbase + tt, zcol)]); }
    return s;
}
DI void unpk4(const u32x2 w, float (&f)[4]) { f[0] = __uint_as_float(w.x << 16); f[1] = __uint_as_float(w.x & 0xffff0000u); f[2] = __uint_as_float(w.y << 16); f[3] = __uint_as_float(w.y & 0xffff0000u); }
DI u32x2 ld4(const bf16_t* p_) { return *(const u32x2*)p_; }
DI u32x2 ld4nt(const bf16_t* p_) { return __builtin_nontemporal_load((const u32x2*)p_); }
DI float fast_silu(float v) { return v * __builtin_amdgcn_rcpf(1.f + __builtin_amdgcn_exp2f(-1.4426950408889634f * v)); }
DI float fast_gelu_tanh(float x) { const float u = 0.7978845608028654f * (x + 0.044715f * x * x * x); const float e = __builtin_amdgcn_exp2f(-2.f * 1.4426950408889634f * u); return x * __builtin_amdgcn_rcpf(1.f + e); }
constexpr int MG_PITCH = 516;
DI void unpk8(const u32x4 w, float (&f)[8]) {
#pragma unroll
    for (int i = 0; i < 4; ++i) { f[2 * i] = __uint_as_float(w[i] << 16); f[2 * i + 1] = __uint_as_float(w[i] & 0xffff0000u); }
}
DI u32x4 ld8(const bf16_t* p_) { return *(const u32x4*)p_; }
DI u32x4 ld8nt(const bf16_t* p_) { return __builtin_nontemporal_load((const u32x4*)p_); }
DI float swap16_add(float v) { const auto r_ = __builtin_amdgcn_permlane16_swap(__float_as_uint(v), __float_as_uint(v), false, false); return __uint_as_float(r_[0]) + __uint_as_float(r_[1]); }
DI float hsum32(float v) { v = row_sum16(v); return swap16_add(v); }
DI void phase_merge(CPARAMS p, int l, LAS unsigned char* lds) {
    const int tid = ltid(), lane = tid & 63, wid = __builtin_amdgcn_readfirstlane(tid >> 6), half = lane >> 5, l5 = lane & 31;
    const bf16_t* Z = (const bf16_t*)(p.ws + WS_Z); bf16_t* ACT = (bf16_t*)(p.ws + WS_ACT);
    const bf16_t* YA = (const bf16_t*)(p.ws + WS_YA); const bf16_t* OF = (const bf16_t*)(p.ws + WS_OF); const bf16_t* OB = (const bf16_t*)(p.ws + WS_OB);
    const bf16_t* HF = (const bf16_t*)(p.ws + WS_HF); const bf16_t* HB = (const bf16_t*)(p.ws + WS_HB);
    const int ch0 = 8 * l5;
    float rng[8], cw[3][8], cb[8];
#pragma unroll
    for (int q = 0; q < 8; ++q) {
        rng[q] = p.in[I_RNG][l * 256 + ch0 + q]; cb[q] = p.in[I_HCB][l * 768 + ch0 + q];
#pragma unroll
        for (int j = 0; j < 3; ++j) cw[j][q] = p.in[I_HCW][((size_t)l * 3 + j) * 768 + ch0 + q];
    }
    const float* gng = p.in[I_GNG] + l * 1024;
    const int ntl = TL / 64, ntc = l == 0 ? TC / 64 : 0;
    for (int u = blockIdx.x; u < ntl + ntc; u += gridDim.x) {
        const bool lat = u < ntl; const int L = lat ? SEQ : CTXL; const int tok0 = lat ? u * 64 : TL + (u - ntl) * 64;
        const int b = lat ? tok0 / SEQ : (tok0 - TL) / CTXL; const int t0 = lat ? tok0 % SEQ : (tok0 - TL) % CTXL;
        const bf16_t* YT = (const bf16_t*)(p.ws + (lat ? WS_YT : WS_YTC));
        u32x4 cug[10], nxg[10];
#define MG_LOAD(i_, g_) do { const int tl_ = wid * 8 + (i_) * 2 + half, tok_ = tok0 + tl_, t_ = t0 + tl_; \
            g_[0] = ld8nt(YA + (size_t)tok_ * 256 + ch0); g_[1] = ld8nt(OF + (size_t)tok_ * 256 + ch0); g_[2] = ld8nt(OB + (size_t)tok_ * 256 + ch0); g_[3] = ld8nt(Z + zoff(tok_, ZC_RG + ch0)); \
            g_[4] = ld8nt(HF + (size_t)tok_ * 256 + ch0); g_[5] = ld8nt(HB + (size_t)tok_ * 256 + ch0); g_[6] = ld8nt(Z + zoff(tok_, ZC_LG + ch0)); \
            _Pragma("unroll") for (int j = 0; j < 3; ++j) { const int tt = t_ - 1 + j; g_[7 + j] = (u32x4){0u, 0u, 0u, 0u}; if (tt >= 0 && tt < L) g_[7 + j] = ld8(Z + zoff(tok_ - 1 + j, ZC_HX0 + ch0)); } } while (0)
        MG_LOAD(0, cug);
        __syncthreads();
#pragma unroll
        for (int j = 0; j < 4; ++j) { const int pi = tid + 512 * j, ch = pi >> 3, tp = pi & 7; const u32x4 v = *(const u32x4*)(YT + ((size_t)ch * NB + b) * L + t0 + tp * 8);
#pragma unroll
            for (int d4 = 0; d4 < 4; ++d4) { *(LAS bf16_t*)(lds + (tp * 8 + 2 * d4) * MG_PITCH + ch * 2) = (bf16_t)(v[d4] & 0xffffu); *(LAS bf16_t*)(lds + (tp * 8 + 2 * d4 + 1) * MG_PITCH + ch * 2) = (bf16_t)(v[d4] >> 16); } }
        __syncthreads();
        for (int i = 0; i < 4; ++i) {
            const int tl = wid * 8 + i * 2 + half, tok = tok0 + tl, t = t0 + tl;
            if (i + 1 < 4) MG_LOAD(i + 1, nxg);
            const u32x4 wya = cug[0], wof = cug[1], wob = cug[2], wrg = cug[3], whf = cug[4], whb = cug[5], wlg = cug[6];
            u32x4 wx[3] = {cug[7], cug[8], cug[9]};
            u32x4 wy;
#pragma unroll
            for (int d4 = 0; d4 < 4; ++d4) wy[d4] = *(const LAS unsigned*)(lds + tl * MG_PITCH + ch0 * 2 + d4 * 4);
            float v[4][8], a[8], c2[8], d2[8];
            unpk8(wya, v[0]);
            unpk8(wof, a); unpk8(wob, c2); unpk8(wrg, d2);
            float ssb = 0.f;
#pragma unroll
            for (int q = 0; q < 8; ++q) { a[q] += c2[q]; ssb += a[q] * a[q]; }
            ssb = dpp_add(ssb, 0); ssb = dpp_add(ssb, 1); ssb = dpp_add(ssb, 2);
            const float rsb = rsqrtf(ssb * (1.f / 64.f) + EPS);
#pragma unroll
            for (int q = 0; q < 8; ++q) v[1][q] = a[q] * rsb * rng[q] * fast_silu(d2[q]);
            {
                float x0[8], y[8];
#pragma unroll
                for (int q = 0; q < 8; ++q) x0[q] = cb[q];
#pragma unroll
                for (int j = 0; j < 3; ++j) { const int tt = t - 1 + j; float xz[8]; unpk8(wx[j], xz); if (tt >= 0 && tt < L) {
#pragma unroll
                        for (int q = 0; q < 8; ++q) x0[q] += cw[j][q] * xz[q]; } }
                unpk8(wy, y);
#pragma unroll
                for (int q = 0; q < 8; ++q) v[2][q] = x0[q] * y[q];
            }
            unpk8(whf, a); unpk8(whb, c2); unpk8(wlg, d2);
#pragma unroll
            for (int q = 0; q < 8; ++q) v[3][q] = (a[q] + c2[q]) * fast_gelu_tanh(d2[q]);
#pragma unroll
            for (int g = 0; g < 4; ++g) {
                float ss = 0.f;
#pragma unroll
                for (int q = 0; q < 8; ++q) ss += v[g][q] * v[g][q];
                ss = hsum32(ss); const float rs = rsqrtf(ss * (1.f / 256.f) + EPS);
                const f32x4 g0 = *(const f32x4*)(gng + g * 256 + ch0), g1 = *(const f32x4*)(gng + g * 256 + ch0 + 4);
                u32x4 w; w.x = pk_bf16(v[g][0] * rs * g0[0], v[g][1] * rs * g0[1]); w.y = pk_bf16(v[g][2] * rs * g0[2], v[g][3] * rs * g0[3]);
                w.z = pk_bf16(v[g][4] * rs * g1[0], v[g][5] * rs * g1[1]); w.w = pk_bf16(v[g][6] * rs * g1[2], v[g][7] * rs * g1[3]);
                *(u32x4*)(ACT + (size_t)tok * D + g * 256 + ch0) = w;
            }
#pragma unroll
            for (int j = 0; j < 10; ++j) cug[j] = nxg[j];
        }
#undef MG_LOAD
    }
}

DI float half_sum32(float v) { v = row_sum16(v); return swap16_add(v); }
DI void phase_norm2(CPARAMS p, int l, LAS unsigned char* lds) {
    const int tid = ltid(), lane = tid & 63, wid = __builtin_amdgcn_readfirstlane(tid >> 6), half = lane >> 5, l5 = lane & 31; const int M = l == 0 ? T : TL;
    const int per = (M + (int)gridDim.x - 1) / (int)gridDim.x; const int tokA = blockIdx.x * per, tokB = (tokA + per < M) ? tokA + per : M;
    LAS unsigned* lcnt = (LAS unsigned*)(lds + 147456); LAS unsigned* lbase = lcnt + 32; LAS unsigned* info = lcnt + 64;
    __syncthreads();
    if (tid < 32) lcnt[tid] = 0u;
    {
        const float* weg = p.in[I_MWE] + (size_t)l * 1024 * 32; const float* wgg = p.in[I_MWG] + (size_t)l * 1024 * 4;
        for (int p0 = tid; p0 < 8192; p0 += 512 * 8) { f32x4 wv8[8];
#pragma unroll
            for (int u = 0; u < 8; ++u) { const int pi = p0 + 512 * u, k = pi >> 3, c = pi & 7; wv8[u] = *(const f32x4*)(weg + (size_t)k * 32 + c * 4); }
#pragma unroll
            for (int u = 0; u < 8; ++u) { const int pi = p0 + 512 * u, k = pi >> 3, c = pi & 7; *(LAS f32x4*)(lds + k * 128 + ((c ^ ((k >> 3) & 7)) * 16)) = wv8[u]; } }
        for (int k = tid; k < 1024; k += 512) { const int jj = k >> 8, ln = (k & 255) >> 3, i = k & 7; *(LAS f32x4*)(lds + 131072 + ((jj * 8 + i) * 32 + ln) * 16) = *(const f32x4*)(wgg + (size_t)k * 4); }
    }
    __syncthreads();
    bf16_t* ACT = (bf16_t*)(p.ws + WS_ACT); const float* XC = (const float*)(p.ws + WS_XC);
    unsigned* cnt = (unsigned*)(p.ws + WS_CTL) + CW_COUNT + l * 32; int* ETOK = (int*)(p.ws + WS_ETOK); float* EW = (float*)(p.ws + WS_EW);
    int wper = (tokB - tokA + 7) / 8; wper += wper & 1; const int wA = tokA + wid * wper, wB = wA + wper < tokB ? wA + wper : tokB;
    const bf16_t* XB1 = (const bf16_t*)(p.ws + WS_XB1);
    float ma[32], mb[32]; int curmr = -1;
    u32x4 nxr[4];
#define N2_LOADRAW(tk) do { _Pragma("unroll") for (int jj = 0; jj < 4; ++jj) nxr[jj] = __builtin_nontemporal_load((const u32x4*)(XB1 + (size_t)(tk) * D + jj * 256 + l5 * 8)); } while (0)
    if (wA < wB && wA < TL) N2_LOADRAW(wA + half);
    for (int tok0 = wA; tok0 < wB; tok0 += 2) {
        const int tok = tok0 + half;
        float x[32];
        if (tok0 < TL) {
#pragma unroll
            for (int jj = 0; jj < 4; ++jj) { float t8[8]; unpk8(nxr[jj], t8);
#pragma unroll
                for (int i = 0; i < 8; ++i) x[jj * 8 + i] = t8[i]; }
            if (tok0 + 2 < wB) N2_LOADRAW(tok + 2);
        } else {
#pragma unroll
            for (int jj = 0; jj < 4; ++jj) { const f32x4 a0 = *(const f32x4*)(XC + (size_t)(tok - TL) * D + jj * 256 + l5 * 8), a1 = *(const f32x4*)(XC + (size_t)(tok - TL) * D + jj * 256 + l5 * 8 + 4);
                x[jj * 8] = a0[0]; x[jj * 8 + 1] = a0[1]; x[jj * 8 + 2] = a0[2]; x[jj * 8 + 3] = a0[3]; x[jj * 8 + 4] = a1[0]; x[jj * 8 + 5] = a1[1]; x[jj * 8 + 6] = a1[2]; x[jj * 8 + 7] = a1[3]; }
        }
        const int mr = tok0 < TL ? tok0 / SEQ : 32;
        if (mr != curmr) { const float* m = modrow(p, l, mr); const float* g = p.in[I_N2G] + l * D;
#pragma unroll
            for (int jj = 0; jj < 4; ++jj)
#pragma unroll
                for (int q = 0; q < 2; ++q) { const int k = jj * 256 + l5 * 8 + 4 * q; const f32x4 gv = *(const f32x4*)(g + k), sv = *(const f32x4*)(m + 4096 + k), hv = *(const f32x4*)(m + 3072 + k);
#pragma unroll
                    for (int e = 0; e < 4; ++e) { ma[jj * 8 + 4 * q + e] = gv[e] * (1.f + sv[e]); mb[jj * 8 + 4 * q + e] = hv[e]; } }
            curmr = mr; }
        float ss = 0.f;
#pragma unroll
        for (int i = 0; i < 32; ++i) ss += x[i] * x[i];
        ss = half_sum32(ss);
        const float rstd = rsqrtf(ss * (1.f / 1024.f) + EPS);
#pragma unroll
        for (int i = 0; i < 32; ++i) x[i] = x[i] * rstd * ma[i] + mb[i];
#pragma unroll
        for (int jj = 0; jj < 4; ++jj) { u32x4 w; w.x = pk_bf16(x[jj * 8], x[jj * 8 + 1]); w.y = pk_bf16(x[jj * 8 + 2], x[jj * 8 + 3]); w.z = pk_bf16(x[jj * 8 + 4], x[jj * 8 + 5]); w.w = pk_bf16(x[jj * 8 + 6], x[jj * 8 + 7]);
            *(u32x4*)(ACT + (size_t)tok * D + jj * 256 + l5 * 8) = w; }
        float lg[4] = {0.f, 0.f, 0.f, 0.f};
#pragma unroll
        for (int jj = 0; jj < 4; ++jj)
#pragma unroll
            for (int i = 0; i < 8; ++i) { const f32x4 wv = *(const LAS f32x4*)(lds + 131072 + ((jj * 8 + i) * 32 + l5) * 16); const float fv = x[jj * 8 + i]; lg[0] += fv * wv[0]; lg[1] += fv * wv[1]; lg[2] += fv * wv[2]; lg[3] += fv * wv[3]; }
#pragma unroll
        for (int j = 0; j < 4; ++j) lg[j] = half_sum32(lg[j]);
        int gi = 0; float gm = lg[0];
#pragma unroll
        for (int j = 1; j < 4; ++j) if (lg[j] > gm) { gm = lg[j]; gi = j; }
        float den = 0.f;
#pragma unroll
        for (int j = 0; j < 4; ++j) den += __builtin_amdgcn_exp2f((lg[j] - gm) * 1.4426950408889634f);
        const float gval = 1.f / den;
        float el[8] = {0.f, 0.f, 0.f, 0.f, 0.f, 0.f, 0.f, 0.f};
        const int c0 = ((gi * 2) ^ (l5 & 7)) * 16, c1 = ((gi * 2 + 1) ^ (l5 & 7)) * 16;
#pragma unroll
        for (int jj = 0; jj < 4; ++jj)
#pragma unroll
            for (int i = 0; i < 8; ++i) { const LAS unsigned char* wr = lds + (jj * 256 + l5 * 8 + i) * 128; const f32x4 w0 = *(const LAS f32x4*)(wr + c0), w1 = *(const LAS f32x4*)(wr + c1); const float fv = x[jj * 8 + i];
                el[0] += fv * w0[0]; el[1] += fv * w0[1]; el[2] += fv * w0[2]; el[3] += fv * w0[3]; el[4] += fv * w1[0]; el[5] += fv * w1[1]; el[6] += fv * w1[2]; el[7] += fv * w1[3]; }
#pragma unroll
        for (int j = 0; j < 8; ++j) el[j] = half_sum32(el[j]);
        int i1 = 0; float m1 = el[0];
#pragma unroll
        for (int j = 1; j < 8; ++j) if (el[j] > m1) { m1 = el[j]; i1 = j; }
        int i2 = -1; float m2 = -3.0e38f;
#pragma unroll
        for (int j = 0; j < 8; ++j) if (j != i1 && el[j] > m2) { m2 = el[j]; i2 = j; }
        const float e2 = __builtin_amdgcn_exp2f((m2 - m1) * 1.4426950408889634f); const float w1v = gval / (1.f + e2), w2v = gval * e2 / (1.f + e2);
        if (l5 == 0) {
            const int ea = gi * 8 + i1, eb = gi * 8 + i2;
            const unsigned ra = __hip_atomic_fetch_add(&lcnt[ea], 1u, __ATOMIC_RELAXED, __HIP_MEMORY_SCOPE_WORKGROUP), rb = __hip_atomic_fetch_add(&lcnt[eb], 1u, __ATOMIC_RELAXED, __HIP_MEMORY_SCOPE_WORKGROUP);
            info[(tok - tokA) * 2] = (unsigned)ea | (ra << 8); info[(tok - tokA) * 2 + 1] = (unsigned)eb | (rb << 8); EW[tok * 2] = w1v; EW[tok * 2 + 1] = w2v;
        }
    }
#undef N2_LOADRAW
    __syncthreads();
    if (tid < 32) lbase[tid] = __hip_atomic_fetch_add(&cnt[tid], lcnt[tid], __ATOMIC_RELAXED, __HIP_MEMORY_SCOPE_AGENT);
    __syncthreads();
    for (int idx = tid; idx < (tokB - tokA) * 2; idx += 512) { const unsigned inf = info[idx]; const unsigned e = inf & 0xffu, r = inf >> 8; ETOK[(size_t)e * CAPE + lbase[e] + r] = (tokA + (idx >> 1)) * 2 + (idx & 1); }
}

DI void phase_combine(CPARAMS p, int l) {
    const int lane = ltid() & 63; const int w = blockIdx.x * 8 + __builtin_amdgcn_readfirstlane(ltid() >> 6), nw = gridDim.x * 8; const int M = l == 0 ? T : TL;
    const bf16_t* Y = (const bf16_t*)(p.ws + WS_YTOK); bf16_t* ACT = (bf16_t*)(p.ws + WS_ACT); float* XC = (float*)(p.ws + WS_XC);
    const float* TW = (const float*)(p.ws + WS_EW);
    const int per = (M + nw - 1) / nw; const int tA = w * per, tB = tA + per < M ? tA + per : M;
    ModVec mv; float g2v[16]; int curmr = -1;
    f32x4 cur[4], nx[4]; u32x2 cy0[4], cy1[4], ny0[4], ny1[4];
#define CB_LOAD(tk, xv_, y0_, y1_) do { if ((tk) < TL) ld_row_bf((const bf16_t*)(p.ws + WS_XB1) + (size_t)(tk) * D, lane, xv_); else ld_row(XC + (size_t)((tk) - TL) * D, lane, xv_); \
        _Pragma("unroll") for (int j = 0; j < 4; ++j) { y0_[j] = *(const u32x2*)(Y + (size_t)((tk) * 2) * D + j * 256 + lane * 4); y1_[j] = *(const u32x2*)(Y + (size_t)((tk) * 2 + 1) * D + j * 256 + lane * 4); } } while (0)
    if (tA < tB) CB_LOAD(tA, cur, cy0, cy1);
    for (int tok = tA; tok < tB; ++tok) {
        if (tok + 1 < tB) CB_LOAD(tok + 1, nx, ny0, ny1);
        const int mr = tok < TL ? tok / SEQ : 32;
        if (mr != curmr) { const float* g2 = modrow(p, l, mr) + 5120;
#pragma unroll
            for (int j = 0; j < 4; ++j) { const f32x4 gv = *(const f32x4*)(g2 + j * 256 + lane * 4); g2v[j * 4] = gv[0]; g2v[j * 4 + 1] = gv[1]; g2v[j * 4 + 2] = gv[2]; g2v[j * 4 + 3] = gv[3]; }
            if (l == 0) { const float* m = modrow(p, 1, mr); load_modvec(p.in[I_N1G] + D, m, m + 1024, lane, mv); }
            curmr = mr; }
        const float tw0 = TW[tok * 2], tw1 = TW[tok * 2 + 1];
        f32x4 o[4];
#pragma unroll
        for (int j = 0; j < 4; ++j) {
            float ya[4], yb[4]; unpk4(cy0[j], ya); unpk4(cy1[j], yb);
#pragma unroll
            for (int q = 0; q < 4; ++q) o[j][q] = cur[j][q] + g2v[j * 4 + q] * (tw0 * ya[q] + tw1 * yb[q]);
            if (tok >= TL) *(f32x4*)(XC + (size_t)(tok - TL) * D + j * 256 + lane * 4) = o[j];
            else if (l == 1) *(f32x4*)(p.out + (size_t)tok * D + j * 256 + lane * 4) = o[j];
            else { u32x2 w; w.x = pk_bf16(o[j][0], o[j][1]); w.y = pk_bf16(o[j][2], o[j][3]); *(u32x2*)((bf16_t*)p.out + (size_t)tok * D + j * 256 + lane * 4) = w; }
        }
        if (l == 0) { float f[16]; norm_store(o, mv, ACT + (size_t)tok * D, lane, f); }
#pragma unroll
        for (int j = 0; j < 4; ++j) { cur[j] = nx[j]; cy0[j] = ny0[j]; cy1[j] = ny1[j]; }
    }
#undef CB_LOAD
}

namespace gp {
#define GP_LAS __attribute__((address_space(3)))
constexpr int BM = 256, BK = 64, HALF = 128, HTB = HALF * BK * 2, STAGE_BYTES = 8 * HTB, NXCD = 8, WGM = 8;
__host__ __device__ __forceinline__ int lds_byte(int r, int c) { const int st = (r >> 4) * 2 + (c >> 5), rr = r & 15, cc = c & 31, ob = rr * 64 + cc * 2; return st * 1024 + (ob ^ (((ob >> 9) & 1) << 5)); }
__host__ __device__ __forceinline__ void stage_rc(int b, int& R, int& C) { const int st = b / 1024, sb = b % 1024, swz = sb ^ (((sb >> 9) & 1) << 5); R = (st >> 1) * 16 + swz / 64; C = (st & 1) * 32 + (swz % 64) / 2; }
__host__ __device__ __forceinline__ int perm32(int rho) { const int n = rho >> 4, i = rho & 15; return 8 * (i >> 2) + 4 * n + (i & 3); }
__device__ __forceinline__ unsigned cvt_pk_bf16(float lo, float hi) { unsigned r; asm volatile("v_cvt_pk_bf16_f32 %0, %1, %2" : "=v"(r) : "v"(lo), "v"(hi)); return r; }

struct Unit { int pm, pn, e, pos0, nvalid; };

struct StaticOrder {
    int nM, nN, nwg, G, c;
    __device__ void init(int nM_, int nN_, int G_, int c_) { nM = nM_; nN = nN_; nwg = nM * nN; G = G_; c = c_; }
    __device__ bool next(int i, Unit& u) const {
        const long L = (long)i * G + c; if (L >= nwg) return false;
        int wgid = (int)L; { const int q = nwg / NXCD, r = nwg % NXCD, xcd = wgid % NXCD, off = wgid / NXCD; wgid = (xcd < r ? xcd * (q + 1) : r * (q + 1) + (xcd - r) * q) + off; }
        const int nig = WGM * nN, gid = wgid / nig, fm = gid * WGM, gsz = (nM - fm) < WGM ? (nM - fm) : WGM;
        u.pm = fm + ((wgid % nig) % gsz); u.pn = (wgid % nig) / gsz; u.e = 0; u.pos0 = 0; u.nvalid = 256; return true;
    }
};
struct CtxTrimOrder {
    StaticOrder so; int nlat, nct, ctxmask, nN, G, c;
    __device__ void init(int nN_, int ctxmask_, int G_, int c_) { nN = nN_; ctxmask = ctxmask_; nct = __popc(ctxmask_); G = G_; c = c_; so.init(TL / 256, nN_, G_, c_); nlat = (TL / 256) * nN_; }
    __device__ bool next(int i, Unit& u) const {
        const long L = (long)i * G + c;
        if (L < nlat) return so.next(i, u);
        const int r = (int)(L - nlat); if (r >= (TC / 256) * nct) return false;
        const int pmc = r / nct; int k = r % nct, pn = 0;
        for (int b = 0; b < nN; ++b) if ((ctxmask >> b) & 1) { if (k == 0) { pn = b; break; } --k; }
        u.pm = TL / 256 + pmc; u.pn = pn; u.e = 0; u.pos0 = 0; u.nvalid = 256; return true;
    }
};
struct MoeOrder {
    StaticOrder so; const LAS unsigned* tab;
    __device__ void init(const LAS unsigned* tab_, int nN, int G, int c) { tab = tab_; so.init(__builtin_amdgcn_readfirstlane((int)tab_[32]), nN, G, c); }
    __device__ bool next(int i, Unit& u) const {
        if (!so.next(i, u)) return false;
        const int lane = threadIdx.x & 63;
        const unsigned bs = tab[lane & 31];
        const unsigned long long m = __ballot(lane < 32 && bs <= (unsigned)u.pm);
        const int e = __popcll(m) - 1;
        const int b0 = __builtin_amdgcn_readfirstlane((int)tab[e]), cn = __builtin_amdgcn_readfirstlane((int)tab[64 + e]);
        u.e = e; u.pos0 = (u.pm - b0) * 256; const int rem = cn - u.pos0; u.nvalid = rem < 256 ? rem : 256; return true;
    }
};
DI void moe_table(const unsigned* cnt, LAS unsigned* tab) {
    const int tid = ltid();
    if (tid < 64) {
        const unsigned cv = tid < 32 ? cnt[tid] : 0u; unsigned nb = (cv + 255u) >> 8, incl = nb;
#pragma unroll
        for (int o = 1; o < 32; o <<= 1) { const unsigned t = __shfl_up(incl, o); if ((tid & 63) >= o) incl += t; }
        if (tid < 32) { tab[tid] = incl - nb; tab[64 + tid] = cv; }
        if (tid == 31) tab[32] = incl;
    }
}
struct SrcPlain {
    static constexpr bool GATHER = false;
    const bf16_t* A; const bf16_t* Bt; int lda, K;
    __device__ __forceinline__ const char* a_base(const Unit& u) const { return (const char*)A + (size_t)u.pm * 256 * lda * 2; }
    __device__ __forceinline__ const char* b_base(const Unit& u) const { return (const char*)Bt + (size_t)u.pn * 256 * K * 2; }
    __device__ __forceinline__ unsigned a_off(const Unit&, int, int) const { return 0u; }
    __device__ __forceinline__ int a_raw(const Unit&, int) const { return 0; }
    __device__ __forceinline__ unsigned a_fin(int, int) const { return 0u; }
};
struct SrcUp {
    static constexpr bool GATHER = false;
    const bf16_t* A; const bf16_t* Bt; int lda, K;
    __device__ __forceinline__ const char* a_base(const Unit& u) const { return (const char*)A + ((size_t)(u.pn >= 2 ? 1 : 0) * T + (size_t)u.pm * 256) * 256 * 2; }
    __device__ __forceinline__ const char* b_base(const Unit& u) const { return (const char*)Bt + (size_t)u.pn * 256 * K * 2; }
    __device__ __forceinline__ unsigned a_off(const Unit&, int, int) const { return 0u; }
    __device__ __forceinline__ int a_raw(const Unit&, int) const { return 0; }
    __device__ __forceinline__ unsigned a_fin(int, int) const { return 0u; }
};
struct SrcMoe2 {
    static constexpr bool GATHER = false;
    const bf16_t* A; const bf16_t* Bt; int lda, K;
    __device__ __forceinline__ const char* a_base(const Unit& u) const { return (const char*)A + (size_t)u.pm * 256 * lda * 2; }
    __device__ __forceinline__ const char* b_base(const Unit& u) const { return (const char*)Bt + ((size_t)u.e * 1024 + (size_t)u.pn * 256) * K * 2; }
    __device__ __forceinline__ unsigned a_off(const Unit&, int, int) const { return 0u; }
    __device__ __forceinline__ int a_raw(const Unit&, int) const { return 0; }
    __device__ __forceinline__ unsigned a_fin(int, int) const { return 0u; }
};
struct SrcMoe1 {
    static constexpr bool GATHER = true;
    const bf16_t* A; const bf16_t* Bt; int lda, K; const int* etok;
    __device__ __forceinline__ const char* a_base(const Unit&) const { return (const char*)A; }
    __device__ __forceinline__ const char* b_base(const Unit& u) const { return (const char*)Bt + ((size_t)u.e * 1024 + (size_t)u.pn * 256) * K * 2; }
    __device__ __forceinline__ unsigned a_off(const Unit& u, int r, int c) const {
        const int tok = r < u.nvalid ? (etok[(size_t)u.e * CAPE + u.pos0 + r] >> 1) : 0; return (unsigned)(tok * lda + c) * 2u; }
    __device__ __forceinline__ int a_raw(const Unit& u, int r) const { const int rr = r < u.nvalid ? r : u.nvalid - 1; return etok[(size_t)u.e * CAPE + u.pos0 + rr]; }
    __device__ __forceinline__ unsigned a_fin(int raw, int c) const { return (unsigned)((raw >> 1) * lda + c) * 2u; }
};

struct EpiBf16 {
    static constexpr bool PERM = true;
    bf16_t* O; int ldc;
    __device__ __forceinline__ void operator()(const f32x4 (&acc)[2][2][4][2], const Unit& u, int wr, int wc, int fr, int fq) const {
        const int row0 = u.pm * BM + wr * 64 + fr, col0 = u.pn * BM + wc * 32 + 8 * fq;
#pragma unroll
        for (int ai = 0; ai < 2; ++ai)
#pragma unroll
            for (int m = 0; m < 4; ++m) { bf16_t* rowp = O + (size_t)(row0 + ai * HALF + m * 16) * ldc + col0;
#pragma unroll
                for (int bj = 0; bj < 2; ++bj) { const f32x4 v0 = acc[ai][bj][m][0], v1 = acc[ai][bj][m][1];
                    u32x4 w; w.x = cvt_pk_bf16(v0[0], v0[1]); w.y = cvt_pk_bf16(v0[2], v0[3]); w.z = cvt_pk_bf16(v1[0], v1[1]); w.w = cvt_pk_bf16(v1[2], v1[3]);
                    *(u32x4*)(rowp + bj * HALF) = w; } }
    }
};
struct EpiZ {
    static constexpr bool PERM = true;
    bf16_t* O;
    __device__ __forceinline__ void operator()(const f32x4 (&acc)[2][2][4][2], const Unit& u, int wr, int wc, int fr, int fq) const {
        const int row0 = u.pm * BM + wr * 64 + fr, col0 = wc * 32 + 8 * fq; bf16_t* base = O + (size_t)u.pn * T * 256;
#pragma unroll
        for (int ai = 0; ai < 2; ++ai)
#pragma unroll
            for (int m = 0; m < 4; ++m) { bf16_t* rowp = base + (size_t)(row0 + ai * HALF + m * 16) * 256 + col0;
#pragma unroll
                for (int bj = 0; bj < 2; ++bj) { const f32x4 v0 = acc[ai][bj][m][0], v1 = acc[ai][bj][m][1];
                    u32x4 w; w.x = cvt_pk_bf16(v0[0], v0[1]); w.y = cvt_pk_bf16(v0[2], v0[3]); w.z = cvt_pk_bf16(v1[0], v1[1]); w.w = cvt_pk_bf16(v1[2], v1[3]);
                    *(u32x4*)(rowp + bj * HALF) = w; } }
    }
};
struct EpiResid {
    static constexpr bool PERM = true;
    const float* xinLf; const bf16_t* xinLb; bf16_t* outLb; const float* xinC; float* outC; const float* mod;
    template <int MODE>
    __device__ __forceinline__ void run(const f32x4 (&acc)[2][2][4][2], size_t ro0, const f32x4 (&gv)[2][2]) const {
#pragma unroll
        for (int ai = 0; ai < 2; ++ai) {
            if constexpr (MODE == 2) {
                u32x4 xw[4][2];
#pragma unroll
                for (int m = 0; m < 4; ++m)
#pragma unroll
                    for (int bj = 0; bj < 2; ++bj) xw[m][bj] = *(const u32x4*)(xinLb + ro0 + (size_t)(ai * HALF + m * 16) * D + bj * HALF);
#pragma unroll
                for (int m = 0; m < 4; ++m)
#pragma unroll
                    for (int bj = 0; bj < 2; ++bj) { const u32x4 w = xw[m][bj];
                        f32x4 x0 = (f32x4){__uint_as_float(w.x << 16), __uint_as_float(w.x & 0xffff0000u), __uint_as_float(w.y << 16), __uint_as_float(w.y & 0xffff0000u)};
                        f32x4 x1 = (f32x4){__uint_as_float(w.z << 16), __uint_as_float(w.z & 0xffff0000u), __uint_as_float(w.w << 16), __uint_as_float(w.w & 0xffff0000u)};
                        x0 = x0 + gv[bj][0] * acc[ai][bj][m][0]; x1 = x1 + gv[bj][1] * acc[ai][bj][m][1];
                        u32x4 o; o.x = cvt_pk_bf16(x0[0], x0[1]); o.y = cvt_pk_bf16(x0[2], x0[3]); o.z = cvt_pk_bf16(x1[0], x1[1]); o.w = cvt_pk_bf16(x1[2], x1[3]);
                        *(u32x4*)(outLb + ro0 + (size_t)(ai * HALF + m * 16) * D + bj * HALF) = o; }
            } else {
                const float* xin = MODE == 0 ? xinC : xinLf;
                f32x4 xv[4][2][2];
#pragma unroll
                for (int m = 0; m < 4; ++m)
#pragma unroll
                    for (int bj = 0; bj < 2; ++bj) { const float* src = xin + ro0 + (size_t)(ai * HALF + m * 16) * D + bj * HALF; xv[m][bj][0] = *(const f32x4*)src; xv[m][bj][1] = *(const f32x4*)(src + 4); }
#pragma unroll
                for (int m = 0; m < 4; ++m)
#pragma unroll
                    for (int bj = 0; bj < 2; ++bj) { const size_t ro = ro0 + (size_t)(ai * HALF + m * 16) * D + bj * HALF;
                        const f32x4 x0 = xv[m][bj][0] + gv[bj][0] * acc[ai][bj][m][0], x1 = xv[m][bj][1] + gv[bj][1] * acc[ai][bj][m][1];
                        if constexpr (MODE == 0) { *(f32x4*)(outC + ro) = x0; *(f32x4*)(outC + ro + 4) = x1; }
                        else { u32x4 o; o.x = cvt_pk_bf16(x0[0], x0[1]); o.y = cvt_pk_bf16(x0[2], x0[3]); o.z = cvt_pk_bf16(x1[0], x1[1]); o.w = cvt_pk_bf16(x1[2], x1[3]); *(u32x4*)(outLb + ro) = o; } }
            }
        }
    }
    __device__ __forceinline__ void operator()(const f32x4 (&acc)[2][2][4][2], const Unit& u, int wr, int wc, int fr, int fq) const {
        const int trow = u.pm * BM; const bool lat = trow < TL;
        const float* g1 = mod + (size_t)(lat ? trow / SEQ : 32) * 6144 + 2048;
        const int row0 = wr * 64 + fr, col0 = u.pn * BM + wc * 32 + 8 * fq;
        f32x4 gv[2][2];
#pragma unroll
        for (int bj = 0; bj < 2; ++bj)
#pragma unroll
            for (int n = 0; n < 2; ++n) gv[bj][n] = *(const f32x4*)(g1 + col0 + bj * HALF + 4 * n);
        const size_t ro0 = (size_t)(lat ? trow : trow - TL) * D + (size_t)row0 * D + col0;
        if (!lat) run<0>(acc, ro0, gv); else if (xinLf) run<1>(acc, ro0, gv); else run<2>(acc, ro0, gv);
    }
};
__device__ __forceinline__ float silu_fast(float v) { return v * __builtin_amdgcn_rcpf(1.f + __builtin_amdgcn_exp2f(-1.4426950408889634f * v)); }
struct EpiMoeH {
    static constexpr bool PERM = true;
    bf16_t* H;
    __device__ __forceinline__ void operator()(const f32x4 (&acc)[2][2][4][2], const Unit& u, int wr, int wc, int fr, int fq) const {
        const int row0 = u.pm * BM + wr * 64 + fr, col0 = u.pn * HALF + wc * 32 + 8 * fq;
#pragma unroll
        for (int ai = 0; ai < 2; ++ai)
#pragma unroll
            for (int m = 0; m < 4; ++m) {
                float h[8];
#pragma unroll
                for (int n = 0; n < 2; ++n)
#pragma unroll
                    for (int q = 0; q < 4; ++q) h[n * 4 + q] = silu_fast(acc[ai][0][m][n][q]) * acc[ai][1][m][n][q];
                u32x4 w; w.x = cvt_pk_bf16(h[0], h[1]); w.y = cvt_pk_bf16(h[2], h[3]); w.z = cvt_pk_bf16(h[4], h[5]); w.w = cvt_pk_bf16(h[6], h[7]);
                *(u32x4*)(H + (size_t)(row0 + ai * HALF + m * 16) * EFF + col0) = w; }
    }
};
struct EpiMoeY {
    static constexpr bool PERM = true;
    bf16_t* Y; const int* etok;
    __device__ __forceinline__ void operator()(const f32x4 (&acc)[2][2][4][2], const Unit& u, int wr, int wc, int fr, int fq) const {
        const int col0 = u.pn * BM + wc * 32 + 8 * fq;
        int dst[2][4];
#pragma unroll
        for (int ai = 0; ai < 2; ++ai)
#pragma unroll
            for (int m = 0; m < 4; ++m) { const int r = ai * HALF + wr * 64 + m * 16 + fr; const int rr = r < u.nvalid ? r : u.nvalid - 1; dst[ai][m] = etok[(size_t)u.e * CAPE + u.pos0 + rr]; }
#pragma unroll
        for (int ai = 0; ai < 2; ++ai)
#pragma unroll
            for (int m = 0; m < 4; ++m) {
                const int r = ai * HALF + wr * 64 + m * 16 + fr;
                if (r < u.nvalid) {
                    bf16_t* rowp = Y + (size_t)dst[ai][m] * D + col0;
#pragma unroll
                    for (int bj = 0; bj < 2; ++bj) { const f32x4 v0 = acc[ai][bj][m][0], v1 = acc[ai][bj][m][1];
                        u32x4 w; w.x = cvt_pk_bf16(v0[0], v0[1]); w.y = cvt_pk_bf16(v0[2], v0[3]); w.z = cvt_pk_bf16(v1[0], v1[1]); w.w = cvt_pk_bf16(v1[2], v1[3]);
                        *(u32x4*)(rowp + bj * HALF) = w; } } }
    }
};

template <class Epi, class Sched, class Src>
__device__ __forceinline__ void gemm_phase(GP_LAS unsigned char* lds, const Sched& S, const Src& src, const Epi& E) {
    const int tid = ltid(), wid = __builtin_amdgcn_readfirstlane(tid >> 6), lane = tid & 63, wr = wid >> 2, wc = wid & 3, fr = lane & 15, fq = lane >> 4;
    const int K = src.K, nt = K / BK;
    int sR[2], sC[2]; unsigned voffA[2], voffB[2];
#pragma unroll
    for (int i = 0; i < 2; ++i) { int R, C; stage_rc(tid * 16 + i * 8192, R, C); sR[i] = R; sC[i] = C; const int Rb = Epi::PERM ? ((R & ~31) + perm32(R & 31)) : R;
        voffA[i] = (unsigned)(R * src.lda + C) * 2u; voffB[i] = (unsigned)(Rb * K + C) * 2u; }
    const size_t kstep = (size_t)(BK * 2);
    const size_t hstepA = (size_t)HALF * src.lda * 2, hstepB = (size_t)HALF * K * 2;
    const unsigned ldsw = (unsigned)wid * 1024u;
    const int aoff = lds_byte(wr * 64 + fr, fq * 8), boff = lds_byte(wc * 32 + fr, fq * 8);
#define GP_SA(b, h) (((b) * 2 + (h)) * HTB)
#define GP_SB(b, h) ((4 + (b) * 2 + (h)) * HTB)
#define GP_STAGE_A(b, h, kb, nx) do { _Pragma("unroll") for (int _i = 0; _i < 2; ++_i) { const char* _g; \
        if constexpr (Src::GATHER) _g = cA + (kb) + ((nx) ? nofs[h][_i] : cofs[h][_i]); \
        else _g = ((nx) ? nA : cA) + (size_t)(h) * hstepA + (kb) + voffA[_i]; \
        __builtin_amdgcn_global_load_lds((const unsigned*)_g, (GP_LAS unsigned*)(lds + GP_SA(b, h) + ldsw + _i * 8192), 16, 0, 0); } } while (0)
#define GP_STAGE_B(b, h, kb, nx) do { _Pragma("unroll") for (int _i = 0; _i < 2; ++_i) { const char* _g = ((nx) ? nB : cB) + (size_t)(h) * hstepB + (kb) + voffB[_i]; \
        __builtin_amdgcn_global_load_lds((const unsigned*)_g, (GP_LAS unsigned*)(lds + GP_SB(b, h) + ldsw + _i * 8192), 16, 0, 0); } } while (0)
#define GP_LDA(dst, b, h) do { _Pragma("unroll") for (int m = 0; m < 4; ++m) _Pragma("unroll") for (int k = 0; k < 2; ++k) dst[m][k] = *(const GP_LAS bf16x8*)(lds + GP_SA(b, h) + aoff + m * 2048 + k * 1024); } while (0)
#define GP_LDB(dst, b, h) do { _Pragma("unroll") for (int n = 0; n < 2; ++n) _Pragma("unroll") for (int k = 0; k < 2; ++k) dst[n][k] = *(const GP_LAS bf16x8*)(lds + GP_SB(b, h) + boff + n * 2048 + k * 1024); } while (0)
#define GP_MMA(ai, bj, At, Bt) do { __builtin_amdgcn_s_setprio(1); _Pragma("unroll") for (int m = 0; m < 4; ++m) _Pragma("unroll") for (int n = 0; n < 2; ++n) _Pragma("unroll") for (int k = 0; k < 2; ++k) \
        acc[ai][bj][m][n] = __builtin_amdgcn_mfma_f32_16x16x32_bf16(Bt[n][k], At[m][k], acc[ai][bj][m][n], 0, 0, 0); __builtin_amdgcn_s_setprio(0); } while (0)
#define GP_WAIT_V(n) asm volatile("s_waitcnt vmcnt(" #n ")" ::: "memory")
#define GP_WAIT_L(n) asm volatile("s_waitcnt lgkmcnt(" #n ")" ::: "memory")
#define GP_BAR __builtin_amdgcn_s_barrier()
#define GP_SCHED __builtin_amdgcn_sched_barrier(0)
    Unit cur, nxt; int ui = 0;
    if (!S.next(0, cur)) return;
    f32x4 acc[2][2][4][2];
#pragma unroll
    for (int a = 0; a < 2; ++a)
#pragma unroll
        for (int b = 0; b < 2; ++b)
#pragma unroll
            for (int m = 0; m < 4; ++m)
#pragma unroll
                for (int n = 0; n < 2; ++n) acc[a][b][m][n] = (f32x4){0.f, 0.f, 0.f, 0.f};
    bf16x8 At[4][2], B0[2][2], B1[2][2];
    const char* cA = src.a_base(cur); const char* cB = src.b_base(cur);
    const char* nA = cA; const char* nB = cB;
    unsigned cofs[2][2], nofs[2][2]; int nraw[2][2] = {{0, 0}, {0, 0}};
#pragma unroll
    for (int h = 0; h < 2; ++h)
#pragma unroll
        for (int i = 0; i < 2; ++i) { cofs[h][i] = Src::GATHER ? src.a_off(cur, h * HALF + sR[i], sC[i]) : 0u; nofs[h][i] = cofs[h][i]; }
    GP_STAGE_B(0, 0, 0, false); GP_STAGE_B(0, 1, 0, false); GP_STAGE_A(0, 0, 0, false); GP_STAGE_A(0, 1, 0, false);
    if (wr == 1) GP_BAR;
    GP_WAIT_V(2); GP_BAR;
    GP_STAGE_B(1, 0, kstep, false); GP_STAGE_A(1, 0, kstep, false); GP_STAGE_B(1, 1, kstep, false);
    GP_WAIT_V(6); GP_BAR;
    for (;;) {
        const bool has_next = S.next(ui + 1, nxt);
        if (has_next) { nA = src.a_base(nxt); nB = src.b_base(nxt);
            if constexpr (Src::GATHER) { const int t2 = ltid();
#pragma unroll
                for (int i = 0; i < 2; ++i) { int R, C; stage_rc(t2 * 16 + i * 8192, R, C);
#pragma unroll
                    for (int h = 0; h < 2; ++h) nraw[h][i] = src.a_raw(nxt, h * HALF + R); } }
        } else { nA = cA; nB = cB;
#pragma unroll
            for (int h = 0; h < 2; ++h)
#pragma unroll
                for (int i = 0; i < 2; ++i) nofs[h][i] = cofs[h][i]; }
        for (int t = 0; t < nt; t += 2) {
            const bool last = (t == nt - 2);
            if constexpr (Src::GATHER) { if (last && has_next) { const int t2 = ltid();
#pragma unroll
                    for (int i = 0; i < 2; ++i) { int R, C; stage_rc(t2 * 16 + i * 8192, R, C);
#pragma unroll
                        for (int h = 0; h < 2; ++h) nofs[h][i] = src.a_fin(nraw[h][i], C); } } }
            const size_t k1 = (size_t)(t + 1) * kstep, k2 = last ? 0 : (size_t)(t + 2) * kstep, k3 = k2 + kstep;
            GP_LDB(B0, 0, 0); GP_LDB(B1, 0, 1); GP_SCHED; GP_LDA(At, 0, 0); GP_STAGE_A(1, 1, k1, false);
            GP_WAIT_V(8); GP_WAIT_L(0); GP_BAR; GP_MMA(0, 0, At, B0); GP_MMA(0, 1, At, B1); GP_BAR; GP_SCHED;
            GP_LDA(At, 0, 1); GP_STAGE_B(0, 0, k2, last); GP_STAGE_B(0, 1, k2, last); GP_STAGE_A(0, 0, k2, last);
            GP_WAIT_V(8); GP_WAIT_L(0); GP_BAR; GP_MMA(1, 0, At, B0); GP_MMA(1, 1, At, B1); GP_BAR; GP_SCHED;
            GP_LDB(B0, 1, 0); GP_LDB(B1, 1, 1); GP_SCHED; GP_LDA(At, 1, 0); GP_STAGE_A(0, 1, k2, last);
            GP_WAIT_V(8); GP_WAIT_L(0); GP_BAR; GP_MMA(0, 0, At, B0); GP_MMA(0, 1, At, B1); GP_BAR; GP_SCHED;
            GP_LDA(At, 1, 1); GP_STAGE_B(1, 0, k3, last); GP_STAGE_B(1, 1, k3, last); GP_STAGE_A(1, 0, k3, last);
            GP_WAIT_V(8); GP_WAIT_L(0); GP_BAR; GP_MMA(1, 0, At, B0); GP_MMA(1, 1, At, B1); GP_BAR; GP_SCHED;
        }
        if (wr == 0) GP_BAR;
        E(acc, cur, wr, wc, fr, fq);
        if (!has_next) break;
#pragma unroll
        for (int a = 0; a < 2; ++a)
#pragma unroll
            for (int b = 0; b < 2; ++b)
#pragma unroll
                for (int m = 0; m < 4; ++m)
#pragma unroll
                    for (int n = 0; n < 2; ++n) acc[a][b][m][n] = (f32x4){0.f, 0.f, 0.f, 0.f};
        cur = nxt; cA = nA; cB = nB; ++ui;
#pragma unroll
        for (int h = 0; h < 2; ++h)
#pragma unroll
            for (int i = 0; i < 2; ++i) cofs[h][i] = nofs[h][i];
        if (wr == 1) GP_BAR;
    }
    GP_WAIT_V(0);
    GP_BAR;
#undef GP_SA
#undef GP_SB
#undef GP_STAGE_A
#undef GP_STAGE_B
#undef GP_LDA
#undef GP_LDB
#undef GP_MMA
#undef GP_WAIT_V
#undef GP_WAIT_L
#undef GP_BAR
#undef GP_SCHED
}
}

constexpr int LDS_BYTES = 163840;

DI void phase_inproj(CPARAMS p, int l, LAS unsigned char* lds) {
    gp::CtxTrimOrder S; S.init(ZW / 256, l == 0 ? 0x7ff : ((1 << 1) | (1 << 3) | (1 << 4) | (1 << 9)), gridDim.x, blockIdx.x);
    gp::SrcPlain src{(const bf16_t*)(p.ws + WS_ACT), (const bf16_t*)(p.ws + WS_WIN_T), D, D};
    gp::EpiZ E{(bf16_t*)(p.ws + WS_Z)};
    gp::gemm_phase(lds, S, src, E);
}
DI void phase_up(CPARAMS p, int l, LAS unsigned char* lds) {
    gp::CtxTrimOrder S; S.init(4, l == 0 ? 0xf : 0xc, gridDim.x, blockIdx.x);
    gp::SrcUp src{(const bf16_t*)(p.ws + WS_Z), (const bf16_t*)(p.ws + WS_WUP_T), 256, 256};
    gp::EpiBf16 E{(bf16_t*)(p.ws + WS_RAW), 1024};
    gp::gemm_phase(lds, S, src, E);
}
DI void phase_outproj(CPARAMS p, int l, LAS unsigned char* lds) {
    gp::StaticOrder S; S.init((l == 0 ? T : TL) / 256, D / 256, gridDim.x, blockIdx.x);
    gp::SrcPlain src{(const bf16_t*)(p.ws + WS_ACT), (const bf16_t*)(p.ws + WS_WOUT_T), D, D};
    gp::EpiResid E{l == 0 ? p.in[I_X] : nullptr, (const bf16_t*)p.out, (bf16_t*)(p.ws + WS_XB1), p.in[I_CTX], (float*)(p.ws + WS_XC), (const float*)(p.ws + WS_MOD) + (size_t)l * 33 * 6144};
    gp::gemm_phase(lds, S, src, E);
}
DI void phase_moe1(CPARAMS p, int l, LAS unsigned char* lds) {
    LAS unsigned* tab = (LAS unsigned*)(lds + gp::STAGE_BYTES);
    __syncthreads(); gp::moe_table((const unsigned*)(p.ws + WS_CTL) + CW_COUNT + l * 32, tab); __syncthreads();
    gp::MoeOrder S; S.init(tab, 4, gridDim.x, blockIdx.x);
    gp::SrcMoe1 src{(const bf16_t*)(p.ws + WS_ACT), (const bf16_t*)(p.ws + WS_W13_T), D, D, (const int*)(p.ws + WS_ETOK)};
    gp::EpiMoeH E{(bf16_t*)(p.ws + WS_H)};
    gp::gemm_phase(lds, S, src, E);
}
DI void phase_moe2(CPARAMS p, int l, LAS unsigned char* lds) {
    LAS unsigned* tab = (LAS unsigned*)(lds + gp::STAGE_BYTES);
    __syncthreads(); gp::moe_table((const unsigned*)(p.ws + WS_CTL) + CW_COUNT + l * 32, tab); __syncthreads();
    gp::MoeOrder S; S.init(tab, 4, gridDim.x, blockIdx.x);
    gp::SrcMoe2 src{(const bf16_t*)(p.ws + WS_H), (const bf16_t*)(p.ws + WS_W2_T), EFF, EFF};
    gp::EpiMoeY E{(bf16_t*)(p.ws + WS_YTOK), (const int*)(p.ws + WS_ETOK)};
    gp::gemm_phase(lds, S, src, E);
}


DI bf16x8 pack8(const f32x16& x, int s) { u32x4 p; p.x = pk_bf16(x[8 * s], x[8 * s + 1]); p.y = pk_bf16(x[8 * s + 2], x[8 * s + 3]); p.z = pk_bf16(x[8 * s + 4], x[8 * s + 5]); p.w = pk_bf16(x[8 * s + 6], x[8 * s + 7]); return __builtin_bit_cast(bf16x8, p); }
#define MFMA32(a, b, c) __builtin_amdgcn_mfma_f32_32x32x16_bf16((a), (b), (c), 0, 0, 0)
constexpr int AT_KP = 208, AT_VP = 264, AT_KBYTES = 128 * AT_KP, AT_VBYTES = 64 * AT_VP, AT_BUF = AT_KBYTES + AT_VBYTES;

DI void attn_unit(CPARAMS p, int bh, int q0, int key0, int nkt, LAS unsigned char* lds) {
    const int tid = ltid(), lane = tid & 63, wid = __builtin_amdgcn_readfirstlane(tid >> 6), h = lane >> 5, c = lane & 31;
    const bf16_t* Qg = (const bf16_t*)(p.ws + WS_Q) + ((size_t)bh * PALL + q0 + wid * 32 + c) * 96;
    const bf16_t* Kg = (const bf16_t*)(p.ws + WS_K) + ((size_t)bh * PALL + key0) * 96;
    const bf16_t* Vg = (const bf16_t*)(p.ws + WS_VT) + (size_t)bh * 64 * PALL + key0;
    bf16x8 qf[6];
#pragma unroll
    for (int s = 0; s < 6; ++s) qf[s] = *(const bf16x8*)(Qg + 16 * s + 8 * h);
    f32x16 o[2];
#pragma unroll
    for (int i = 0; i < 16; ++i) { o[0][i] = 0.f; o[1][i] = 0.f; }
    float m = 0.f, lsum = 0.f;
    u32x4 kreg[3], vreg[2];
    int krow[3], kpc[3], vd[2], vpc[2];
#pragma unroll
    for (int j = 0; j < 3; ++j) { const int pi = tid + 512 * j; krow[j] = pi / 12; kpc[j] = pi % 12; }
#pragma unroll
    for (int j = 0; j < 2; ++j) { const int pi = tid + 512 * j; vd[j] = pi >> 4; vpc[j] = pi & 15; }
#define AT_LOAD(t) do { _Pragma("unroll") for (int j = 0; j < 3; ++j) kreg[j] = *(const u32x4*)(Kg + (size_t)(128 * (t) + krow[j]) * 96 + kpc[j] * 8); \
        _Pragma("unroll") for (int j = 0; j < 2; ++j) vreg[j] = *(const u32x4*)(Vg + (size_t)vd[j] * PALL + 128 * (t) + vpc[j] * 8); } while (0)
#define AT_STORE(bs) do { LAS unsigned char* _b = lds + (bs) * AT_BUF; \
        _Pragma("unroll") for (int j = 0; j < 3; ++j) *(LAS u32x4*)(_b + krow[j] * AT_KP + kpc[j] * 16) = kreg[j]; \
        _Pragma("unroll") for (int j = 0; j < 2; ++j) { LAS unsigned char* _v = _b + AT_KBYTES + vd[j] * AT_VP + vpc[j] * 16; u32x2 lo = {vreg[j].x, vreg[j].y}, hi = {vreg[j].z, vreg[j].w}; *(LAS u32x2*)_v = lo; *(LAS u32x2*)(_v + 8) = hi; } } while (0)
    f32x16 st0, st1, NM;
    bf16x8 kf[6];
    u32x4 vf[4], pp[2];
#pragma unroll
    for (int j = 0; j < 4; ++j) vf[j] = u32x4{0u, 0u, 0u, 0u};
    pp[0] = u32x4{0u, 0u, 0u, 0u}; pp[1] = pp[0];
#define AT_SB() __builtin_amdgcn_sched_barrier(0)
#define AT_KLD(kt) do { _Pragma("unroll") for (int s = 0; s < 6; ++s) kf[s] = *(const LAS bf16x8*)(kb0 + 32 * (kt) * AT_KP + 32 * s); } while (0)
#define AT_VLD(kt) do { _Pragma("unroll") for (int q = 0; q < 4; ++q) { \
            const LAS unsigned char* _v = vb0 + 32 * (q & 1) * AT_VP + (32 * (kt) + 16 * (q >> 1)) * 2; const u32x2 lo = *(const LAS u32x2*)_v, hi = *(const LAS u32x2*)(_v + 16); \
            vf[q] = u32x4{lo.x, lo.y, hi.x, hi.y}; } } while (0)
#define AT_PVQ(q) o[(q) & 1] = MFMA32(__builtin_bit_cast(bf16x8, vf[q]), __builtin_bit_cast(bf16x8, pp[(q) >> 1]), o[(q) & 1])
#define AT_STEP(i, SC, SN) do { \
        if ((i) + 1 <= 3) AT_KLD((i) + 1); \
        AT_SB(); \
        _Pragma("unroll") for (int q = 0; q < 4; ++q) { \
            AT_PVQ(q); AT_SB(); \
            _Pragma("unroll") for (int j = 4 * q; j < 4 * q + 4; ++j) tmx = fmaxf(tmx, SC[j]); \
            AT_SB(); } \
        AT_VLD(i); \
        AT_SB(); \
        _Pragma("unroll") for (int s = 0; s < 6; ++s) { \
            if ((i) + 1 <= 3) { SN = MFMA32(kf[s], qf[s], s == 0 ? NM : SN); AT_SB(); } \
            constexpr int e0_[7] = {0, 3, 6, 9, 12, 14, 16}; \
            _Pragma("unroll") for (int j = e0_[s]; j < e0_[s + 1]; ++j) { const float e = __builtin_amdgcn_exp2f(SC[j]); SC[j] = e; lsum += e; } \
            _Pragma("unroll") for (int pr = e0_[s] / 2; pr < e0_[s + 1] / 2; ++pr) pp[pr >> 2][pr & 3] = pk_bf16(SC[2 * pr], SC[2 * pr + 1]); \
            if ((i) + 1 <= 3) AT_SB(); } \
        AT_SB(); \
    } while (0)
    AT_LOAD(0); AT_STORE(0);
    __syncthreads();
    {
        const LAS unsigned char* kb0 = lds + c * AT_KP + 16 * h;
        AT_KLD(0);
#pragma unroll
        for (int j = 0; j < 16; ++j) st0[j] = 0.f;
#pragma unroll
        for (int s = 0; s < 6; ++s) st0 = MFMA32(kf[s], qf[s], st0);
        float mx = st0[0];
#pragma unroll
        for (int j = 1; j < 16; ++j) mx = fmaxf(mx, st0[j]);
        m = fmaxf(mx, __shfl_xor(mx, 32));
#pragma unroll
        for (int j = 0; j < 16; ++j) { st0[j] -= m; NM[j] = -m; }
    }
    for (int t = 0; t < nkt; ++t) {
        if (t + 1 < nkt) AT_LOAD(t + 1);
        {
            const LAS unsigned char* base = lds + (t & 1) * AT_BUF;
            const LAS unsigned char* kb0 = base + c * AT_KP + 16 * h;
            const LAS unsigned char* vb0 = base + AT_KBYTES + c * AT_VP + 8 * h;
            float tmx = st0[0];
            AT_SB();
            AT_STEP(0, st0, st1);
            AT_STEP(1, st1, st0);
            AT_STEP(2, st0, st1);
            AT_STEP(3, st1, st0);
            if (__builtin_expect(!__all(tmx <= 8.0f), 0)) {
                AT_PVQ(0); AT_PVQ(1); AT_PVQ(2); AT_PVQ(3);
                pp[0] = u32x4{0u, 0u, 0u, 0u}; pp[1] = pp[0];
                tmx = fmaxf(tmx, __shfl_xor(tmx, 32));
                const float d = fmaxf(tmx, 0.f), alpha = __builtin_amdgcn_exp2f(-d);
                m += d; lsum *= alpha;
#pragma unroll
                for (int j = 0; j < 16; ++j) { o[0][j] *= alpha; o[1][j] *= alpha; NM[j] = -m; }
            }
        }
        if (t + 1 < nkt) AT_STORE((t + 1) & 1);
        __syncthreads();
        if (t + 1 < nkt) {
            const LAS unsigned char* kb0 = lds + ((t + 1) & 1) * AT_BUF + c * AT_KP + 16 * h;
            AT_KLD(0);
            AT_SB();
#pragma unroll
            for (int s = 0; s < 6; ++s) st0 = MFMA32(kf[s], qf[s], s == 0 ? NM : st0);
            AT_SB();
        }
    }
    AT_PVQ(0); AT_PVQ(1); AT_PVQ(2); AT_PVQ(3);
#undef AT_LOAD
#undef AT_STORE
#undef AT_KLD
#undef AT_VLD
#undef AT_STEP
#undef AT_SB
#undef AT_PVQ
    const float inv = 1.f / (lsum + __shfl_xor(lsum, 32));
    const int b = bh >> 2, hh = bh & 3, qpos = q0 + wid * 32 + c;
    const int tok = qpos < SEQ ? b * SEQ + qpos : TL + b * CTXL + (qpos - SEQ);
    bf16_t* YA = (bf16_t*)(p.ws + WS_YA) + (size_t)tok * 256 + hh * 64;
#pragma unroll
    for (int dt = 0; dt < 2; ++dt)
#pragma unroll
        for (int g = 0; g < 4; ++g) { u32x2 w; w.x = pk_bf16(o[dt][4 * g] * inv, o[dt][4 * g + 1] * inv); w.y = pk_bf16(o[dt][4 * g + 2] * inv, o[dt][4 * g + 3] * inv); *(u32x2*)(YA + 32 * dt + 8 * g + 4 * h) = w; }
}
DI void phase_attn(CPARAMS p, int l, LAS unsigned char* lds) {
    const int cI = blockIdx.x, xcd = cI & 7, j = cI >> 3;
    for (int r = 0; r < 4; ++r) { const int bh = r * 32 + xcd * 4 + (j >> 3), qb = j & 7; attn_unit(p, bh, qb * 256, 0, 18, lds); }
    if (l == 0 && cI < 128) attn_unit(p, cI, SEQ, SEQ, 2, lds);
}


constexpr int RT_QP = 144, RT_TP = 272;
constexpr int RT_QS = 0, RT_KS = 128 * RT_QP, RT_KT = 2 * 128 * RT_QP, RT_VT = RT_KT + 64 * RT_TP, RT_ST = RT_VT + 64 * RT_TP, RT_END = RT_ST + 64 * RT_QP;
DI int ret_tok(int b, int dir, int ci, int j) {
    if (ci < 2) { const int cp = 128 * ci + j; return TL + b * CTXL + (dir ? CTXL - 1 - cp : cp); }
    const int tp = 128 * (ci - 2) + j; return b * SEQ + (dir ? SEQ - 1 - tp : tp);
}
DI void ret_unit(CPARAMS p, int l, int b, int hh, int dir, LAS unsigned char* lds) {
    const int tid = ltid(), lane = tid & 63, wid = __builtin_amdgcn_readfirstlane(tid >> 6), h = lane >> 5, c = lane & 31;
    const float lg = p.in[I_RLG][(l * 2 + dir) * 4 + hh];
    const int jp = lane, dg = wid;
    const float qs[2] = {expf(lg * (float)(2 * jp)), expf(lg * (float)(2 * jp + 1))};
    const float ks[2] = {expf(-lg * (float)(2 * jp)) * 0.125f, expf(-lg * (float)(2 * jp + 1)) * 0.125f};
    const float gam = expf(lg), g127 = expf(lg * 127.f), g128 = expf(lg * 128.f);
    const bf16_t* Z = (const bf16_t*)(p.ws + WS_Z);
    bf16_t* OUT = (bf16_t*)(p.ws + (dir ? WS_OB : WS_OF));
    __syncthreads();
    for (int i = tid; i < 64 * RT_QP / 4; i += 512) ((LAS unsigned*)(lds + RT_ST))[i] = 0u;
    f32x16 sacc;
#pragma unroll
    for (int i = 0; i < 16; ++i) sacc[i] = 0.f;
    u32x4 rq2[2][2], rk2[2][2], rv2[2][2];
#define RT_LOAD(ci, rq, rk, rv) do { _Pragma("unroll") for (int r = 0; r < 2; ++r) { const size_t ro_ = zoff(ret_tok(b, dir, (ci), 2 * jp + r), ZC_RQ + hh * 64 + 8 * dg); \
        rq[r] = *(const u32x4*)(Z + ro_); rk[r] = *(const u32x4*)(Z + ro_ + (size_t)T * 256); rv[r] = *(const u32x4*)(Z + ro_ + (size_t)2 * T * 256); } } while (0)
#define RT_STORE(rq, rk, rv) do { u32x4 nk[2]; \
        _Pragma("unroll") for (int r = 0; r < 2; ++r) { u32x4 nq; \
            _Pragma("unroll") for (int d4 = 0; d4 < 4; ++d4) { const unsigned wq = rq[r][d4], wk = rk[r][d4]; \
                nq[d4] = pk_bf16(__uint_as_float(wq << 16) * qs[r], __uint_as_float(wq & 0xffff0000u) * qs[r]); \
                nk[r][d4] = pk_bf16(__uint_as_float(wk << 16) * ks[r], __uint_as_float(wk & 0xffff0000u) * ks[r]); } \
            *(LAS u32x4*)(lds + RT_QS + (2 * jp + r) * RT_QP + dg * 16) = nq; *(LAS u32x4*)(lds + RT_KS + (2 * jp + r) * RT_QP + dg * 16) = nk[r]; } \
        _Pragma("unroll") for (int d4 = 0; d4 < 4; ++d4) { \
            *(LAS unsigned*)(lds + RT_KT + (8 * dg + 2 * d4) * RT_TP + jp * 4) = (nk[0][d4] & 0xffffu) | (nk[1][d4] << 16); \
            *(LAS unsigned*)(lds + RT_KT + (8 * dg + 2 * d4 + 1) * RT_TP + jp * 4) = (nk[0][d4] >> 16) | (nk[1][d4] & 0xffff0000u); \
            *(LAS unsigned*)(lds + RT_VT + (8 * dg + 2 * d4) * RT_TP + jp * 4) = (rv[0][d4] & 0xffffu) | (rv[1][d4] << 16); \
            *(LAS unsigned*)(lds + RT_VT + (8 * dg + 2 * d4 + 1) * RT_TP + jp * 4) = (rv[0][d4] >> 16) | (rv[1][d4] & 0xffff0000u); } } while (0)
    RT_LOAD(0, rq2[0], rk2[0], rv2[0]); RT_STORE(rq2[0], rk2[0], rv2[0]); RT_LOAD(1, rq2[1], rk2[1], rv2[1]);
    __syncthreads();
    const int I = wid < 4 ? (wid >> 1) : 5 - (wid >> 1), dt = wid & 1;
#pragma unroll 2
    for (int ci = 0; ci < 18; ++ci) {
        RT_LOAD((ci + 2 < 18 ? ci + 2 : 17), rq2[ci & 1], rk2[ci & 1], rv2[ci & 1]);
        const bool doOut = (ci >= 2) || (l == 0);
#define RT_SB() __builtin_amdgcn_sched_barrier(0)
#define RT_KLD(dst, J) do { _Pragma("unroll") for (int s = 0; s < 4; ++s) dst[s] = *(const LAS bf16x8*)(lds + RT_KS + (32 * (J) + c) * RT_QP + (16 * s + 8 * h) * 2); } while (0)
#define RT_QK(J, src) do { at[J] = MFMA32(src[0], bq[0], zero16); _Pragma("unroll") for (int s = 1; s < 4; ++s) at[J] = MFMA32(src[s], bq[s], at[J]); \
            if ((J) == I) { _Pragma("unroll") for (int r = 0; r < 16; ++r) { const int kr = (r & 3) + 8 * (r >> 2) + 4 * h; if (kr > c) at[J][r] = 0.f; } } } while (0)
#define RT_VLD(dst, J) do { _Pragma("unroll") for (int s2 = 0; s2 < 2; ++s2) { const LAS unsigned char* vb = lds + RT_VT + (32 * dt + c) * RT_TP + (32 * (J) + 16 * s2 + 4 * h) * 2; \
            const u32x2 lo = *(const LAS u32x2*)vb, hi = *(const LAS u32x2*)(vb + 16); dst[s2] = u32x4{lo.x, lo.y, hi.x, hi.y}; } } while (0)
#define RT_PV(J, src) do { _Pragma("unroll") for (int s2 = 0; s2 < 2; ++s2) o = MFMA32(__builtin_bit_cast(bf16x8, src[s2]), pack8(at[J], s2), o); } while (0)
        if (doOut) {
            const f32x16 zero16 = {0.f, 0.f, 0.f, 0.f, 0.f, 0.f, 0.f, 0.f, 0.f, 0.f, 0.f, 0.f, 0.f, 0.f, 0.f, 0.f};
            bf16x8 bq[4], sf[4], ka[4];
            u32x4 va[2];
#pragma unroll
            for (int s = 0; s < 4; ++s) bq[s] = *(const LAS bf16x8*)(lds + RT_QS + (32 * I + c) * RT_QP + (16 * s + 8 * h) * 2);
            RT_KLD(ka, 0);
            RT_SB();
            f32x16 at[4];
            RT_QK(0, ka); RT_SB();
            if (I >= 1) { RT_KLD(ka, 1); RT_SB(); RT_QK(1, ka); RT_SB();
                if (I >= 2) { RT_KLD(ka, 2); RT_SB(); RT_QK(2, ka); RT_SB();
                    if (I >= 3) { RT_KLD(ka, 3); RT_SB(); RT_QK(3, ka); RT_SB(); } } }
            f32x16 o = zero16;
            RT_VLD(va, 0);
#pragma unroll
            for (int s = 0; s < 4; ++s) sf[s] = *(const LAS bf16x8*)(lds + RT_ST + (32 * dt + c) * RT_QP + (16 * s + 8 * h) * 2);
            RT_SB();
            RT_PV(0, va); RT_SB();
            if (I >= 1) { RT_VLD(va, 1); RT_SB(); RT_PV(1, va); RT_SB();
                if (I >= 2) { RT_VLD(va, 2); RT_SB(); RT_PV(2, va); RT_SB();
                    if (I >= 3) { RT_VLD(va, 3); RT_SB(); RT_PV(3, va); RT_SB(); } } }
            f32x16 cr = MFMA32(sf[0], bq[0], zero16);
#pragma unroll
            for (int s = 1; s < 4; ++s) cr = MFMA32(sf[s], bq[s], cr);
            bf16_t* dst = OUT + (size_t)ret_tok(b, dir, ci, 32 * I + c) * 256 + hh * 64 + 32 * dt;
#pragma unroll
            for (int g = 0; g < 4; ++g) { u32x2 w; w.x = pk_bf16(o[4 * g] + gam * cr[4 * g], o[4 * g + 1] + gam * cr[4 * g + 1]); w.y = pk_bf16(o[4 * g + 2] + gam * cr[4 * g + 2], o[4 * g + 3] + gam * cr[4 * g + 3]); *(u32x2*)(dst + 8 * g + 4 * h) = w; }
        }
        if (wid < 4) {
            const int dtl = wid & 1, kdt = wid >> 1;
            bf16x8 ua[4], ub[4], uc[4], ud[4];
#define RT_ULD(A_, B_, s0) do { _Pragma("unroll") for (int s = 0; s < 4; ++s) { A_[s] = *(const LAS bf16x8*)(lds + RT_VT + (32 * dtl + c) * RT_TP + (16 * ((s0) + s) + 8 * h) * 2); B_[s] = *(const LAS bf16x8*)(lds + RT_KT + (32 * kdt + c) * RT_TP + (16 * ((s0) + s) + 8 * h) * 2); } } while (0)
            RT_ULD(ua, ub, 0); RT_ULD(uc, ud, 4);
            RT_SB();
            const f32x16 zu = {0.f, 0.f, 0.f, 0.f, 0.f, 0.f, 0.f, 0.f, 0.f, 0.f, 0.f, 0.f, 0.f, 0.f, 0.f, 0.f};
            f32x16 upd = MFMA32(ua[0], ub[0], zu);
#pragma unroll
            for (int s = 1; s < 4; ++s) upd = MFMA32(ua[s], ub[s], upd);
#pragma unroll
            for (int s = 0; s < 4; ++s) upd = MFMA32(uc[s], ud[s], upd);
#undef RT_ULD
#pragma unroll
            for (int i = 0; i < 16; ++i) sacc[i] = g128 * sacc[i] + g127 * upd[i];
        }
#undef RT_SB
#undef RT_KLD
#undef RT_QK
#undef RT_VLD
#undef RT_PV
        __syncthreads();
        if (wid < 4) {
            const int dtl = wid & 1, kdt = wid >> 1;
#pragma unroll
            for (int r = 0; r < 16; ++r) { const int d = 32 * dtl + (r & 3) + 8 * (r >> 2) + 4 * h; *(LAS bf16_t*)(lds + RT_ST + d * RT_QP + (32 * kdt + c) * 2) = f2bf(sacc[r]); }
        }
        if (ci + 1 < 18) RT_STORE(rq2[(ci + 1) & 1], rk2[(ci + 1) & 1], rv2[(ci + 1) & 1]);
        __syncthreads();
    }
#undef RT_LOAD
#undef RT_STORE
}
DI void phase_ret(CPARAMS p, int l, LAS unsigned char* lds) { const int u = blockIdx.x; if (u < 256) ret_unit(p, l, u >> 3, (u >> 1) & 3, u & 1, lds); }


constexpr int HP_PITCH = 1032;
DI void hyprep_tile(CPARAMS p, int l, int tokbase, int L, int t0, bf16_t* dstS  , int b, LAS unsigned char* lds) {
    const int tid = ltid(), lane = tid & 63, wid = __builtin_amdgcn_readfirstlane(tid >> 6);
    const bf16_t* Z = (const bf16_t*)(p.ws + WS_Z); const float* cw = p.in[I_HCW] + (size_t)l * 3 * 768; const float* cb = p.in[I_HCB] + l * 768;
    __syncthreads();
    {
        u32x4 hv[9];
#pragma unroll
        for (int u = 0; u < 9; ++u) { const int pi = tid + 512 * u, r = pi >> 6, pc = pi & 63, t = t0 - 1 + r; hv[u] = (u32x4){0u, 0u, 0u, 0u};
            if (pi < 66 * 64 && t >= 0 && t < L) hv[u] = *(const u32x4*)(Z + zoff(tokbase + t, (pc < 32 ? ZC_HX1 : ZC_HV) + (pc & 31) * 8)); }
#pragma unroll
        for (int u = 0; u < 9; ++u) { const int pi = tid + 512 * u, r = pi >> 6, pc = pi & 63;
            if (pi < 66 * 64) { LAS unsigned char* d = lds + r * HP_PITCH + pc * 16; u32x2 lo = {hv[u].x, hv[u].y}, hi = {hv[u].z, hv[u].w}; *(LAS u32x2*)d = lo; *(LAS u32x2*)(d + 8) = hi; } }
    }
    __syncthreads();
#pragma unroll 2
    for (int k = 0; k < 8; ++k) {
        const int ch = wid * 32 + k * 4;
        float x1[4], vv[4];
        { const f32x4 b1 = *(const f32x4*)(cb + 256 + ch), b2 = *(const f32x4*)(cb + 512 + ch); x1[0] = b1[0]; x1[1] = b1[1]; x1[2] = b1[2]; x1[3] = b1[3]; vv[0] = b2[0]; vv[1] = b2[1]; vv[2] = b2[2]; vv[3] = b2[3]; }
#pragma unroll
        for (int j = 0; j < 3; ++j) {
            float a[4], bq[4]; unpk4(*(const LAS u32x2*)(lds + (lane + j) * HP_PITCH + ch * 2), a); unpk4(*(const LAS u32x2*)(lds + (lane + j) * HP_PITCH + 512 + ch * 2), bq);
            const f32x4 w1 = *(const f32x4*)(cw + j * 768 + 256 + ch), w2 = *(const f32x4*)(cw + j * 768 + 512 + ch);
#pragma unroll
            for (int q = 0; q < 4; ++q) { x1[q] += w1[q] * a[q]; vv[q] += w2[q] * bq[q]; }
        }
#pragma unroll
        for (int q = 0; q < 4; ++q) dstS[((size_t)(ch + q) * NB + b) * L + t0 + lane] = f2bf(x1[q] * vv[q]);
    }
}
DI void phase_hyprep(CPARAMS p, int l, LAS unsigned char* lds) {
    const int ntl = NB * (SEQ / 64), ntc = l == 0 ? NB * (CTXL / 64) : 0;
    for (int u = blockIdx.x; u < ntl + ntc; u += gridDim.x) {
        if (u < ntl) { const int b = u / (SEQ / 64), tt = u % (SEQ / 64); hyprep_tile(p, l, b * SEQ, SEQ, tt * 64, (bf16_t*)(p.ws + WS_SL), b, lds); }
        else { const int v = u - ntl, b = v / (CTXL / 64), tt = v % (CTXL / 64); hyprep_tile(p, l, TL + b * CTXL, CTXL, tt * 64, (bf16_t*)(p.ws + WS_SC), b, lds); }
    }
}
template <int L, int TPW>
DI void hyena_unit(const bf16_t* Sg, const bf16_t* Gg, bf16_t* Yg, LAS unsigned char* lds) {
    constexpr int PITCH = 2 * L + 16, NK = L / 16, GOFF = 32 * PITCH;
    const int tid = ltid(), lane = tid & 63, wid = __builtin_amdgcn_readfirstlane(tid >> 6), h = lane >> 5, c = lane & 31;
    __syncthreads();
    { constexpr int NPT = 32 * (L / 8) / 512, UB = NPT < 8 ? NPT : 8;
      for (int p0 = 0; p0 < NPT; p0 += UB) { u32x4 sv[UB];
#pragma unroll
        for (int u = 0; u < UB; ++u) { const int pi = tid + 512 * (p0 + u), b = pi / (L / 8), pc = pi % (L / 8); sv[u] = *(const u32x4*)(Sg + (size_t)b * L + pc * 8); }
#pragma unroll
        for (int u = 0; u < UB; ++u) { const int pi = tid + 512 * (p0 + u), b = pi / (L / 8), pc = pi % (L / 8); *(LAS u32x4*)(lds + b * PITCH + pc * 16) = sv[u]; } } }
    for (int pi = tid; pi < (2 * L) / 8; pi += 512) { const u32x4 gv = *(const u32x4*)(Gg + pi * 8); const unsigned nx = (pi + 1 < (2 * L) / 8) ? *(const unsigned*)(Gg + (pi + 1) * 8) : 0u;
        *(LAS u32x4*)(lds + GOFF + pi * 16) = gv;
        u32x4 sh; sh.x = (gv.x >> 16) | (gv.y << 16); sh.y = (gv.y >> 16) | (gv.z << 16); sh.z = (gv.z >> 16) | (gv.w << 16); sh.w = (gv.w >> 16) | (nx << 16);
        *(LAS u32x4*)(lds + GOFF + 4 * L + pi * 16) = sh; }
    __syncthreads();
    f32x16 acc[TPW];
#pragma unroll
    for (int a = 0; a < TPW; ++a)
#pragma unroll
        for (int i = 0; i < 16; ++i) acc[a][i] = 0.f;
    const int a0 = (TPW == 8 ? (wid < 4 ? wid : 11 - wid) : wid) * TPW;
    if (a0 * 32 < L) {
        const LAS bf16_t* gbase = (c & 1) ? (const LAS bf16_t*)(lds + GOFF + 4 * L) + L + 8 * h - c - 1 : (const LAS bf16_t*)(lds + GOFF) + L + 8 * h - c;
        const LAS unsigned char* arow = lds + c * PITCH + 16 * h;
#define HY_BFRAG(q_, out_) do { const LAS unsigned* gp_ = (const LAS unsigned*)(gbase + 16 * (q_)); u32x4 bw_; bw_.x = gp_[0]; bw_.y = gp_[1]; bw_.z = gp_[2]; bw_.w = gp_[3]; \
            out_ = __builtin_bit_cast(bf16x8, bw_); } while (0)
        const int qlo = -2 * (a0 + TPW - 1), qhi = NK - 1 - 2 * a0;
        const int ilo = -2 * a0, ihi = NK - 1 - 2 * (a0 + TPW - 1);
        int q = qlo;
        for (; q < ilo && q <= qhi; ++q) {
            bf16x8 bfrag; HY_BFRAG(q, bfrag);
#pragma unroll
            for (int ai = 0; ai < TPW; ++ai) { const int ks = q + 2 * (a0 + ai); if (ks >= 0 && ks < NK) { const bf16x8 a = *(const LAS bf16x8*)(arow + 32 * ks); acc[ai] = MFMA32(a, bfrag, acc[ai]); } }
        }
        if (ilo <= ihi) {
            bf16x8 bnext; HY_BFRAG(q, bnext);
            for (; q <= ihi; ++q) {
                const bf16x8 bfrag = bnext;
                bf16x8 av[TPW];
#pragma unroll
                for (int ai = 0; ai < TPW; ++ai) av[ai] = *(const LAS bf16x8*)(arow + 32 * (q + 2 * (a0 + ai)));
                if (q + 1 <= qhi) HY_BFRAG(q + 1, bnext);
#pragma unroll
                for (int ai = 0; ai < TPW; ++ai) acc[ai] = MFMA32(av[ai], bfrag, acc[ai]);
            }
        }
        for (; q <= qhi; ++q) {
            bf16x8 bfrag; HY_BFRAG(q, bfrag);
#pragma unroll
            for (int ai = 0; ai < TPW; ++ai) { const int ks = q + 2 * (a0 + ai); if (ks >= 0 && ks < NK) { const bf16x8 a = *(const LAS bf16x8*)(arow + 32 * ks); acc[ai] = MFMA32(a, bfrag, acc[ai]); } }
        }
#undef HY_BFRAG
    }
    __syncthreads();
    if (a0 * 32 < L) {
#pragma unroll
        for (int ai = 0; ai < TPW; ++ai)
#pragma unroll
            for (int r = 0; r < 16; ++r) { const int bb = (r & 3) + 8 * (r >> 2) + 4 * h; *(LAS bf16_t*)(lds + bb * PITCH + (32 * (a0 + ai) + c) * 2) = f2bf(acc[ai][r]); }
    }
    __syncthreads();
#pragma unroll 8
    for (int pi = tid; pi < 32 * (L / 8); pi += 512) { const int b = pi / (L / 8), pc = pi % (L / 8); *(u32x4*)(Yg + (size_t)b * L + pc * 8) = *(const LAS u32x4*)(lds + b * PITCH + pc * 16); }
}
DI void phase_hyena(CPARAMS p, int l, LAS unsigned char* lds) {
    const int ch = blockIdx.x; if (ch >= 256) return;
    hyena_unit<SEQ, 8>((const bf16_t*)(p.ws + WS_SL) + (size_t)ch * NB * SEQ, (const bf16_t*)(p.ws + WS_G2048) + (size_t)ch * 2 * SEQ, (bf16_t*)(p.ws + WS_YT) + (size_t)ch * NB * SEQ, lds);
    if (l == 0) hyena_unit<CTXL, 1>((const bf16_t*)(p.ws + WS_SC) + (size_t)ch * NB * CTXL, (const bf16_t*)(p.ws + WS_G256) + (size_t)ch * 2 * CTXL, (bf16_t*)(p.ws + WS_YTC) + (size_t)ch * NB * CTXL, lds);
}


constexpr int LR_XP = 144, LR_XT = 0, LR_XTB = 256 * LR_XP, LR_COMP = 2 * LR_XTB, LR_CARRY = LR_COMP + 8 * 64 * 8, LR_CW = LR_CARRY + 2 * 64 * 4, LR_W = LR_CW + 5 * 64 * 4, LR_END = LR_W + 2 * 64 * LR_XP;
DI void lru_unit(CPARAMS p, int l, int b, int blk, int dir, LAS unsigned char* lds) {
    const int tid = ltid(), lane = tid & 63, wid = __builtin_amdgcn_readfirstlane(tid >> 6), h = lane >> 5, c = lane & 31;
    const bf16_t* Z = (const bf16_t*)(p.ws + WS_Z);
    const bf16_t* WT = (const bf16_t*)(p.ws + WS_LRUW_T);
    bf16_t* OUT = (bf16_t*)(p.ws + (dir ? WS_HB : WS_HF));
    __syncthreads();
    for (int i = tid; i < 5 * 64; i += 512) { const int jj = i >> 6, e = i & 63; ((LAS float*)(lds + LR_CW))[i] = jj < 4 ? p.in[I_LCW][((size_t)l * 4 + jj) * 256 + blk * 64 + e] : p.in[I_LCB][l * 256 + blk * 64 + e]; }
    if (tid < 64) ((LAS float*)(lds + LR_CARRY))[tid] = 0.f;
    for (int pi = tid; pi < 2 * 64 * 8; pi += 512) { const int gate = pi >> 9, e = (pi >> 3) & 63, pc = pi & 7;
        *(LAS u32x4*)(lds + LR_W + (gate * 64 + e) * LR_XP + pc * 16) = *(const u32x4*)(WT + (size_t)(((dir * 2 + gate) * 4 + blk) * 64 + e) * 64 + pc * 8); }
    float ba[2], bx[2], sp8[2];
#pragma unroll
    for (int et = 0; et < 2; ++et) {
        const int e = 32 * et + c;
        const int pi = (l * 2 + dir) * 256 + blk * 64 + e;
        ba[et] = p.in[I_LBA][pi]; bx[et] = p.in[I_LBX][pi]; sp8[et] = -8.f * 1.4426950408889634f * log1pf(expf(-p.in[I_LLAM][pi]));
    }
    const int tq = tid >> 3, cg = tid & 7;
    u32x4 xr[7];
#define LR_GEOM(t) const int _ctx = ((t) == 0); const int L_ = _ctx ? CTXL : SEQ; const int tokbase = _ctx ? TL + b * CTXL : b * SEQ; const int tt_ = _ctx ? 0 : (t) - 1; \
        const int pbase = 256 * tt_, pend = L_ - 1 - 256 * tt_;
#define LR_LOAD(t) do { LR_GEOM(t) const int plo = dir ? pend - 4 * tq - 3 : pbase + 4 * tq; \
        _Pragma("unroll") for (int r = 0; r < 7; ++r) { const int pp = plo - 2 + r; u32x4 v = {0u, 0u, 0u, 0u}; if (pp >= 0 && pp < L_) v = *(const u32x4*)(Z + zoff(tokbase + pp, ZC_LX + blk * 64 + 8 * cg)); xr[r] = v; } } while (0)
#define LR_CONV(t, buf) do { LR_GEOM(t) const int plo = dir ? pend - 4 * tq - 3 : pbase + 4 * tq; (void)L_; (void)tokbase; \
        const LAS float* cwl = (const LAS float*)(lds + LR_CW); \
        _Pragma("unroll") for (int i = 0; i < 4; ++i) { float acc8[8]; \
            _Pragma("unroll") for (int q = 0; q < 8; ++q) acc8[q] = cwl[4 * 64 + 8 * cg + q]; \
            _Pragma("unroll") for (int jj = 0; jj < 4; ++jj) { const u32x4 xv = xr[i + jj]; \
                _Pragma("unroll") for (int d4 = 0; d4 < 4; ++d4) { acc8[2 * d4] += cwl[jj * 64 + 8 * cg + 2 * d4] * __uint_as_float(xv[d4] << 16); acc8[2 * d4 + 1] += cwl[jj * 64 + 8 * cg + 2 * d4 + 1] * __uint_as_float(xv[d4] & 0xffff0000u); } } \
            const int pp = plo + i; const int j = dir ? pend - pp : pp - pbase; \
            u32x4 w; w.x = pk_bf16(acc8[0], acc8[1]); w.y = pk_bf16(acc8[2], acc8[3]); w.z = pk_bf16(acc8[4], acc8[5]); w.w = pk_bf16(acc8[6], acc8[7]); \
            *(LAS u32x4*)(lds + (buf) * LR_XTB + j * LR_XP + cg * 16) = w; } } while (0)
    __syncthreads();
    LR_LOAD(0); LR_CONV(0, 0);
    __syncthreads();
    for (int t = 0; t < 9; ++t) {
        if (t + 1 < 9) LR_LOAD(t + 1);
        LAS unsigned char* xb = lds + (t & 1) * LR_XTB;
        f32x16 ga[2], gx[2];
#pragma unroll
        for (int et = 0; et < 2; ++et)
#pragma unroll
            for (int i = 0; i < 16; ++i) { ga[et][i] = 0.f; gx[et][i] = 0.f; }
#pragma unroll
        for (int s2 = 0; s2 < 4; ++s2) {
            const bf16x8 a = *(const LAS bf16x8*)(xb + (32 * wid + c) * LR_XP + (16 * s2 + 8 * h) * 2);
#pragma unroll
            for (int et = 0; et < 2; ++et) {
                const bf16x8 wa_ = *(const LAS bf16x8*)(lds + LR_W + (32 * et + c) * LR_XP + (16 * s2 + 8 * h) * 2), wx_ = *(const LAS bf16x8*)(lds + LR_W + (64 + 32 * et + c) * LR_XP + (16 * s2 + 8 * h) * 2);
                ga[et] = MFMA32(a, wa_, ga[et]); gx[et] = MFMA32(a, wx_, gx[et]); }
        }
        bf16_t xq[2][16];
#pragma unroll
        for (int et = 0; et < 2; ++et)
#pragma unroll
            for (int r = 0; r < 16; ++r) { const int j = 32 * wid + (r & 3) + 8 * (r >> 2) + 4 * h; xq[et][r] = *(const LAS bf16_t*)(xb + j * LR_XP + (32 * et + c) * 2); }
        __builtin_amdgcn_sched_barrier(0);
#pragma unroll
        for (int et = 0; et < 2; ++et)
#pragma unroll
            for (int r = 0; r < 16; ++r) {
                const float xv = bf2f(xq[et][r]);
                const float rr = __builtin_amdgcn_rcpf(1.f + __builtin_amdgcn_exp2f(-1.4426950408889634f * (ga[et][r] + ba[et])));
                const float ig = __builtin_amdgcn_rcpf(1.f + __builtin_amdgcn_exp2f(-1.4426950408889634f * (gx[et][r] + bx[et])));
                const float av = __builtin_amdgcn_exp2f(sp8[et] * rr);
                ga[et][r] = av; gx[et][r] = __builtin_amdgcn_sqrtf(fmaxf(1.f - av * av, 0.f)) * (ig * xv);
            }
        float PA[2][4], PB[2][4], A0[2][4], B0[2][4];
#pragma unroll
        for (int et = 0; et < 2; ++et) {
            float WA = 1.f, WB = 0.f;
#pragma unroll
            for (int g = 0; g < 4; ++g) {
                float Ag = ga[et][4 * g], Bg = gx[et][4 * g];
#pragma unroll
                for (int i = 1; i < 4; ++i) { Bg = Bg * ga[et][4 * g + i] + gx[et][4 * g + i]; Ag *= ga[et][4 * g + i]; }
                const auto sA_ = __builtin_amdgcn_permlane32_swap(__float_as_uint(Ag), __float_as_uint(Ag), false, false), sB_ = __builtin_amdgcn_permlane32_swap(__float_as_uint(Bg), __float_as_uint(Bg), false, false);
                const float a0 = __uint_as_float(sA_[0]), a1 = __uint_as_float(sA_[1]), b0 = __uint_as_float(sB_[0]), b1 = __uint_as_float(sB_[1]);
                A0[et][g] = a0; B0[et][g] = b0; PA[et][g] = a0 * a1; PB[et][g] = b0 * a1 + b1;
                WB = WB * PA[et][g] + PB[et][g]; WA *= PA[et][g];
            }
            if (h == 0) { LAS float* cp = (LAS float*)(lds + LR_COMP) + (wid * 64 + 32 * et + c) * 2; cp[0] = WA; cp[1] = WB; }
        }
        if (t + 1 < 9) LR_CONV(t + 1, (t + 1) & 1);
        __syncthreads();
        {
            LR_GEOM(t) (void)pbase; (void)pend;
#pragma unroll
            for (int et = 0; et < 2; ++et) {
                const int e = 32 * et + c;
                float hin = ((const LAS float*)(lds + LR_CARRY))[(t & 1) * 64 + e];
                float wa7 = 1.f, wb7 = 0.f;
                for (int w2 = 0; w2 < 8; ++w2) { const LAS float* cp = (const LAS float*)(lds + LR_COMP) + (w2 * 64 + e) * 2; const float ca = cp[0], cb2 = cp[1]; if (w2 < wid) hin = hin * ca + cb2; if (w2 == wid) { wa7 = ca; wb7 = cb2; } }
                if (wid == 7 && h == 0) ((LAS float*)(lds + LR_CARRY))[((t + 1) & 1) * 64 + e] = hin * wa7 + wb7;
                float sg = hin;
#pragma unroll
                for (int g = 0; g < 4; ++g) {
                    float hh = h ? sg * A0[et][g] + B0[et][g] : sg;
#pragma unroll
                    for (int i = 0; i < 4; ++i) {
                        hh = ga[et][4 * g + i] * hh + gx[et][4 * g + i];
                        const int j = 32 * wid + 8 * g + 4 * h + i; const int pp = dir ? (L_ - 1 - 256 * tt_) - j : 256 * tt_ + j;
                        OUT[(size_t)(tokbase + pp) * 256 + blk * 64 + e] = f2bf(hh);
                    }
                    sg = sg * PA[et][g] + PB[et][g];
                }
            }
        }
        __syncthreads();
    }
#undef LR_GEOM
#undef LR_LOAD
#undef LR_CONV
}
DI void phase_lru(CPARAMS p, int l, LAS unsigned char* lds) { const int u = blockIdx.x; if (u < 256) lru_unit(p, l, u >> 3, (u >> 1) & 3, u & 1, lds); }


constexpr int QP_PITCH = 516;
DI float red16(float v) { return row_sum16(v); }
DI void phase_qkvpost(CPARAMS p, int l, LAS unsigned char* lds) {
    const int tid = ltid(), lane = tid & 63, wid = __builtin_amdgcn_readfirstlane(tid >> 6), tq = lane >> 4, li = lane & 15;
    const bf16_t* Z = (const bf16_t*)(p.ws + WS_Z); const bf16_t* RAW = (const bf16_t*)(p.ws + WS_RAW);
    bf16_t* Qo = (bf16_t*)(p.ws + WS_Q); bf16_t* Ko = (bf16_t*)(p.ws + WS_K); bf16_t* VT = (bf16_t*)(p.ws + WS_VT);
    const int d4 = 4 * li, ra = li >> 3, ri = li & 7, dr = 64 + 16 * ra + ri;
    float qg[4], kg[4], qgr[2], kgr[2];
#pragma unroll
    for (int q = 0; q < 4; ++q) { qg[q] = p.in[I_QN][l * 96 + d4 + q]; kg[q] = p.in[I_KN][l * 96 + d4 + q]; }
    qgr[0] = p.in[I_QN][l * 96 + dr]; qgr[1] = p.in[I_QN][l * 96 + dr + 8];
    kgr[0] = p.in[I_KN][l * 96 + dr]; kgr[1] = p.in[I_KN][l * 96 + dr + 8];
    const float invf = __builtin_amdgcn_exp2f(-(float)ri * (13.287712379549449f / 8.f)) * 0.15915494309189535f;
    const float qsc = 0.10206207261596575f * 1.4426950408889634f;
    const int ntl = TL / 64, ntc = TC / 64;
    struct PL { u32x2 wcq[3]; u32x4 wckv; bf16_t kr0, kr1; u32x2 wq[4], wk[4], wv[4]; bf16_t q0[4], q1[4]; };
    const int NTU = ntl + ntc;
#define QP_GEOM(uu) const bool lat = (uu) < ntl; const int tok0 = lat ? (uu) * 64 : TL + ((uu) - ntl) * 64; \
        const int b = lat ? tok0 / SEQ : (tok0 - TL) / CTXL; const int pos0 = lat ? tok0 % SEQ : SEQ + (tok0 - TL) % CTXL; const bool doq = lat || l == 0; (void)b; (void)pos0; (void)doq;
#define QP_LOAD(L, uu, it) do { QP_GEOM(uu) const int tl = wid * 8 + (it) * 4 + tq, tok = tok0 + tl; const bf16_t* rr = RAW + (size_t)tok * 1024; \
        _Pragma("unroll") for (int j = 0; j < 3; ++j) L.wcq[j] = ld4nt(Z + zoff(tok, ZC_CQ + 12 * li + 4 * j)); \
        L.wckv = ld8nt(Z + zoff(tok, ZC_CKV + 8 * li)); \
        L.kr0 = Z[zoff(tok, ZC_KR + 16 * ra + ri)]; L.kr1 = Z[zoff(tok, ZC_KR + 8 + 16 * ra + ri)]; \
        _Pragma("unroll") for (int hh = 0; hh < 4; ++hh) { L.wq[hh] = ld4nt(rr + hh * 96 + d4); L.q0[hh] = rr[hh * 96 + dr]; L.q1[hh] = rr[hh * 96 + dr + 8]; \
            L.wk[hh] = ld4nt(rr + 512 + hh * 128 + d4); L.wv[hh] = ld4nt(rr + 512 + hh * 128 + 64 + d4); } } while (0)
    PL LA, LB;
    if ((int)blockIdx.x < NTU) QP_LOAD(LA, (int)blockIdx.x, 0);
    for (int u = blockIdx.x; u < NTU; u += gridDim.x) {
        QP_GEOM(u)
        __syncthreads();
#pragma unroll
        for (int it = 0; it < 2; ++it) {
            if (it == 0) QP_LOAD(LB, u, 1); else { const int un = u + (int)gridDim.x < NTU ? u + (int)gridDim.x : u; QP_LOAD(LA, un, 0); }
            const PL& L = it == 0 ? LA : LB;
            const int tl = wid * 8 + it * 4 + tq, pos = pos0 + tl;
            const u32x2 (&wcq)[3] = L.wcq; const u32x4 wckv = L.wckv; const bf16_t kr0 = L.kr0, kr1 = L.kr1;
            const u32x2 (&wq)[4] = L.wq; const u32x2 (&wk)[4] = L.wk; const u32x2 (&wv)[4] = L.wv; const bf16_t (&q0)[4] = L.q0; const bf16_t (&q1)[4] = L.q1;
            float sq = 0.f, skv = 0.f;
#pragma unroll
            for (int j = 0; j < 3; ++j) { float f[4]; unpk4(wcq[j], f); sq += f[0] * f[0] + f[1] * f[1] + f[2] * f[2] + f[3] * f[3]; }
            { float f[8]; unpk8(wckv, f);
#pragma unroll
              for (int q = 0; q < 8; ++q) skv += f[q] * f[q]; }
            sq = red16(sq); skv = red16(skv);
            const float rq = rsqrtf(sq * (1.f / 192.f) + EPS), rkv = rsqrtf(skv * (1.f / 128.f) + EPS);
            float cs = 1.f, sn = 0.f;
            if (lat) { const float pa = ra == 0 ? (float)(pos >> 6) : (float)(pos & 63); float rev = pa * invf; rev -= floorf(rev); cs = __builtin_amdgcn_cosf(rev); sn = __builtin_amdgcn_sinf(rev); }
            const float kx1 = bf2f(kr0), kx2 = bf2f(kr1);
#pragma unroll
            for (int hh = 0; hh < 4; ++hh) {
                const size_t ob = (((size_t)b * 4 + hh) * PALL + pos) * 96;
                if (doq) {
                    float qn[4]; unpk4(wq[hh], qn); float x1 = bf2f(q0[hh]), x2 = bf2f(q1[hh]);
                    float ss = x1 * x1 + x2 * x2 + qn[0] * qn[0] + qn[1] * qn[1] + qn[2] * qn[2] + qn[3] * qn[3];
                    ss = red16(ss) * rq * rq;
                    const float rs = rsqrtf(ss * (1.f / 96.f) + EPS) * rq * qsc;
                    u32x2 w; w.x = pk_bf16(qn[0] * rs * qg[0], qn[1] * rs * qg[1]); w.y = pk_bf16(qn[2] * rs * qg[2], qn[3] * rs * qg[3]);
                    *(u32x2*)(Qo + ob + d4) = w;
                    x1 *= rs * qgr[0]; x2 *= rs * qgr[1];
                    Qo[ob + dr] = f2bf(x1 * cs - x2 * sn); Qo[ob + dr + 8] = f2bf(x2 * cs + x1 * sn);
                }
                {
                    float kn[4]; unpk4(wk[hh], kn);
                    float ss = 0.f;
#pragma unroll
                    for (int q = 0; q < 4; ++q) { kn[q] *= rkv; ss += kn[q] * kn[q]; }
                    ss += kx1 * kx1 + kx2 * kx2;
                    ss = red16(ss);
                    const float rs = rsqrtf(ss * (1.f / 96.f) + EPS);
                    u32x2 w; w.x = pk_bf16(kn[0] * rs * kg[0], kn[1] * rs * kg[1]); w.y = pk_bf16(kn[2] * rs * kg[2], kn[3] * rs * kg[3]);
                    *(u32x2*)(Ko + ob + d4) = w;
                    const float y1 = kx1 * rs * kgr[0], y2 = kx2 * rs * kgr[1];
                    Ko[ob + dr] = f2bf(y1 * cs - y2 * sn); Ko[ob + dr + 8] = f2bf(y2 * cs + y1 * sn);
                    float vv[4]; unpk4(wv[hh], vv);
                    u32x2 wv2; wv2.x = pk_bf16(vv[0] * rkv, vv[1] * rkv); wv2.y = pk_bf16(vv[2] * rkv, vv[3] * rkv);
                    LAS unsigned* vl = (LAS unsigned*)(lds + tl * QP_PITCH + (hh * 64 + d4) * 2); vl[0] = wv2.x; vl[1] = wv2.y;
                }
            }
        }
        __syncthreads();
#pragma unroll
        for (int j = 0; j < 4; ++j) {
            const int pi = tid + 512 * j, r = pi >> 3, tp = pi & 7;
            unsigned short e[8];
#pragma unroll
            for (int q = 0; q < 8; ++q) e[q] = *(const LAS bf16_t*)(lds + (tp * 8 + q) * QP_PITCH + r * 2);
            u32x4 w; w.x = (unsigned)e[0] | ((unsigned)e[1] << 16); w.y = (unsigned)e[2] | ((unsigned)e[3] << 16); w.z = (unsigned)e[4] | ((unsigned)e[5] << 16); w.w = (unsigned)e[6] | ((unsigned)e[7] << 16);
            *(u32x4*)(VT + (((size_t)b * 4 + (r >> 6)) * 64 + (r & 63)) * PALL + pos0 + tp * 8) = w;
        }
    }
#undef QP_LOAD
#undef QP_GEOM
}

#define XB_TMO      128
#define XB_XCNT(j)  (256  + 64 * (j))
#define XB_XSUB(j)  (1280 + 64 * (j))
#define XB_XGEN(j)  (2304 + 64 * (j))
#define XB_TOP      3328
#define XB_TOPGEN   3392
#define XCD_BAR_WORDS 3456
#define XB_SPIN_CAP (1u << 18)
__device__ __forceinline__ unsigned xb_ld(unsigned* p)              { return __hip_atomic_load(p, __ATOMIC_RELAXED, __HIP_MEMORY_SCOPE_AGENT); }
__device__ __forceinline__ unsigned xb_add(unsigned* p, unsigned v) { return __hip_atomic_fetch_add(p, v, __ATOMIC_RELAXED, __HIP_MEMORY_SCOPE_AGENT); }
__device__ __forceinline__ unsigned xb_xcc_id() { return (unsigned)__builtin_amdgcn_s_getreg((3 << 11) | 20) & 0xFu; }
#define XB_SPIN(cond, bar) do { unsigned _sp = 0; while (cond) { __builtin_amdgcn_s_sleep(1); \
    if ((++_sp & 255u) == 0u) { if (xb_ld(&(bar)[XB_TMO])) break; if (_sp > XB_SPIN_CAP) { atomicAdd(&(bar)[XB_TMO], 1u); break; } } } } while (0)
struct XcdBarrier { unsigned* bar; unsigned x; volatile LAS unsigned* st; };
__device__ __forceinline__ XcdBarrier xcd_barrier_post(unsigned* bar, volatile LAS unsigned* st) {
    XcdBarrier b; b.bar = bar; b.x = xb_xcc_id(); b.st = st;
    if (threadIdx.x == 0) (void)xb_add(&bar[XB_XCNT(b.x)], 1u);
    return b;
}
__device__ __forceinline__ void xcd_barrier_complete(unsigned* bar, unsigned x, unsigned& nloc, unsigned& nx) {
    const unsigned G = gridDim.x * gridDim.y * gridDim.z;
    unsigned sum, cnt, mine, sp = 0u;
    for (;;) {
        sum = 0u; cnt = 0u; mine = 0u;
#pragma unroll
        for (unsigned j = 0; j < 16; ++j) { const unsigned c = xb_ld(&bar[XB_XCNT(j)]); sum += c; cnt += (c > 0u) ? 1u : 0u; mine = (j == x) ? c : mine; }
        if (sum == G) break;
        __builtin_amdgcn_s_sleep(1);
        if ((++sp & 255u) == 0u) { if (xb_ld(&bar[XB_TMO])) break; if (sp > XB_SPIN_CAP) { atomicAdd(&bar[XB_TMO], 1u); break; } }
    }
    nloc = mine > 0u ? mine : 1u; nx = cnt > 0u ? cnt : 1u;
}
__device__ __forceinline__ void xcd_barrier(const XcdBarrier& b) {
    asm volatile("s_waitcnt vmcnt(0)" ::: "memory");
    __syncthreads();
    if (threadIdx.x == 0) {
        unsigned* bar = b.bar;
        __builtin_amdgcn_s_waitcnt(0);
        unsigned nloc = b.st[0], nx = b.st[1];
        if (nloc == 0u) { xcd_barrier_complete(bar, b.x, nloc, nx); b.st[0] = nloc; b.st[1] = nx; }
        const unsigned old = xb_add(&bar[XB_XSUB(b.x)], 1u);
        const unsigned gen = old / nloc;
        if (old + 1u == (gen + 1u) * nloc) {
            __builtin_amdgcn_fence(__ATOMIC_RELEASE, "agent");
            asm volatile("s_waitcnt vmcnt(0)" ::: "memory");
            const unsigned og = xb_add(&bar[XB_TOP], 1u);
            const unsigned tg = og / nx;
            if (og + 1u == (tg + 1u) * nx) xb_add(&bar[XB_TOPGEN], 1u);
            else XB_SPIN(xb_ld(&bar[XB_TOPGEN]) == tg, bar);
            __builtin_amdgcn_fence(__ATOMIC_ACQUIRE, "agent");
            xb_add(&bar[XB_XGEN(b.x)], 1u);
            asm volatile("s_waitcnt vmcnt(0)" ::: "memory");
        } else {
            XB_SPIN(xb_ld(&bar[XB_XGEN(b.x)]) == gen, bar);
            __builtin_amdgcn_fence(__ATOMIC_ACQUIRE, "agent");
            asm volatile("s_waitcnt vmcnt(0)" ::: "memory");
        }
    }
    __syncthreads();
}

constexpr int CW_BAR = 8192;
constexpr int N_PHASES = 22;
__global__ void __launch_bounds__(512, 2) fwd(Params p_unused) {
    extern __shared__ __attribute__((aligned(16))) unsigned char dynlds[];
    LAS unsigned char* lds = (LAS unsigned char*)dynlds;
    volatile LAS unsigned* st = (volatile LAS unsigned*)(lds + LDS_BYTES - 16);
    if (threadIdx.x == 0) { st[0] = 0u; st[1] = 0u; st[2] = 0u; st[3] = 0u; }
    __syncthreads();
    #define PP (*launder_kp((KP)__builtin_amdgcn_kernarg_segment_ptr()))
    (void)xcd_barrier_post((unsigned*)(PP.ws + WS_CTL) + CW_BAR, st);
#define IN(k) (PP.ph_lo <= (k) && (k) < PP.ph_hi)
#define SEAM(k) do { if (IN(k) && IN((k) + 1)) { XcdBarrier bar_; bar_.bar = (unsigned*)(PP.ws + WS_CTL) + CW_BAR; bar_.x = xb_xcc_id(); bar_.st = (volatile LAS unsigned*)(lds + LDS_BYTES - 16); for (int rb_ = 0; rb_ < 1 + PROBE_BAR; ++rb_) xcd_barrier(bar_); } } while (0)
#ifndef PROBE_PH
#define PROBE_PH -1
#endif
#ifndef PROBE_BAR
#define PROBE_BAR 0
#endif
#ifndef PROBE_DUP
#define PROBE_DUP 0
#endif
#define RUN(bit, call) do { for (int rep_ = 0; rep_ < 1 + ((PROBE_DUP >> (bit)) & 1); ++rep_) { call; } } while (0)
#define PSTART(id) do { if (PROBE_PH == (id) && ltid() == 0) { *(volatile LAS unsigned long long*)(lds + LDS_BYTES - 48) = wall_clock64(); } } while (0)
#define PEND(id) do { if (PROBE_PH == (id) && ltid() == 0) { volatile LAS unsigned long long* q_ = (volatile LAS unsigned long long*)(lds + LDS_BYTES - 48); q_[1] = wall_clock64() - q_[0]; } } while (0)
    PSTART(777); PEND(777);
    PSTART(0);
    if (IN(0)) { phase_mod(PP, (LAS float*)lds); phase_convert(PP, 0, (LAS float*)lds); phase_filter(PP, 0, (LAS float*)lds); }
    SEAM(0); PEND(0);
    PSTART(1);
    if (IN(1)) phase_norm1(PP, 0);
    SEAM(1); PEND(1);
    for (int l = 0; l < 2; ++l) {
        const int pb = 2 + 10 * l;
        PSTART(pb + 0);
        if (IN(pb + 0)) phase_inproj(PP, l, lds);
        SEAM(pb + 0); PEND(pb + 0);
        PSTART(pb + 1);
        if (IN(pb + 1)) { RUN(0, phase_up(PP, l, lds)); RUN(1, phase_hyprep(PP, l, lds)); }
        SEAM(pb + 1); PEND(pb + 1);
        PSTART(pb + 2);
        if (IN(pb + 2)) RUN(2, phase_qkvpost(PP, l, lds));
        SEAM(pb + 2); PEND(pb + 2);
        PSTART(pb + 3);
        if (IN(pb + 3)) { PSTART(200 + pb); phase_attn(PP, l, lds); PEND(200 + pb); PSTART(300 + pb); RUN(3, phase_ret(PP, l, lds)); PEND(300 + pb); PSTART(400 + pb); RUN(4, phase_hyena(PP, l, lds)); PEND(400 + pb); PSTART(500 + pb); RUN(5, phase_lru(PP, l, lds)); PEND(500 + pb); }
        SEAM(pb + 3); PEND(pb + 3);
        PSTART(pb + 4);
        if (IN(pb + 4)) RUN(6, phase_merge(PP, l, lds));
        SEAM(pb + 4); PEND(pb + 4);
        PSTART(pb + 5);
        if (IN(pb + 5)) phase_outproj(PP, l, lds);
        SEAM(pb + 5); PEND(pb + 5);
        PSTART(pb + 6);
        if (IN(pb + 6)) phase_norm2(PP, l, lds);
        SEAM(pb + 6); PEND(pb + 6);
        PSTART(pb + 7);
        if (IN(pb + 7)) phase_moe1(PP, l, lds);
        SEAM(pb + 7); PEND(pb + 7);
        PSTART(pb + 8);
        if (IN(pb + 8)) phase_moe2(PP, l, lds);
        SEAM(pb + 8); PEND(pb + 8);
        PSTART(pb + 9);
        if (IN(pb + 9)) { phase_combine(PP, l); if (l == 0) { phase_convert(PP, 1, (LAS float*)lds); phase_filter(PP, 1, (LAS float*)lds); } }
        if (l == 0) SEAM(pb + 9);
        PEND(pb + 9);
    }
    if (PROBE_PH >= 0) { __syncthreads(); if (ltid() == 0) { const unsigned long long dt_ = ((volatile LAS unsigned long long*)(lds + LDS_BYTES - 48))[1]; const unsigned long long t_ = wall_clock64(); while (wall_clock64() - t_ < dt_) __builtin_amdgcn_s_sleep(8); } }
#undef IN
#undef SEAM
}

#ifndef MK_PER_PHASE
#define MK_PER_PHASE 0
#endif
extern "C" void kernel_launch(void* const* d_in, const int* in_sizes, int n_in, void* d_out, int out_size, void* d_ws, size_t ws_size, hipStream_t stream) {
    static int grid = 0;
    if (grid == 0) {
        if (ws_size < WS_END) fprintf(stderr, "kernel_launch: workspace too small: %zu < %zu\n", ws_size, (size_t)WS_END);
        int dev = 0, cus = 0, per_cu = 0;
        (void)hipGetDevice(&dev); (void)hipDeviceGetAttribute(&cus, hipDeviceAttributeMultiprocessorCount, dev);
        (void)hipFuncSetAttribute((const void*)fwd, hipFuncAttributeMaxDynamicSharedMemorySize, LDS_BYTES);
        if (hipOccupancyMaxActiveBlocksPerMultiprocessor(&per_cu, (const void*)fwd, 512, LDS_BYTES) != hipSuccess || per_cu < 1) { fprintf(stderr, "kernel_launch: occupancy query says %d\n", per_cu); per_cu = 1; }
        (void)hipGetLastError();
        grid = cus > 0 ? cus : 256;
    }
    Params p{};
    for (int i = 0; i < N_IN; ++i) p.in[i] = (const float*)d_in[i];
    p.out = (float*)d_out; p.ws = (unsigned char*)d_ws;
    (void)hipMemsetAsync((char*)d_ws + WS_CTL, 0, 1 * MiB, stream);
#if MK_PER_PHASE
    for (int ph = 0; ph < N_PHASES; ++ph) { p.ph_lo = ph; p.ph_hi = ph + 1; hipLaunchKernelGGL(fwd, dim3(grid), dim3(512), LDS_BYTES, stream, p); }
#else
    p.ph_lo = 0; p.ph_hi = N_PHASES; hipLaunchKernelGGL(fwd, dim3(grid), dim3(512), LDS_BYTES, stream, p);
#endif
}
```
